# Optimizing an MI355X kernel written in HIP

```python
import jax, jax.numpy as jnp
from jax import lax
import numpy as np

D_MODEL = 1024
BATCH = 8
SEQ = 2048
DEPTH = 1

CHUNK = 64
Q_BLOCK = 128
RMS_EPS = 1e-6
FOX_HEADS = 8
FOX_HEAD_DIM = 64
FOX_WIDTH = FOX_HEADS * FOX_HEAD_DIM
MLA_HEADS = 8
MLA_Q_LORA = 384
MLA_KV_LORA = 256
MLA_NOPE_DIM = 64
MLA_ROPE_DIM = 32
MLA_V_DIM = 64
MLA_WIDTH = MLA_HEADS * MLA_V_DIM
ROPE_BASE = 10000.0
MIX_WIDTH = FOX_WIDTH + MLA_WIDTH
IN_SIZES = (FOX_WIDTH, FOX_WIDTH, FOX_WIDTH, FOX_HEADS, MLA_Q_LORA, MLA_KV_LORA, MLA_ROPE_DIM)
IN_COLS = sum(IN_SIZES)
MEM_TOKENS = 256
MEM_HEADS = 4
MEM_HEAD_DIM = 128
MEM_WIDTH = MEM_HEADS * MEM_HEAD_DIM
N_EXPERTS = 32
TOP_K = 4
D_EXPERT = D_MODEL
SWIGLU_LIMIT = 7.0
SWIGLU_ALPHA = 1.702

kernel_name = 'hybrid_fox_mla_moe_stream_encoder'


def rmsnorm(x, g):
    xf = x.astype(jnp.float32)
    y = xf * lax.rsqrt(jnp.mean(xf * xf, axis=-1, keepdims=True) + RMS_EPS)
    return (y * g.astype(jnp.float32)).astype(x.dtype)


def rope_tables(seq_len):
    inv = 1.0 / (ROPE_BASE ** (jnp.arange(0, MLA_ROPE_DIM, 2, dtype=jnp.float32) / MLA_ROPE_DIM))
    ang = jnp.arange(seq_len, dtype=jnp.float32)[:, None] * inv[None, :]
    return jnp.cos(ang), jnp.sin(ang)


def apply_rope(x, cos, sin):
    half = x.shape[-1] // 2
    x1, x2 = x[..., :half], x[..., half:]
    cos = cos.astype(x.dtype)
    sin = sin.astype(x.dtype)
    return jnp.concatenate([x1 * cos - x2 * sin, x2 * cos + x1 * sin], axis=-1)


def to_heads(y, n_heads):
    b, s, _ = y.shape
    return y.reshape(b, s, n_heads, -1).transpose(0, 2, 1, 3)


def from_heads(y):
    b, h, s, d = y.shape
    return y.transpose(0, 2, 1, 3).reshape(b, s, h * d)


def frame_causal(t, s):
    return s <= t


def chunk_causal(t, s):
    return (s // CHUNK) <= (t // CHUNK)


def blocked_attention(q, k, v, mask_fn, decay=None):
    b, h, s_len, dk = q.shape
    dv = v.shape[-1]
    nb = s_len // Q_BLOCK
    scale = dk ** -0.5
    kpos = jnp.arange(s_len, dtype=jnp.int32)
    qb = q.reshape(b, h, nb, Q_BLOCK, dk).transpose(2, 0, 1, 3, 4)
    starts = jnp.arange(nb, dtype=jnp.int32) * Q_BLOCK
    if decay is None:
        xs = (qb, starts)
    else:
        xs = (qb, starts, decay.reshape(b, h, nb, Q_BLOCK).transpose(2, 0, 1, 3))

    def block(args):
        qi, start = args[0], args[1]
        tpos = start + jnp.arange(Q_BLOCK, dtype=jnp.int32)
        logits = jnp.einsum('bhqd,bhkd->bhqk', qi, k).astype(jnp.float32) * scale
        if decay is not None:
            logits = logits + (args[2][..., :, None] - decay[..., None, :])
        allowed = mask_fn(tpos[:, None], kpos[None, :])
        logits = jnp.where(allowed, logits, -jnp.inf)
        p = jax.nn.softmax(logits, axis=-1).astype(v.dtype)
        return jnp.einsum('bhqk,bhkd->bhqd', p, v)

    out = lax.map(block, xs)
    return out.transpose(1, 2, 0, 3, 4).reshape(b, h, s_len, dv)


def parallel_mixer(a, w_in, b_f, g_q_lat, w_uq, g_kv_lat, w_ukv, g_fox_out, g_mla_out, w_o, cos, sin):
    b, s_len, _ = a.shape
    points = np.cumsum(IN_SIZES)[:-1].tolist()
    proj = a @ w_in
    fq, fk, fv, f_logit, q_lat, kv_lat, k_rope = jnp.split(proj, points, axis=-1)

    log_f = jax.nn.log_sigmoid(f_logit.astype(jnp.float32) + b_f.astype(jnp.float32))
    decay = jnp.cumsum(log_f, axis=1).transpose(0, 2, 1)
    o_fox = blocked_attention(to_heads(fq, FOX_HEADS), to_heads(fk, FOX_HEADS),
                              to_heads(fv, FOX_HEADS), frame_causal, decay)
    o_fox = from_heads(o_fox)

    q = (rmsnorm(q_lat, g_q_lat) @ w_uq).reshape(b, s_len, MLA_HEADS, MLA_NOPE_DIM + MLA_ROPE_DIM)
    q_nope, q_pe = q[..., :MLA_NOPE_DIM], q[..., MLA_NOPE_DIM:]
    q_pe = apply_rope(q_pe, cos[:, None, :], sin[:, None, :])
    kv = (rmsnorm(kv_lat, g_kv_lat) @ w_ukv).reshape(b, s_len, MLA_HEADS, MLA_NOPE_DIM + MLA_V_DIM)
    k_nope, v = kv[..., :MLA_NOPE_DIM], kv[..., MLA_NOPE_DIM:]
    k_pe = apply_rope(k_rope, cos, sin)[:, :, None, :]
    k_pe = jnp.broadcast_to(k_pe, (b, s_len, MLA_HEADS, MLA_ROPE_DIM))
    q_full = jnp.concatenate([q_nope, q_pe], axis=-1).transpose(0, 2, 1, 3)
    k_full = jnp.concatenate([k_nope, k_pe], axis=-1).transpose(0, 2, 1, 3)
    o_mla = from_heads(blocked_attention(q_full, k_full, v.transpose(0, 2, 1, 3), chunk_causal))

    mixed = jnp.concatenate([rmsnorm(o_fox, g_fox_out), rmsnorm(o_mla, g_mla_out)], axis=-1)
    return mixed @ w_o


def memory_cross_attention(a, mem_n, w_q, w_kv, w_o):
    q = to_heads(a @ w_q, MEM_HEADS)
    kv = mem_n @ w_kv
    k = to_heads(kv[..., :MEM_WIDTH], MEM_HEADS)
    v = to_heads(kv[..., MEM_WIDTH:], MEM_HEADS)
    logits = jnp.einsum('bhqd,bhmd->bhqm', q, k).astype(jnp.float32) * (MEM_HEAD_DIM ** -0.5)
    p = jax.nn.softmax(logits, axis=-1).astype(v.dtype)
    o = jnp.einsum('bhqm,bhmd->bhqd', p, v)
    return from_heads(o) @ w_o


def moe_ffn(a, w_router, b_router, w_gate_up, b_gate_up, w_down, b_down):
    b, s_len, d = a.shape
    t = a.reshape(-1, d)
    logits = (t @ w_router + b_router).astype(jnp.float32)
    top_v, top_i = lax.top_k(logits, TOP_K)
    top_w = jax.nn.softmax(top_v, axis=-1)
    gates = jnp.sum(jax.nn.one_hot(top_i, N_EXPERTS, dtype=jnp.float32) * top_w[..., None], axis=1)
    gates = gates.astype(t.dtype)
    y = jnp.zeros_like(t)
    for e in range(N_EXPERTS):
        gu = t @ w_gate_up[e] + b_gate_up[e]
        gate = jnp.minimum(gu[:, :D_EXPERT], SWIGLU_LIMIT)
        up = jnp.clip(gu[:, D_EXPERT:], -SWIGLU_LIMIT, SWIGLU_LIMIT)
        act = gate * jax.nn.sigmoid(SWIGLU_ALPHA * gate) * (up + 1.0)
        y = y + gates[:, e:e + 1] * (act @ w_down[e] + b_down[e])
    return y.reshape(b, s_len, d)


def setup_inputs(seed: int = 0) -> dict:
    key = jax.random.key(seed)
    ks = jax.random.split(key, 26)
    L = DEPTH

    def normal(k, shape, scale):
        return jax.random.normal(k, shape, jnp.float32) * scale

    def gain(k, shape):
        return 1.0 + 0.02 * jax.random.normal(k, shape, jnp.float32)

    return {
        'x': normal(ks[0], (BATCH, SEQ, D_MODEL), 1.0),
        'mem': normal(ks[1], (BATCH, MEM_TOKENS, D_MODEL), 1.0),
        'g_mix': gain(ks[2], (L, D_MODEL)),
        'w_in': normal(ks[3], (L, D_MODEL, IN_COLS), D_MODEL ** -0.5),
        'b_f': jax.random.uniform(ks[4], (L, FOX_HEADS), jnp.float32, 1.0, 4.0),
        'g_q_lat': gain(ks[5], (L, MLA_Q_LORA)),
        'w_uq': normal(ks[6], (L, MLA_Q_LORA, MLA_HEADS * (MLA_NOPE_DIM + MLA_ROPE_DIM)), MLA_Q_LORA ** -0.5),
        'g_kv_lat': gain(ks[7], (L, MLA_KV_LORA)),
        'w_ukv': normal(ks[8], (L, MLA_KV_LORA, MLA_HEADS * (MLA_NOPE_DIM + MLA_V_DIM)), MLA_KV_LORA ** -0.5),
        'g_fox_out': gain(ks[9], (L, FOX_WIDTH)),
        'g_mla_out': gain(ks[10], (L, MLA_WIDTH)),
        'w_o': normal(ks[11], (L, MIX_WIDTH, D_MODEL), MIX_WIDTH ** -0.5),
        'g_mem_q': gain(ks[12], (L, D_MODEL)),
        'w_mem_q': normal(ks[13], (L, D_MODEL, MEM_WIDTH), D_MODEL ** -0.5),
        'g_mem_kv': gain(ks[14], (L, D_MODEL)),
        'w_mem_kv': normal(ks[15], (L, D_MODEL, 2 * MEM_WIDTH), D_MODEL ** -0.5),
        'w_mem_o': normal(ks[16], (L, MEM_WIDTH, D_MODEL), MEM_WIDTH ** -0.5),
        'g_ffn': gain(ks[17], (L, D_MODEL)),
        'w_router': normal(ks[18], (L, D_MODEL, N_EXPERTS), D_MODEL ** -0.5),
        'b_router': normal(ks[19], (L, N_EXPERTS), 0.01),
        'w_gate_up': normal(ks[20], (L, N_EXPERTS, D_MODEL, 2 * D_EXPERT), D_MODEL ** -0.5),
        'b_gate_up': normal(ks[21], (L, N_EXPERTS, 2 * D_EXPERT), 0.02),
        'w_down': normal(ks[22], (L, N_EXPERTS, D_EXPERT, D_MODEL), D_EXPERT ** -0.5),
        'b_down': normal(ks[23], (L, N_EXPERTS, D_MODEL), 0.02),
        'g_final': gain(ks[24], (D_MODEL,)),
    }


def reference(x, mem, g_mix, w_in, b_f, g_q_lat, w_uq, g_kv_lat, w_ukv, g_fox_out, g_mla_out, w_o,
              g_mem_q, w_mem_q, g_mem_kv, w_mem_kv, w_mem_o, g_ffn, w_router, b_router,
              w_gate_up, b_gate_up, w_down, b_down, g_final):
    cos, sin = rope_tables(x.shape[1])
    h = x
    for l in range(DEPTH):
        h = h + parallel_mixer(rmsnorm(h, g_mix[l]), w_in[l], b_f[l], g_q_lat[l], w_uq[l],
                               g_kv_lat[l], w_ukv[l], g_fox_out[l], g_mla_out[l], w_o[l], cos, sin)
        h = h + memory_cross_attention(rmsnorm(h, g_mem_q[l]), rmsnorm(mem, g_mem_kv[l]),
                                       w_mem_q[l], w_mem_kv[l], w_mem_o[l])
        h = h + moe_ffn(rmsnorm(h, g_ffn[l]), w_router[l], b_router[l], w_gate_up[l],
                        b_gate_up[l], w_down[l], b_down[l])
    return rmsnorm(h, g_final)
```

```cpp
#include <hip/hip_runtime.h>
#include <hip/hip_cooperative_groups.h>
#include <cstdio>
#include <cstdint>

constexpr int NB = 8, S = 2048, D = 1024, T = NB * S;
constexpr int IN_PAD = 2304;
constexpr int MEMT = 256, MROWS = NB * MEMT;
constexpr int NE = 32, TOPK = 4, NPAIR = T * TOPK;
constexpr int LCAP = T;
constexpr float EPS = 1e-6f;
constexpr float LOG2E = 1.4426950408889634f;
constexpr float QS_FOX = 0.125f * LOG2E;
constexpr float QS_MLA = 0.10206207261596577f * LOG2E;
constexpr float QS_MEM = 0.08838834764831845f * LOG2E;

typedef unsigned short bf16;
typedef float f32x4 __attribute__((ext_vector_type(4)));
typedef unsigned u32x4 __attribute__((ext_vector_type(4)));
typedef unsigned u32x2 __attribute__((ext_vector_type(2)));

constexpr size_t MiB = 1u << 20;
constexpr size_t WS_CTL = 0;
constexpr size_t WS_CNT = 64 * 1024;
constexpr size_t WS_RS1 = 1 * MiB + 5 * 65536, WS_RS3 = 1 * MiB + 6 * 65536, WS_RSMEM = 1 * MiB + 7 * 65536;
constexpr size_t WS_PQ = 11 * MiB, WS_PKV = 12 * MiB, WS_PFOX = 12 * MiB + 524288, WS_PMLA = 13 * MiB, WS_P2 = 14 * MiB;
constexpr size_t WS_COS = 2 * MiB, WS_SIN = 2 * MiB + 131072, WS_WR = 2 * MiB + 262144, WS_LOGF = 3 * MiB, WS_CDEC = 3 * MiB + 524288, WS_KROPE = 4 * MiB;
constexpr size_t WS_TOKE = 6 * MiB, WS_TOKP = 6 * MiB + 262144, WS_LIST = 7 * MiB, WS_GATEV = 9 * MiB;
constexpr size_t WS_WIN = 16 * MiB, WS_WUQ = 21 * MiB, WS_WUKV = 22 * MiB, WS_WO = 23 * MiB, WS_WMQ = 25 * MiB, WS_WMKV = 26 * MiB, WS_WMO = 28 * MiB;
constexpr size_t WS_WGU = 32 * MiB, WS_WD = 160 * MiB;
constexpr size_t WS_XB = 224 * MiB, WS_MEMB = 256 * MiB, WS_KVM = 260 * MiB, WS_QF = 264 * MiB, WS_KF = 280 * MiB, WS_VF = 296 * MiB;
constexpr size_t WS_QLAT = 312 * MiB, WS_KVLAT = 324 * MiB, WS_QM = 332 * MiB, WS_KM = 356 * MiB, WS_VM = 380 * MiB, WS_OMIX = 396 * MiB;
constexpr size_t WS_H1 = 428 * MiB, WS_QMEM = 460 * MiB, WS_OMEM = 476 * MiB, WS_H2 = 492 * MiB, WS_ACT = 524 * MiB, WS_YP = 653 * MiB, WS_END = 782 * MiB;

struct Params {
    const float *x, *mem, *g_mix, *w_in, *b_f, *g_q_lat, *w_uq, *g_kv_lat, *w_ukv, *g_fox_out, *g_mla_out, *w_o, *g_mem_q, *w_mem_q, *g_mem_kv, *w_mem_kv, *w_mem_o,
        *g_ffn, *w_router, *b_router, *w_gate_up, *b_gate_up, *w_down, *b_down, *g_final;
    float* out; unsigned char* ws;
    int ph_lo, ph_hi;
};
struct Bufs {
    int* cnt; float *pq, *pkv, *pfox, *pmla, *p2, *rs1, *rs3, *rsmem, *cosT, *sinT, *wr, *logf, *cdec, *krope, *gatev;
    int *toke, *tokp, *list;
    bf16 *WinT, *WuqT, *WukvT, *WoT, *WmqT, *WmkvT, *WmoT, *WguT, *WdT;
    bf16 *xb, *memb, *KVm, *Qf, *Kf, *Vf, *qlat, *kvlat, *Qm, *Km, *Vm, *Omix, *h1, *Qmem, *Omem, *h2, *act, *yp;
};
__host__ __device__ __forceinline__ Bufs make_bufs(unsigned char* ws) {
    Bufs b;
    b.cnt = (int*)(ws + WS_CNT);
    b.pq = (float*)(ws + WS_PQ); b.pkv = (float*)(ws + WS_PKV); b.pfox = (float*)(ws + WS_PFOX); b.pmla = (float*)(ws + WS_PMLA);
    b.p2 = (float*)(ws + WS_P2); b.rs1 = (float*)(ws + WS_RS1); b.rs3 = (float*)(ws + WS_RS3); b.rsmem = (float*)(ws + WS_RSMEM);
    b.cosT = (float*)(ws + WS_COS); b.sinT = (float*)(ws + WS_SIN); b.wr = (float*)(ws + WS_WR); b.logf = (float*)(ws + WS_LOGF); b.cdec = (float*)(ws + WS_CDEC);
    b.krope = (float*)(ws + WS_KROPE); b.gatev = (float*)(ws + WS_GATEV);
    b.toke = (int*)(ws + WS_TOKE); b.tokp = (int*)(ws + WS_TOKP); b.list = (int*)(ws + WS_LIST);
    b.WinT = (bf16*)(ws + WS_WIN); b.WuqT = (bf16*)(ws + WS_WUQ); b.WukvT = (bf16*)(ws + WS_WUKV); b.WoT = (bf16*)(ws + WS_WO); b.WmqT = (bf16*)(ws + WS_WMQ);
    b.WmkvT = (bf16*)(ws + WS_WMKV); b.WmoT = (bf16*)(ws + WS_WMO); b.WguT = (bf16*)(ws + WS_WGU); b.WdT = (bf16*)(ws + WS_WD);
    b.xb = (bf16*)(ws + WS_XB); b.memb = (bf16*)(ws + WS_MEMB); b.KVm = (bf16*)(ws + WS_KVM); b.Qf = (bf16*)(ws + WS_QF); b.Kf = (bf16*)(ws + WS_KF); b.Vf = (bf16*)(ws + WS_VF);
    b.qlat = (bf16*)(ws + WS_QLAT); b.kvlat = (bf16*)(ws + WS_KVLAT); b.Qm = (bf16*)(ws + WS_QM); b.Km = (bf16*)(ws + WS_KM); b.Vm = (bf16*)(ws + WS_VM);
    b.Omix = (bf16*)(ws + WS_OMIX); b.h1 = (bf16*)(ws + WS_H1); b.Qmem = (bf16*)(ws + WS_QMEM); b.Omem = (bf16*)(ws + WS_OMEM); b.h2 = (bf16*)(ws + WS_H2);
    b.act = (bf16*)(ws + WS_ACT); b.yp = (bf16*)(ws + WS_YP);
    return b;
}

__device__ __forceinline__ unsigned f2bf(float f) { unsigned u = __builtin_bit_cast(unsigned, f); return (u + 0x7fffu + ((u >> 16) & 1u)) >> 16; }
__device__ __forceinline__ unsigned pk2(float lo, float hi) { return f2bf(lo) | (f2bf(hi) << 16); }
__device__ __forceinline__ float bf2f(unsigned short h) { return __builtin_bit_cast(float, (unsigned)h << 16); }
__device__ __forceinline__ float bflo(unsigned w) { return __builtin_bit_cast(float, w << 16); }
__device__ __forceinline__ float bfhi(unsigned w) { return __builtin_bit_cast(float, w & 0xffff0000u); }
__device__ __forceinline__ float wave_sum(float v) {
#pragma unroll
    for (int o = 1; o < 64; o <<= 1) v += __shfl_xor(v, o);
    return v;
}
__device__ __forceinline__ float wave_max(float v) {
#pragma unroll
    for (int o = 1; o < 64; o <<= 1) v = fmaxf(v, __shfl_xor(v, o));
    return v;
}
__device__ __forceinline__ void unpack8(const u32x4 w, float (&f)[8]) {
    f[0] = bflo(w.x); f[1] = bfhi(w.x); f[2] = bflo(w.y); f[3] = bfhi(w.y); f[4] = bflo(w.z); f[5] = bfhi(w.z); f[6] = bflo(w.w); f[7] = bfhi(w.w);
}
__device__ __forceinline__ u32x4 pack8(const float (&f)[8]) { u32x4 w; w.x = pk2(f[0], f[1]); w.y = pk2(f[2], f[3]); w.z = pk2(f[4], f[5]); w.w = pk2(f[6], f[7]); return w; }

constexpr int TP_LDS = 64 * 257 * 4;
struct TItem { const float* W; int ldw, Nsrc, K; const float* gain; const float* gain2; bf16* WT; int mapkind; int k0, n0; };
__device__ __forceinline__ int map_row(int kind, int n) {
    if (kind == 0) return n;
    if (kind == 1) {
        if (n < 1536) return n;
        if (n < 1544) return 2208 + (n - 1536);
        if (n < 1928) return 1536 + (n - 1544);
        if (n < 2184) return 1920 + (n - 1928);
        return 2176 + (n - 2184);
    }
    return ((n & 1023) >> 7) * 256 + (n >> 10) * 128 + (n & 127);
}
__device__ __forceinline__ void transpose_item(const TItem& it, float* Sm) {
    const int tid = threadIdx.x;
#pragma unroll
    for (int j = 0; j < 8; ++j) {
        const int kr = (tid >> 6) + 8 * j, n4 = (tid & 63) * 4, n = it.n0 + n4, k = it.k0 + kr;
        f32x4 v = (f32x4){0.f, 0.f, 0.f, 0.f};
        if (n < it.Nsrc) v = *(const f32x4*)(it.W + (size_t)k * it.ldw + n);
        float g = 1.f;
        if (it.gain) g = (it.gain2 && k >= 512) ? it.gain2[k - 512] : it.gain[k];
        float* s = Sm + kr * 257 + n4;
        s[0] = v.x * g; s[1] = v.y * g; s[2] = v.z * g; s[3] = v.w * g;
    }
    __syncthreads();
#pragma unroll
    for (int j = 0; j < 4; ++j) {
        const int r = (tid >> 3) + 64 * j, c = tid & 7, n = it.n0 + r;
        if (n < it.Nsrc) {
            const int row = map_row(it.mapkind, n);
            const float* s = Sm + (8 * c) * 257 + r;
            u32x4 o; o.x = pk2(s[0], s[257]); o.y = pk2(s[2 * 257], s[3 * 257]); o.z = pk2(s[4 * 257], s[5 * 257]); o.w = pk2(s[6 * 257], s[7 * 257]);
            *(u32x4*)(it.WT + (size_t)row * it.K + it.k0 + 8 * c) = o;
        }
    }
    __syncthreads();
}
constexpr int TI_WIN = 16 * 9, TI_WUQ = 6 * 3, TI_WUKV = 4 * 4, TI_WO = 16 * 4, TI_WMQ = 16 * 2, TI_WMKV = 16 * 4, TI_WMO = 8 * 4, TI_WGU = 32 * 16 * 8, TI_WD = 32 * 16 * 4;
constexpr int TI_TOTAL = TI_WIN + TI_WUQ + TI_WUKV + TI_WO + TI_WMQ + TI_WMKV + TI_WMO + TI_WGU + TI_WD;
__device__ __forceinline__ TItem get_titem(const Params& p, const Bufs& b, int i) {
    TItem t; t.gain2 = nullptr; t.mapkind = 0;
    auto fill = [&](const float* W, int ldw, int Nsrc, int K, const float* g, bf16* WT, int li) { const int nn = (Nsrc + 255) / 256; t.W = W; t.ldw = ldw; t.Nsrc = Nsrc; t.K = K; t.gain = g; t.WT = WT; t.k0 = (li / nn) * 64; t.n0 = (li % nn) * 256; };
    if (i < TI_WIN) { fill(p.w_in, 2216, 2216, 1024, p.g_mix, b.WinT, i); t.mapkind = 1; return t; } i -= TI_WIN;
    if (i < TI_WUQ) { fill(p.w_uq, 768, 768, 384, p.g_q_lat, b.WuqT, i); return t; } i -= TI_WUQ;
    if (i < TI_WUKV) { fill(p.w_ukv, 1024, 1024, 256, p.g_kv_lat, b.WukvT, i); return t; } i -= TI_WUKV;
    if (i < TI_WO) { fill(p.w_o, 1024, 1024, 1024, p.g_fox_out, b.WoT, i); t.gain2 = p.g_mla_out; return t; } i -= TI_WO;
    if (i < TI_WMQ) { fill(p.w_mem_q, 512, 512, 1024, p.g_mem_q, b.WmqT, i); return t; } i -= TI_WMQ;
    if (i < TI_WMKV) { fill(p.w_mem_kv, 1024, 1024, 1024, p.g_mem_kv, b.WmkvT, i); return t; } i -= TI_WMKV;
    if (i < TI_WMO) { fill(p.w_mem_o, 1024, 1024, 512, nullptr, b.WmoT, i); return t; } i -= TI_WMO;
    if (i < TI_WGU) { const int e = i / 128; fill(p.w_gate_up + (size_t)e * 1024 * 2048, 2048, 2048, 1024, p.g_ffn, b.WguT + (size_t)e * 2048 * 1024, i % 128); t.mapkind = 2; return t; } i -= TI_WGU;
    { const int e = i / 64; fill(p.w_down + (size_t)e * 1024 * 1024, 1024, 1024, 1024, nullptr, b.WdT + (size_t)e * 1024 * 1024, i % 64); return t; }
}
__device__ __forceinline__ void row_to_bf16(const float* xrow, bf16* orow, float* rs_out, int lane) {
    const f32x4* xr = (const f32x4*)xrow + lane;
    f32x4 v[4]; float s = 0.f;
#pragma unroll
    for (int j = 0; j < 4; ++j) { v[j] = xr[64 * j]; s += (v[j].x * v[j].x + v[j].y * v[j].y) + (v[j].z * v[j].z + v[j].w * v[j].w); }
    s = wave_sum(s);
    if (lane == 0) *rs_out = 1.0f / sqrtf(s * (1.0f / 1024.0f) + EPS);
    u32x2* o8 = (u32x2*)orow + lane;
#pragma unroll
    for (int j = 0; j < 4; ++j) { u32x2 w; w.x = pk2(v[j].x, v[j].y); w.y = pk2(v[j].z, v[j].w); o8[64 * j] = w; }
}
__device__ __forceinline__ void prep_phase(const Params& p, const Bufs& b, unsigned char* lds, int vblock, int nblocks) {
    const int tid = threadIdx.x, lane = tid & 63, wave = tid >> 6;
    float* Sm = (float*)lds;
    for (int i = vblock; i < TI_TOTAL; i += nblocks) { const TItem t = get_titem(p, b, i); transpose_item(t, Sm); }
    const int gw = vblock * 8 + wave, ngw = nblocks * 8;
    for (int r = gw; r < T; r += ngw) row_to_bf16(p.x + (size_t)r * D, b.xb + (size_t)r * D, b.rs1 + r, lane);
    for (int r = gw; r < MROWS; r += ngw) row_to_bf16(p.mem + (size_t)r * D, b.memb + (size_t)r * D, b.rsmem + r, lane);
    const int gt = vblock * 512 + tid, ngt = nblocks * 512;
    for (int i = gt; i < S * 16; i += ngt) {
        const int s = i >> 4, j = i & 15; const double inv = pow(10000.0, -(double)j / 16.0), ang = (double)s * inv;
        b.cosT[i] = (float)cos(ang); b.sinT[i] = (float)sin(ang);
    }
    for (int i = gt; i < 1024 * 32; i += ngt) b.wr[i] = p.w_router[i] * p.g_ffn[i >> 5];
    for (int i = gt; i < (int)(5 * MiB / 16); i += ngt) ((u32x4*)(p.ws + WS_PQ))[i] = (u32x4){0u, 0u, 0u, 0u};
    for (int i = gt; i < 32; i += ngt) b.cnt[i] = 0;
    for (int i = gt; i < (IN_PAD - 2216) * 1024 / 8; i += ngt) ((u32x4*)(b.WinT + (size_t)2216 * 1024))[i] = (u32x4){0u, 0u, 0u, 0u};
}

struct Unit { int kind, pm, pn, e, m0, rows; };
struct GemmOp { const bf16* A; const int* rowlist; const bf16* B; int K; int khook; };

__device__ __forceinline__ void dense_map(int L, int nM, int nN, int& pm, int& pn) {
    const int nwg = nM * nN; int wgid = L; { const int q = nwg / 8, r = nwg % 8, xcd = wgid % 8, off = wgid / 8; wgid = (xcd < r ? xcd * (q + 1) : r * (q + 1) + (xcd - r) * q) + off; }
    const int nig = 8 * nN, gid = wgid / nig, fm = gid * 8, gsz = (nM - fm) < 8 ? (nM - fm) : 8;
    pm = fm + ((wgid % nig) % gsz); pn = (wgid % nig) / gsz;
}
struct SchedIn {
    static constexpr int NUNITS = 64 * 9 + 8 * 4;
    __device__ __forceinline__ static void get(int i, Unit& u) { if (i < 576) { u.kind = 0; dense_map(i, 64, 9, u.pm, u.pn); } else { i -= 576; u.kind = 1; u.pm = i / 4; u.pn = i % 4; } u.e = 0; u.m0 = 0; u.rows = 256; }
    __device__ __forceinline__ static GemmOp op(const Bufs& b, const Unit& u) {
        GemmOp g; g.rowlist = nullptr; g.K = 1024; g.khook = 0;
        if (u.kind == 0) { g.A = b.xb + (size_t)u.pm * 256 * 1024; g.B = b.WinT + (size_t)u.pn * 256 * 1024; }
        else { g.A = b.memb + (size_t)u.pm * 256 * 1024; g.B = b.WmkvT + (size_t)u.pn * 256 * 1024; }
        return g;
    }
};
struct EpiIn {
    static constexpr bool HOOK = false, PAIRED = false; Params p; Bufs b;
    template <bool FAST> __device__ __forceinline__ void operator()(const Unit& u, int r, int c, float (&v)[8]) const {
        const int row = u.pm * 256 + r, gc = u.pn * 256 + c;
        if (u.kind == 1) { const float s = b.rsmem[row];
#pragma unroll
            for (int i = 0; i < 8; ++i) v[i] *= s;
            *(u32x4*)(b.KVm + (size_t)row * 1024 + gc) = pack8(v); return; }
        const float s = b.rs1[row];
#pragma unroll
        for (int i = 0; i < 8; ++i) v[i] *= s;
        if (gc < 1536) {
            bf16* dst = b.Qf + (size_t)(gc >> 9) * (8u << 20);
            if (gc < 512) {
#pragma unroll
                for (int i = 0; i < 8; ++i) v[i] *= QS_FOX;
            }
            *(u32x4*)(dst + (size_t)row * 512 + (gc & 511)) = pack8(v);
        } else if (gc < 2176) {
            const bool isq = gc < 1920;
            float ss = 0.f;
#pragma unroll
            for (int i = 0; i < 8; ++i) ss += v[i] * v[i];
            if (isq) *(u32x4*)(b.qlat + (size_t)row * 384 + (gc - 1536)) = pack8(v);
            else *(u32x4*)(b.kvlat + (size_t)row * 256 + (gc - 1920)) = pack8(v);
            float* dst = isq ? b.pq + (size_t)row * 12 + ((gc - 1536) >> 5) : b.pkv + (size_t)row * 8 + ((gc - 1920) >> 5);
            if (FAST) { ss += __shfl_xor(ss, 16); ss += __shfl_xor(ss, 32); if ((threadIdx.x & 63) < 16) *dst = ss; }
            else *dst += ss;
        } else if (gc < 2208) {
            float* dst = b.krope + (size_t)row * 32 + (gc - 2176);
            *(f32x4*)dst = (f32x4){v[0], v[1], v[2], v[3]}; *(f32x4*)(dst + 4) = (f32x4){v[4], v[5], v[6], v[7]};
        } else if (gc == 2208) {
            float o[8];
#pragma unroll
            for (int i = 0; i < 8; ++i) { const float z = v[i] + p.b_f[i]; o[i] = fminf(z, 0.f) - logf(1.0f + expf(-fabsf(z))); }
            float* dst = b.logf + (size_t)row * 8;
            *(f32x4*)dst = (f32x4){o[0], o[1], o[2], o[3]}; *(f32x4*)(dst + 4) = (f32x4){o[4], o[5], o[6], o[7]};
        }
    }
};
struct SchedUp {
    static constexpr int NUNITS = 64 * 3 + 64 * 4;
    __device__ __forceinline__ static void get(int i, Unit& u) { if (i < 192) { u.kind = 0; dense_map(i, 64, 3, u.pm, u.pn); } else { i -= 192; u.kind = 1; dense_map(i, 64, 4, u.pm, u.pn); } u.e = 0; u.m0 = 0; u.rows = 256; }
    __device__ __forceinline__ static GemmOp op(const Bufs& b, const Unit& u) {
        GemmOp g; g.rowlist = nullptr; g.khook = 0;
        if (u.kind == 0) { g.K = 384; g.A = b.qlat + (size_t)u.pm * 256 * 384; g.B = b.WuqT + (size_t)u.pn * 256 * 384; }
        else { g.K = 256; g.A = b.kvlat + (size_t)u.pm * 256 * 256; g.B = b.WukvT + (size_t)u.pn * 256 * 256; }
        return g;
    }
};
struct SchedUpQ { static constexpr int NUNITS = 192; __device__ __forceinline__ static void get(int i, Unit& u) { SchedUp::get(i, u); } __device__ __forceinline__ static GemmOp op(const Bufs& b, const Unit& u) { return SchedUp::op(b, u); } };
struct SchedUpKV { static constexpr int NUNITS = 256; __device__ __forceinline__ static void get(int i, Unit& u) { SchedUp::get(192 + i, u); } __device__ __forceinline__ static GemmOp op(const Bufs& b, const Unit& u) { return SchedUp::op(b, u); } };
struct EpiUp {
    static constexpr bool HOOK = false, PAIRED = false; Params p; Bufs b;
    template <bool FAST> __device__ __forceinline__ void operator()(const Unit& u, int r, int c, float (&v)[8]) const {
        const int row = u.pm * 256 + r, gc = u.pn * 256 + c;
        if (u.kind == 0) {
            float q = 0.f;
#pragma unroll
            for (int i = 0; i < 12; ++i) q += b.pq[(size_t)row * 12 + i];
            const float s = (1.0f / sqrtf(q * (1.0f / 384.0f) + EPS)) * QS_MLA;
#pragma unroll
            for (int i = 0; i < 8; ++i) v[i] *= s;
            *(u32x4*)(b.Qm + (size_t)row * 768 + gc) = pack8(v);
        } else {
            float q = 0.f;
#pragma unroll
            for (int i = 0; i < 8; ++i) q += b.pkv[(size_t)row * 8 + i];
            const float s = 1.0f / sqrtf(q * (1.0f / 256.0f) + EPS);
#pragma unroll
            for (int i = 0; i < 8; ++i) v[i] *= s;
            const int h = gc >> 7, w = gc & 127;
            if (w < 64) *(u32x4*)(b.Km + (size_t)row * 768 + h * 96 + w) = pack8(v);
            else *(u32x4*)(b.Vm + (size_t)row * 512 + h * 64 + (w - 64)) = pack8(v);
        }
    }
};
struct SchedOut {
    static constexpr int NUNITS = 64 * 4;
    __device__ __forceinline__ static void get(int i, Unit& u) { u.kind = 0; dense_map(i, 64, 4, u.pm, u.pn); u.e = 0; u.m0 = 0; u.rows = 256; }
    __device__ __forceinline__ static GemmOp op(const Bufs& b, const Unit& u) { GemmOp g; g.rowlist = nullptr; g.K = 1024; g.khook = 512; g.A = b.Omix + (size_t)u.pm * 256 * 1024; g.B = b.WoT + (size_t)u.pn * 256 * 1024; return g; }
};
__device__ __forceinline__ float rs_of(float ssq, float n) { return 1.0f / sqrtf(ssq / n + EPS); }
__device__ __forceinline__ float sum8(const float* q) { const f32x4 a = *(const f32x4*)q, c = *(const f32x4*)(q + 4); return ((a.x + a.y) + (a.z + a.w)) + ((c.x + c.y) + (c.z + c.w)); }
struct EpiOut {
    static constexpr bool HOOK = true, PAIRED = false; Params p; Bufs b;
    __device__ __forceinline__ float hook_ratio(const Unit& u, int r) const { const int row = u.pm * 256 + r; return rs_of(sum8(b.pfox + (size_t)row * 8), 512.f) / rs_of(sum8(b.pmla + (size_t)row * 8), 512.f); }
    template <bool FAST> __device__ __forceinline__ void operator()(const Unit& u, int r, int c, float (&v)[8]) const {
        const int row = u.pm * 256 + r, gc = u.pn * 256 + c;
        const float s = rs_of(sum8(b.pmla + (size_t)row * 8), 512.f);
        const float* xr = p.x + (size_t)row * D + gc; const f32x4 x0 = *(const f32x4*)xr, x1 = *(const f32x4*)(xr + 4);
        v[0] = x0.x + v[0] * s; v[1] = x0.y + v[1] * s; v[2] = x0.z + v[2] * s; v[3] = x0.w + v[3] * s;
        v[4] = x1.x + v[4] * s; v[5] = x1.y + v[5] * s; v[6] = x1.z + v[6] * s; v[7] = x1.w + v[7] * s;
        float ss = 0.f;
#pragma unroll
        for (int i = 0; i < 8; ++i) ss += v[i] * v[i];
        *(u32x4*)(b.h1 + (size_t)row * D + gc) = pack8(v);
        float* dst = b.p2 + (size_t)row * 32 + (gc >> 5);
        if (FAST) { ss += __shfl_xor(ss, 16); ss += __shfl_xor(ss, 32); if ((threadIdx.x & 63) < 16) *dst = ss; }
        else *dst += ss;
    }
};
struct SchedMq {
    static constexpr int NUNITS = 64 * 2;
    __device__ __forceinline__ static void get(int i, Unit& u) { u.kind = 0; dense_map(i, 64, 2, u.pm, u.pn); u.e = 0; u.m0 = 0; u.rows = 256; }
    __device__ __forceinline__ static GemmOp op(const Bufs& b, const Unit& u) { GemmOp g; g.rowlist = nullptr; g.K = 1024; g.khook = 0; g.A = b.h1 + (size_t)u.pm * 256 * 1024; g.B = b.WmqT + (size_t)u.pn * 256 * 1024; return g; }
};
struct EpiMq {
    static constexpr bool HOOK = false, PAIRED = false; Params p; Bufs b;
    template <bool FAST> __device__ __forceinline__ void operator()(const Unit& u, int r, int c, float (&v)[8]) const {
        const int row = u.pm * 256 + r, gc = u.pn * 256 + c; float q = 0.f;
#pragma unroll
        for (int i = 0; i < 4; ++i) q += sum8(b.p2 + (size_t)row * 32 + 8 * i);
        const float s = rs_of(q, 1024.f) * QS_MEM;
#pragma unroll
        for (int i = 0; i < 8; ++i) v[i] *= s;
        *(u32x4*)(b.Qmem + (size_t)row * 512 + gc) = pack8(v);
    }
};
struct SchedMo {
    static constexpr int NUNITS = 64 * 4;
    __device__ __forceinline__ static void get(int i, Unit& u) { u.kind = 0; dense_map(i, 64, 4, u.pm, u.pn); u.e = 0; u.m0 = 0; u.rows = 256; }
    __device__ __forceinline__ static GemmOp op(const Bufs& b, const Unit& u) { GemmOp g; g.rowlist = nullptr; g.K = 512; g.khook = 0; g.A = b.Omem + (size_t)u.pm * 256 * 512; g.B = b.WmoT + (size_t)u.pn * 256 * 512; return g; }
};
struct EpiMo {
    static constexpr bool HOOK = false, PAIRED = false; Params p; Bufs b;
    template <bool FAST> __device__ __forceinline__ void operator()(const Unit& u, int r, int c, float (&v)[8]) const {
        const int row = u.pm * 256 + r, gc = u.pn * 256 + c; float h[8]; unpack8(*(const u32x4*)(b.h1 + (size_t)row * D + gc), h);
#pragma unroll
        for (int i = 0; i < 8; ++i) v[i] += h[i];
        *(u32x4*)(b.h2 + (size_t)row * D + gc) = pack8(v);
    }
};
#define LAS __attribute__((address_space(3)))
struct MoeTabL { int ntile[32]; int cumT[33]; int off[33]; };
__device__ __forceinline__ void moe_unit(const int* cnt, int npn, int i, Unit& u, int& valid) {
    int base = 0; valid = 0;
    for (int e = 0; e < NE; ++e) { const int c = cnt[e], nt = (c + 255) >> 8, nu = nt * npn; if (i < base + nu) { const int l = i - base; u.kind = 0; u.e = e; u.pn = l / nt; u.pm = l % nt; u.m0 = u.pm * 256; u.rows = min(256, c - u.m0); valid = 1; return; } base += nu; }
}
__device__ __forceinline__ int moe_off(const int* cnt, int e) { int o = 0; for (int i = 0; i < e; ++i) o += cnt[i]; return o; }
struct EpiG1 {
    static constexpr bool HOOK = false, PAIRED = true; Params p; Bufs b; LAS MoeTabL* tab; int off_fixed;
    __device__ __forceinline__ void pair(const Unit& u, int r, int c, float (&vg)[8], float (&vu)[8]) const {
        if (r >= u.rows) return;
        const int off_e = tab ? tab->off[u.e] : off_fixed;
        const int tok = b.list[u.e * LCAP + u.m0 + r]; const float rs = b.rs3[tok];
        const int col = u.pn * 128 + c; const float* bg = p.b_gate_up + (size_t)u.e * 2048 + col;
        float o[8];
#pragma unroll
        for (int i = 0; i < 8; ++i) { float g = vg[i] * rs + bg[i], uu = vu[i] * rs + bg[1024 + i]; g = fminf(g, 7.0f); uu = fminf(fmaxf(uu, -7.0f), 7.0f);
            o[i] = g * (1.0f / (1.0f + __expf(-1.702f * g))) * (uu + 1.0f); }
        *(u32x4*)(b.act + (size_t)(off_e + u.m0 + r) * 1024 + col) = pack8(o);
    }
};
struct EpiG2 {
    static constexpr bool HOOK = false, PAIRED = false; Params p; Bufs b; LAS MoeTabL* tab; int off_fixed;
    template <bool FAST> __device__ __forceinline__ void operator()(const Unit& u, int r, int c, float (&v)[8]) const {
        if (r >= u.rows) return;
        const int off_e = tab ? tab->off[u.e] : off_fixed;
        const int col = u.pn * 256 + c; const float gw = b.gatev[u.e * LCAP + u.m0 + r]; const float* bd = p.b_down + (size_t)u.e * 1024 + col;
#pragma unroll
        for (int i = 0; i < 8; ++i) v[i] = (v[i] + bd[i]) * gw;
        *(u32x4*)(b.yp + (size_t)(off_e + u.m0 + r) * 1024 + col) = pack8(v);
    }
};

__device__ __forceinline__ void naive_dot8(const bf16* arow, const bf16* Bbase, int K, int c, int khook, float ratio, float (&acc)[8]) {
#pragma unroll
    for (int i = 0; i < 8; ++i) acc[i] = 0.f;
    for (int k = 0; k < K; k += 8) {
        if (khook && k == khook) {
#pragma unroll
            for (int i = 0; i < 8; ++i) acc[i] *= ratio;
        }
        float a[8]; unpack8(*(const u32x4*)(arow + k), a);
#pragma unroll
        for (int i = 0; i < 8; ++i) { float w[8]; unpack8(*(const u32x4*)(Bbase + (size_t)(c + i) * K + k), w);
#pragma unroll
            for (int j = 0; j < 8; ++j) acc[i] += a[j] * w[j]; }
    }
}
template <class Sched, class Epi> __global__ void __launch_bounds__(512) k_naive_gemm(Params p) {
    const Bufs b = make_bufs(p.ws); const Epi E{p, b};
    Unit u; Sched::get(blockIdx.x, u); const GemmOp g = Sched::op(b, u);
    const int tid = threadIdx.x, r = tid >> 1, ch = (tid & 1) * 128;
    const bf16* arow = g.A + (size_t)r * g.K;
    float ratio = 1.f; if constexpr (Epi::HOOK) ratio = E.hook_ratio(u, r);
    for (int cg = 0; cg < 16; ++cg) { const int c = ch + cg * 8; float acc[8]; naive_dot8(arow, g.B, g.K, c, g.khook, ratio, acc); E.template operator()<false>(u, r, c, acc); }
}
template <int WHICH> __global__ void __launch_bounds__(512) k_naive_moe(Params p) {
    const Bufs b = make_bufs(p.ws);
    Unit u; int valid; moe_unit(b.cnt, WHICH == 1 ? 8 : 4, blockIdx.x, u, valid); if (!valid) return;
    const int off_e = moe_off(b.cnt, u.e);
    const int tid = threadIdx.x, r = tid >> 1;
    const int rr = r < u.rows ? r : 0;
    if (WHICH == 1) {
        const bf16* arow = b.h2 + (size_t)b.list[u.e * LCAP + u.m0 + rr] * 1024; const bf16* B = b.WguT + (size_t)u.e * 2048 * 1024 + (size_t)u.pn * 256 * 1024;
        EpiG1 E{p, b, nullptr, off_e};
        for (int cg = 0; cg < 8; ++cg) { const int c = (tid & 1) * 64 + cg * 8; float ag[8], au[8]; naive_dot8(arow, B, 1024, c, 0, 1.f, ag); naive_dot8(arow, B, 1024, 128 + c, 0, 1.f, au); E.pair(u, r, c, ag, au); }
    } else {
        const bf16* arow = b.act + (size_t)(off_e + u.m0 + rr) * 1024; const bf16* B = b.WdT + (size_t)u.e * 1024 * 1024 + (size_t)u.pn * 256 * 1024;
        EpiG2 E{p, b, nullptr, off_e};
        for (int cg = 0; cg < 16; ++cg) { const int c = (tid & 1) * 128 + cg * 8; float acc[8]; naive_dot8(arow, B, 1024, c, 0, 1.f, acc); E.template operator()<false>(u, r, c, acc); }
    }
}

__device__ __forceinline__ void kpe_task(const Bufs& b, int gt, int ngt) {
    for (int i = gt; i < T * 16; i += ngt) {
        const int row = i >> 4, j = i & 15, pos = row & (S - 1);
        const float x1 = b.krope[(size_t)row * 32 + j], x2 = b.krope[(size_t)row * 32 + 16 + j], c = b.cosT[pos * 16 + j], sn = b.sinT[pos * 16 + j];
        const bf16 y1 = (bf16)f2bf(x1 * c - x2 * sn), y2 = (bf16)f2bf(x2 * c + x1 * sn);
        bf16* dst = b.Km + (size_t)row * 768 + 64 + j;
#pragma unroll
        for (int h = 0; h < 8; ++h) { dst[h * 96] = y1; dst[h * 96 + 16] = y2; }
    }
}
__device__ __forceinline__ void scan_task(const Bufs& b, int gw, int ngw, int lane) {
    for (int q = gw; q < NB * 8; q += ngw) {
        const int bb = q >> 3, h = q & 7; float carry = 0.f;
        for (int s0 = 0; s0 < S; s0 += 64) {
            float v = b.logf[(size_t)(bb * S + s0 + lane) * 8 + h];
#pragma unroll
            for (int o = 1; o < 64; o <<= 1) { const float t = __shfl_up(v, o); if (lane >= o) v += t; }
            b.cdec[(size_t)q * S + s0 + lane] = (carry + v) * LOG2E;
            carry += __shfl(v, 63);
        }
    }
}
__global__ void __launch_bounds__(512) k_side2(Params p) {
    const Bufs b = make_bufs(p.ws);
    kpe_task(b, blockIdx.x * 512 + threadIdx.x, gridDim.x * 512);
    scan_task(b, blockIdx.x * 8 + (threadIdx.x >> 6), gridDim.x * 8, threadIdx.x & 63);
}

template <int MODE> __global__ void __launch_bounds__(256) k_naive_attn(Params p) {
    constexpr int DK = MODE == 0 ? 64 : (MODE == 1 ? 96 : 128), DV = MODE == 2 ? 128 : 64, NH = MODE == 2 ? 4 : 8;
    __shared__ float lg[4][2048]; __shared__ float qs[4][128];
    const Bufs b = make_bufs(p.ws);
    const int lane = threadIdx.x & 63, w = threadIdx.x >> 6;
    const int item = blockIdx.x * 4 + w;
    const int t = item % S, h = (item / S) % NH, bb = item / (S * NH);
    const int row = bb * S + t;
    const bf16* Q = MODE == 0 ? b.Qf + (size_t)row * 512 + h * 64 : (MODE == 1 ? b.Qm + (size_t)row * 768 + h * 96 : b.Qmem + (size_t)row * 512 + h * 128);
    for (int d = lane; d < DK; d += 64) qs[w][d] = bf2f(Q[d]);
    __syncthreads();
    if (MODE == 1 && lane < 16) { const float x1 = qs[w][64 + lane], x2 = qs[w][80 + lane], c = b.cosT[t * 16 + lane], sn = b.sinT[t * 16 + lane];
        qs[w][64 + lane] = bf2f((bf16)f2bf(x1 * c - x2 * sn)); qs[w][80 + lane] = bf2f((bf16)f2bf(x2 * c + x1 * sn)); }
    __syncthreads();
    const int limit = MODE == 0 ? t + 1 : (MODE == 1 ? 64 * (t / 64 + 1) : MEMT);
    const bf16* Kb = MODE == 0 ? b.Kf + (size_t)bb * S * 512 + h * 64 : (MODE == 1 ? b.Km + (size_t)bb * S * 768 + h * 96 : b.KVm + (size_t)bb * MEMT * 1024 + h * 128);
    const int ldk = MODE == 0 ? 512 : (MODE == 1 ? 768 : 1024);
    const bf16* Vb = MODE == 0 ? b.Vf + (size_t)bb * S * 512 + h * 64 : (MODE == 1 ? b.Vm + (size_t)bb * S * 512 + h * 64 : b.KVm + (size_t)bb * MEMT * 1024 + 512 + h * 128);
    const int ldv = MODE == 2 ? 1024 : 512;
    const float* cd = b.cdec + (size_t)(bb * 8 + h) * S;
    float mx = -INFINITY;
    for (int s = lane; s < limit; s += 64) {
        float dot = 0.f;
        for (int d = 0; d < DK; d += 8) { float kk[8]; unpack8(*(const u32x4*)(Kb + (size_t)s * ldk + d), kk);
#pragma unroll
            for (int i = 0; i < 8; ++i) dot += qs[w][d + i] * kk[i]; }
        if (MODE == 0) dot += cd[t] - cd[s];
        lg[w][s] = dot; mx = fmaxf(mx, dot);
    }
    mx = wave_max(mx);
    float sum = 0.f;
    for (int s = lane; s < limit; s += 64) { const float e = exp2f(lg[w][s] - mx); lg[w][s] = e; sum += e; }
    sum = wave_sum(sum);
    __syncthreads();
    float o0 = 0.f, o1 = 0.f;
    for (int s = 0; s < limit; ++s) { const float pp = lg[w][s]; o0 += pp * bf2f(Vb[(size_t)s * ldv + lane]); if (DV == 128) o1 += pp * bf2f(Vb[(size_t)s * ldv + 64 + lane]); }
    const float inv = 1.0f / sum; o0 *= inv; o1 *= inv;
    if (MODE == 0) { b.Omix[(size_t)row * 1024 + h * 64 + lane] = (bf16)f2bf(o0); const float ss = wave_sum(o0 * o0); if (lane == 0) b.pfox[(size_t)row * 8 + h] = ss; }
    else if (MODE == 1) { b.Omix[(size_t)row * 1024 + 512 + h * 64 + lane] = (bf16)f2bf(o0); const float ss = wave_sum(o0 * o0); if (lane == 0) b.pmla[(size_t)row * 8 + h] = ss; }
    else { b.Omem[(size_t)row * 512 + h * 128 + lane] = (bf16)f2bf(o0); b.Omem[(size_t)row * 512 + h * 128 + 64 + lane] = (bf16)f2bf(o1); }
}

__device__ __forceinline__ void router_token(const Params& p, const Bufs& b, int tok, int lane, float* lgs  , float* rowb  ) {
    float ss = 0.f;
    { const u32x4* hr = (const u32x4*)(b.h2 + (size_t)tok * D + lane * 16); float a[8], c[8]; unpack8(hr[0], a); unpack8(hr[1], c);
#pragma unroll
      for (int i = 0; i < 8; ++i) { ss += a[i] * a[i] + c[i] * c[i]; }
      f32x4* dst = (f32x4*)(rowb + lane * 16);
      dst[0] = (f32x4){a[0], a[1], a[2], a[3]}; dst[1] = (f32x4){a[4], a[5], a[6], a[7]}; dst[2] = (f32x4){c[0], c[1], c[2], c[3]}; dst[3] = (f32x4){c[4], c[5], c[6], c[7]}; }
    ss = wave_sum(ss);
    const float rs = 1.0f / sqrtf(ss * (1.0f / 1024.0f) + EPS);
    __builtin_amdgcn_s_waitcnt(0xc07f); __builtin_amdgcn_wave_barrier();
    {
        const int e = lane & 31, k0 = (lane >> 5) * 512; const float* wr = b.wr + (size_t)k0 * 32 + e; const float* xr = rowb + k0;
        float a0 = 0.f, a1 = 0.f, a2 = 0.f, a3 = 0.f;
#pragma unroll 4
        for (int k = 0; k < 512; k += 4) { const f32x4 xv = *(const f32x4*)(xr + k); a0 += xv.x * wr[(k + 0) * 32]; a1 += xv.y * wr[(k + 1) * 32]; a2 += xv.z * wr[(k + 2) * 32]; a3 += xv.w * wr[(k + 3) * 32]; }
        float acc = (a0 + a1) + (a2 + a3);
        acc += __shfl_xor(acc, 32);
        if (lane < 32) lgs[e] = acc * rs + p.b_router[e];
    }
    __builtin_amdgcn_s_waitcnt(0xc07f); __builtin_amdgcn_wave_barrier();
    {
        unsigned taken = 0u; float tv0 = 0.f, tv1 = 0.f, tv2 = 0.f, tv3 = 0.f; int ti0 = 0, ti1 = 0, ti2 = 0, ti3 = 0;
#pragma unroll
        for (int k = 0; k < 4; ++k) {
            float best = -INFINITY; int bi = 0;
            for (int e = 0; e < 32; ++e) { const float x = lgs[e]; if (!((taken >> e) & 1u) && x > best) { best = x; bi = e; } }
            taken |= 1u << bi;
            if (k == 0) { tv0 = best; ti0 = bi; } else if (k == 1) { tv1 = best; ti1 = bi; } else if (k == 2) { tv2 = best; ti2 = bi; } else { tv3 = best; ti3 = bi; }
        }
        const float e0 = 1.0f, e1 = expf(tv1 - tv0), e2 = expf(tv2 - tv0), e3 = expf(tv3 - tv0), inv = 1.0f / (e0 + e1 + e2 + e3);
        if (lane < 4) {
            const int e = lane == 0 ? ti0 : (lane == 1 ? ti1 : (lane == 2 ? ti2 : ti3));
            const float w = (lane == 0 ? e0 : (lane == 1 ? e1 : (lane == 2 ? e2 : e3))) * inv;
            const int pos = atomicAdd(b.cnt + e, 1); b.list[e * LCAP + pos] = tok; b.gatev[e * LCAP + pos] = w; b.toke[tok * 4 + lane] = e; b.tokp[tok * 4 + lane] = pos;
        }
        if (lane == 0) b.rs3[tok] = rs;
    }
    __builtin_amdgcn_wave_barrier();
}
__global__ void __launch_bounds__(512) k_router(Params p) {
    __shared__ float lgs[8][32]; __shared__ __attribute__((aligned(16))) float rowb[8][1024];
    const Bufs b = make_bufs(p.ws); const int lane = threadIdx.x & 63, w = threadIdx.x >> 6;
    for (int tok = blockIdx.x * 8 + w; tok < T; tok += gridDim.x * 8) router_token(p, b, tok, lane, lgs[w], rowb[w]);
}
__device__ __forceinline__ void final_token(const Params& p, const Bufs& b, int tok, int lane, const int* offs  ) {
    float v[16];
#pragma unroll
    for (int hf = 0; hf < 2; ++hf) { float a[8]; unpack8(*(const u32x4*)(b.h2 + (size_t)tok * D + hf * 512 + lane * 8), a);
#pragma unroll
        for (int i = 0; i < 8; ++i) v[hf * 8 + i] = a[i]; }
#pragma unroll
    for (int k = 0; k < 4; ++k) { const int e = b.toke[tok * 4 + k], slot = offs[e] + b.tokp[tok * 4 + k];
#pragma unroll
        for (int hf = 0; hf < 2; ++hf) { float a[8]; unpack8(*(const u32x4*)(b.yp + (size_t)slot * D + hf * 512 + lane * 8), a);
#pragma unroll
            for (int i = 0; i < 8; ++i) v[hf * 8 + i] += a[i]; } }
    float ss = 0.f;
#pragma unroll
    for (int i = 0; i < 16; ++i) ss += v[i] * v[i];
    ss = wave_sum(ss);
    const float rs = 1.0f / sqrtf(ss * (1.0f / 1024.0f) + EPS);
#pragma unroll
    for (int hf = 0; hf < 2; ++hf) { const float* g = p.g_final + hf * 512 + lane * 8; float* o = p.out + (size_t)tok * D + hf * 512 + lane * 8;
        const f32x4 g0 = *(const f32x4*)g, g1 = *(const f32x4*)(g + 4);
        *(f32x4*)o = (f32x4){v[hf * 8 + 0] * rs * g0.x, v[hf * 8 + 1] * rs * g0.y, v[hf * 8 + 2] * rs * g0.z, v[hf * 8 + 3] * rs * g0.w};
        *(f32x4*)(o + 4) = (f32x4){v[hf * 8 + 4] * rs * g1.x, v[hf * 8 + 5] * rs * g1.y, v[hf * 8 + 6] * rs * g1.z, v[hf * 8 + 7] * rs * g1.w}; }
}
__global__ void __launch_bounds__(512) k_final(Params p) {
    __shared__ int offs[32];
    const Bufs b = make_bufs(p.ws); const int lane = threadIdx.x & 63, w = threadIdx.x >> 6;
    if (threadIdx.x < 32) offs[threadIdx.x] = moe_off(b.cnt, threadIdx.x);
    __syncthreads();
    for (int tok = blockIdx.x * 8 + w; tok < T; tok += gridDim.x * 8) final_token(p, b, tok, lane, offs);
}
__global__ void __launch_bounds__(512) k_prep(Params p) {
    extern __shared__ __attribute__((aligned(16))) unsigned char lds[];
    const Bufs b = make_bufs(p.ws);
    prep_phase(p, b, lds, blockIdx.x, gridDim.x);
}

typedef short bf16x8 __attribute__((ext_vector_type(8)));
namespace pg8 {
constexpr int BM = 256, BK = 64, HALF = 128, HTB = HALF * BK * 2, STAGE_BYTES = 8 * HTB;
__host__ __device__ __forceinline__ int lds_byte(int r, int c) { const int st = (r >> 4) * 2 + (c >> 5), rr = r & 15, cc = c & 31, ob = rr * 64 + cc * 2; return st * 1024 + (ob ^ (((ob >> 9) & 1) << 5)); }
__host__ __device__ __forceinline__ void stage_rc(int b, int& R, int& C) { const int st = b / 1024, sb = b % 1024, swz = sb ^ (((sb >> 9) & 1) << 5); R = (st >> 1) * 16 + swz / 64; C = (st & 1) * 32 + (swz % 64) / 2; }
__host__ __device__ __forceinline__ int perm32(int rho) { const int n = rho >> 4, i = rho & 15; return 8 * (i >> 2) + 4 * n + (i & 3); }

template <class Sched, class Epi>
__device__ __forceinline__ void gemm_phase(LAS unsigned char* lds, const Sched& S, const Epi& E) {
    const int tid = threadIdx.x, wid = __builtin_amdgcn_readfirstlane(tid >> 6), lane = tid & 63, wr = wid >> 2, wc = wid & 3, fr = lane & 15, fq = lane >> 4;
    int RA[2], CA[2], RB[2];
#pragma unroll
    for (int i = 0; i < 2; ++i) { int R, C; stage_rc(tid * 16 + i * 8192, R, C); RA[i] = R; CA[i] = C; RB[i] = (R & ~31) + perm32(R & 31); }
    const unsigned ldsw = (unsigned)wid * 1024u;
    const int aoff = lds_byte(wr * 64 + fr, fq * 8), boff = lds_byte(wc * 32 + fr, fq * 8);
#define PG8_SA(b, h) (((b) * 2 + (h)) * HTB)
#define PG8_SB(b, h) ((4 + (b) * 2 + (h)) * HTB)
#define PG8_STAGE(bufoff, gbase, v0, v1) do { \
        __builtin_amdgcn_global_load_lds((const unsigned*)((gbase) + (v0)), (LAS unsigned*)(lds + (bufoff) + ldsw), 16, 0, 0); \
        __builtin_amdgcn_global_load_lds((const unsigned*)((gbase) + (v1)), (LAS unsigned*)(lds + (bufoff) + ldsw + 8192), 16, 0, 0); } while (0)
#define PG8_LDA(dst, b, h) do { _Pragma("unroll") for (int m = 0; m < 4; ++m) _Pragma("unroll") for (int k = 0; k < 2; ++k) dst[m][k] = *(const LAS bf16x8*)(lds + PG8_SA(b, h) + aoff + m * 2048 + k * 1024); } while (0)
#define PG8_LDB(dst, b, h) do { _Pragma("unroll") for (int n = 0; n < 2; ++n) _Pragma("unroll") for (int k = 0; k < 2; ++k) dst[n][k] = *(const LAS bf16x8*)(lds + PG8_SB(b, h) + boff + n * 2048 + k * 1024); } while (0)
#define PG8_MMA(ai, bj, At, Bt) do { __builtin_amdgcn_s_setprio(1); _Pragma("unroll") for (int m = 0; m < 4; ++m) _Pragma("unroll") for (int n = 0; n < 2; ++n) _Pragma("unroll") for (int k = 0; k < 2; ++k) \
        acc[ai][bj][m][n] = __builtin_amdgcn_mfma_f32_16x16x32_bf16(Bt[n][k], At[m][k], acc[ai][bj][m][n], 0, 0, 0); __builtin_amdgcn_s_setprio(0); } while (0)
#define PG8_WAIT_V(n) asm volatile("s_waitcnt vmcnt(" #n ")" ::: "memory")
#define PG8_WAIT_L(n) asm volatile("s_waitcnt lgkmcnt(" #n ")" ::: "memory")
#define PG8_BAR __builtin_amdgcn_s_barrier()
#define PG8_SCHED __builtin_amdgcn_sched_barrier(0)
    Unit cur, nxt; int ui = 0;
    if (!S.next(0, cur)) return;
    f32x4 acc[2][2][4][2];
#pragma unroll
    for (int a = 0; a < 2; ++a)
#pragma unroll
        for (int b = 0; b < 2; ++b)
#pragma unroll
            for (int m = 0; m < 4; ++m)
#pragma unroll
                for (int n = 0; n < 2; ++n) acc[a][b][m][n] = (f32x4){0.f, 0.f, 0.f, 0.f};
    bf16x8 At[4][2], B0[2][2], B1[2][2];
    const int K = S.K, nt = K / BK, khook_t = S.khook ? S.khook / BK : -1;
    const unsigned vB0 = (unsigned)(RB[0] * K + CA[0]) * 2u, vB1 = (unsigned)(RB[1] * K + CA[1]) * 2u;
    const size_t hstep = (size_t)HALF * K * 2;
    constexpr size_t kstep = (size_t)(BK * 2);
    const char *cA, *cB, *nA, *nB;
    unsigned vA00 = (unsigned)(RA[0] * K + CA[0]) * 2u, vA01 = (unsigned)(RA[1] * K + CA[1]) * 2u, vA10 = vA00 + (unsigned)hstep, vA11 = vA01 + (unsigned)hstep;
    unsigned nvA00 = vA00, nvA01 = vA01, nvA10 = vA10, nvA11 = vA11;
#define PG8_SETUP(u, pA, pB, a00, a01, a10, a11) do { const GemmOp g_ = S.op(u); pA = (const char*)g_.A; pB = (const char*)g_.B; \
        if constexpr (Sched::GATHER) { const int mx_ = (u).rows - 1; const int r00 = g_.rowlist[min(RA[0], mx_)], r01 = g_.rowlist[min(RA[1], mx_)], r10 = g_.rowlist[min(HALF + RA[0], mx_)], r11 = g_.rowlist[min(HALF + RA[1], mx_)]; \
            a00 = (unsigned)(r00 * K + CA[0]) * 2u; a01 = (unsigned)(r01 * K + CA[1]) * 2u; a10 = (unsigned)(r10 * K + CA[0]) * 2u; a11 = (unsigned)(r11 * K + CA[1]) * 2u; } } while (0)
    PG8_SETUP(cur, cA, cB, vA00, vA01, vA10, vA11);
    PG8_STAGE(PG8_SB(0, 0), cB, vB0, vB1); PG8_STAGE(PG8_SB(0, 1), cB + hstep, vB0, vB1); PG8_STAGE(PG8_SA(0, 0), cA, vA00, vA01); PG8_STAGE(PG8_SA(0, 1), cA, vA10, vA11);
    if (wr == 1) PG8_BAR;
    PG8_WAIT_V(2); PG8_BAR;
    PG8_STAGE(PG8_SB(1, 0), cB + kstep, vB0, vB1); PG8_STAGE(PG8_SA(1, 0), cA + kstep, vA00, vA01); PG8_STAGE(PG8_SB(1, 1), cB + hstep + kstep, vB0, vB1);
    PG8_WAIT_V(6); PG8_BAR;
    for (;;) {
        const bool has_next = S.next(ui + 1, nxt);
        if (has_next) PG8_SETUP(nxt, nA, nB, nvA00, nvA01, nvA10, nvA11);
        else { nA = cA; nB = cB; if constexpr (Sched::GATHER) { nvA00 = vA00; nvA01 = vA01; nvA10 = vA10; nvA11 = vA11; } }
        for (int t = 0; t < nt; t += 2) {
            const bool last = (t == nt - 2);
            if constexpr (Epi::HOOK) { if (t == khook_t) {
#pragma unroll
                for (int ai = 0; ai < 2; ++ai)
#pragma unroll
                    for (int m = 0; m < 4; ++m) { int rh = ai * HALF + wr * 64 + m * 16 + fr; asm volatile("" : "+v"(rh)); const float rt = E.hook_ratio(cur, rh);
#pragma unroll
                        for (int bj = 0; bj < 2; ++bj)
#pragma unroll
                            for (int n = 0; n < 2; ++n) acc[ai][bj][m][n] = acc[ai][bj][m][n] * rt;
                        asm volatile("" ::: "memory"); } } }
            const char* a1 = cA + (size_t)(t + 1) * kstep;
            const char* a2 = last ? nA : cA + (size_t)(t + 2) * kstep; const char* b2 = last ? nB : cB + (size_t)(t + 2) * kstep;
            const char* a3 = a2 + kstep; const char* b3 = b2 + kstep;
            unsigned wA00 = vA00, wA01 = vA01, wA10 = vA10, wA11 = vA11;
            if constexpr (Sched::GATHER) { wA00 = last ? nvA00 : vA00; wA01 = last ? nvA01 : vA01; wA10 = last ? nvA10 : vA10; wA11 = last ? nvA11 : vA11; }
            PG8_LDB(B0, 0, 0); PG8_LDB(B1, 0, 1); PG8_SCHED; PG8_LDA(At, 0, 0); PG8_STAGE(PG8_SA(1, 1), a1, vA10, vA11);
            PG8_WAIT_V(8); PG8_WAIT_L(0); PG8_BAR; PG8_MMA(0, 0, At, B0); PG8_MMA(0, 1, At, B1); PG8_BAR; PG8_SCHED;
            PG8_LDA(At, 0, 1); PG8_STAGE(PG8_SB(0, 0), b2, vB0, vB1); PG8_STAGE(PG8_SB(0, 1), b2 + hstep, vB0, vB1); PG8_STAGE(PG8_SA(0, 0), a2, wA00, wA01);
            PG8_WAIT_V(8); PG8_WAIT_L(0); PG8_BAR; PG8_MMA(1, 0, At, B0); PG8_MMA(1, 1, At, B1); PG8_BAR; PG8_SCHED;
            PG8_LDB(B0, 1, 0); PG8_LDB(B1, 1, 1); PG8_SCHED; PG8_LDA(At, 1, 0); PG8_STAGE(PG8_SA(0, 1), a2, wA10, wA11);
            PG8_WAIT_V(8); PG8_WAIT_L(0); PG8_BAR; PG8_MMA(0, 0, At, B0); PG8_MMA(0, 1, At, B1); PG8_BAR; PG8_SCHED;
            PG8_LDA(At, 1, 1); PG8_STAGE(PG8_SB(1, 0), b3, vB0, vB1); PG8_STAGE(PG8_SB(1, 1), b3 + hstep, vB0, vB1); PG8_STAGE(PG8_SA(1, 0), a3, wA00, wA01);
            PG8_WAIT_V(8); PG8_WAIT_L(0); PG8_BAR; PG8_MMA(1, 0, At, B0); PG8_MMA(1, 1, At, B1); PG8_BAR; PG8_SCHED;
        }
        if (wr == 0) PG8_BAR;
#pragma unroll
        for (int ai = 0; ai < 2; ++ai)
#pragma unroll
            for (int m = 0; m < 4; ++m) {
                int r = ai * HALF + wr * 64 + m * 16 + fr; asm volatile("" : "+v"(r));
                if constexpr (Epi::PAIRED) {
                    float vg[8], vu[8];
#pragma unroll
                    for (int j = 0; j < 4; ++j) { vg[j] = acc[ai][0][m][0][j]; vg[4 + j] = acc[ai][0][m][1][j]; vu[j] = acc[ai][1][m][0][j]; vu[4 + j] = acc[ai][1][m][1][j]; }
                    E.pair(cur, r, wc * 32 + 8 * fq, vg, vu);
                } else {
#pragma unroll
                    for (int bj = 0; bj < 2; ++bj) { float v[8];
#pragma unroll
                        for (int j = 0; j < 4; ++j) { v[j] = acc[ai][bj][m][0][j]; v[4 + j] = acc[ai][bj][m][1][j]; }
                        E.template operator()<true>(cur, r, bj * HALF + wc * 32 + 8 * fq, v); }
                }
                asm volatile("" ::: "memory");
            }
        if (!has_next) break;
#pragma unroll
        for (int a = 0; a < 2; ++a)
#pragma unroll
            for (int b = 0; b < 2; ++b)
#pragma unroll
                for (int m = 0; m < 4; ++m)
#pragma unroll
                    for (int n = 0; n < 2; ++n) acc[a][b][m][n] = (f32x4){0.f, 0.f, 0.f, 0.f};
        cur = nxt; cA = nA; cB = nB; if constexpr (Sched::GATHER) { vA00 = nvA00; vA01 = nvA01; vA10 = nvA10; vA11 = nvA11; } ++ui;
        if (wr == 1) PG8_BAR;
    }
    PG8_WAIT_V(0);
    PG8_BAR;
#undef PG8_SA
#undef PG8_SB
#undef PG8_STAGE
#undef PG8_LDA
#undef PG8_LDB
#undef PG8_MMA
#undef PG8_WAIT_V
#undef PG8_WAIT_L
#undef PG8_BAR
#undef PG8_SCHED
#undef PG8_SETUP
}
}

typedef float f32x16 __attribute__((ext_vector_type(16)));
typedef short s16x4 __attribute__((ext_vector_type(4)));
typedef float f32x2_t __attribute__((ext_vector_type(2)));
typedef __bf16 bf16x2_t __attribute__((ext_vector_type(2)));
__device__ __forceinline__ unsigned cvtpk(float lo, float hi) { f32x2_t v = {lo, hi}; bf16x2_t b = __builtin_convertvector(v, bf16x2_t); return __builtin_bit_cast(unsigned, b); }
__device__ __forceinline__ int crow(int r, int hi) { return (r & 3) + 8 * (r >> 2) + 4 * hi; }
struct AttnPtrs { const bf16* Q; int ldq; const bf16* K; int ldk; const bf16* V; int ldv; bf16* O; int ldo; float* part; int pstride; const float* cd; const float* cosT; const float* sinT; };
template <int DK, int DV, int MODE>
__device__ __forceinline__ void attn_unit(LAS unsigned char* lds, const AttnPtrs& A, int qb) {
    constexpr int KSLOT = DK * 128, VSLOT = DV * 128, NKP = DK / 8, NVP = DV / 8, BUF = KSLOT + VSLOT, ND = DK / 16, NO = DV / 32;
    const int tid = threadIdx.x, lane = tid & 63, r32 = lane & 31, hi = lane >> 5; const int wid = __builtin_amdgcn_readfirstlane(tid >> 6);
    const int q0 = qb * 256, qrow = q0 + wid * 32 + r32;
    const int NT = MODE == 2 ? 4 : 4 * qb + 4, NTw = MODE == 2 ? 4 : 4 * qb + (wid >> 1) + 1;
    auto issue = [&](int t, int buf) {
        LAS unsigned char* base = lds + buf * BUF;
        for (int pi = wid; pi < NKP + NVP; pi += 8) {
            if (pi < NKP) { const bf16* src = A.K + (size_t)(t * 64 + lane) * A.ldk + pi * 8; __builtin_amdgcn_global_load_lds((const unsigned*)src, (LAS unsigned*)(base + pi * 1024), 16, 0, 0); }
            else { const int v = pi - NKP, dh = v >> 2, kg = v & 3; const bf16* src = A.V + (size_t)(t * 64 + 16 * kg + (lane >> 2)) * A.ldv + dh * 32 + (lane & 3) * 8;
                   __builtin_amdgcn_global_load_lds((const unsigned*)src, (LAS unsigned*)(base + KSLOT + v * 1024), 16, 0, 0); }
        }
    };
    issue(0, 0);
    bf16x8 qr[ND];
#pragma unroll
    for (int d0 = 0; d0 < ND; ++d0) qr[d0] = *(const bf16x8*)(A.Q + (size_t)qrow * A.ldq + d0 * 16 + hi * 8);
    if constexpr (MODE == 1) {
        const float* cp = A.cosT + qrow * 16 + hi * 8; const float* sp = A.sinT + qrow * 16 + hi * 8;
        bf16x8 a = qr[4], c = qr[5];
#pragma unroll
        for (int i = 0; i < 8; ++i) { const float x1 = bf2f((unsigned short)a[i]), x2 = bf2f((unsigned short)c[i]), cs = cp[i], sn = sp[i];
            a[i] = (short)f2bf(x1 * cs - x2 * sn); c[i] = (short)f2bf(x2 * cs + x1 * sn); }
        qr[4] = a; qr[5] = c;
    }
    float m = -INFINITY, l = 0.f; f32x16 o[NO];
#pragma unroll
    for (int i = 0; i < NO; ++i) o[i] = f32x16{};
    float cq = 0.f; if constexpr (MODE == 0) cq = A.cd[qrow];
    __syncthreads();
    for (int t = 0; t < NT; ++t) {
        const int cur = t & 1;
        if (t + 1 < NT) issue(t + 1, cur ^ 1);
        if (t < NTw) {
            const LAS unsigned char* Kb = lds + cur * BUF + hi * 1024 + r32 * 16;
            f32x16 p0, p1;
            if constexpr (MODE == 0) {
                const float* ck = A.cd + t * 64 + 4 * hi;
#pragma unroll
                for (int g = 0; g < 4; ++g) { const f32x4 c0 = *(const f32x4*)(ck + 8 * g), c1 = *(const f32x4*)(ck + 32 + 8 * g);
#pragma unroll
                    for (int i = 0; i < 4; ++i) { p0[4 * g + i] = cq - c0[i]; p1[4 * g + i] = cq - c1[i]; } }
            } else { p0 = f32x16{}; p1 = f32x16{}; }
#pragma unroll
            for (int d0 = 0; d0 < ND; ++d0) {
                const bf16x8 b0 = *(const LAS bf16x8*)(Kb + d0 * 2048), b1 = *(const LAS bf16x8*)(Kb + d0 * 2048 + 512);
                p0 = __builtin_amdgcn_mfma_f32_32x32x16_bf16(b0, qr[d0], p0, 0, 0, 0); p1 = __builtin_amdgcn_mfma_f32_32x32x16_bf16(b1, qr[d0], p1, 0, 0, 0);
            }
            if constexpr (MODE == 0) { if (t == NTw - 1) {
                const int kb = t * 64 + 4 * hi;
#pragma unroll
                for (int r = 0; r < 16; ++r) { const int kv = kb + (r & 3) + 8 * (r >> 2); if (kv > qrow) p0[r] = -INFINITY; if (kv + 32 > qrow) p1[r] = -INFINITY; } } }
            float rm = fmaxf(p0[0], p1[0]);
#pragma unroll
            for (int r = 1; r < 16; ++r) rm = fmaxf(rm, fmaxf(p0[r], p1[r]));
            { auto rr = __builtin_amdgcn_permlane32_swap(__float_as_uint(rm), __float_as_uint(rm), false, false); rm = fmaxf(__uint_as_float(rr[0]), __uint_as_float(rr[1])); }
            const float mn = fmaxf(m, rm), alpha = __builtin_amdgcn_exp2f(m - mn); m = mn;
            float sum = 0.f;
#pragma unroll
            for (int r = 0; r < 16; ++r) { p0[r] = __builtin_amdgcn_exp2f(p0[r] - mn); p1[r] = __builtin_amdgcn_exp2f(p1[r] - mn); sum += p0[r] + p1[r]; }
            l = l * alpha + sum;
#pragma unroll
            for (int i = 0; i < NO; ++i)
#pragma unroll
                for (int r = 0; r < 16; ++r) o[i][r] *= alpha;
            u32x4 pw[4];
#pragma unroll
            for (int s = 0; s < 2; ++s) { pw[s] = (u32x4){cvtpk(p0[8 * s], p0[8 * s + 1]), cvtpk(p0[8 * s + 2], p0[8 * s + 3]), cvtpk(p0[8 * s + 4], p0[8 * s + 5]), cvtpk(p0[8 * s + 6], p0[8 * s + 7])};
                pw[2 + s] = (u32x4){cvtpk(p1[8 * s], p1[8 * s + 1]), cvtpk(p1[8 * s + 2], p1[8 * s + 3]), cvtpk(p1[8 * s + 4], p1[8 * s + 5]), cvtpk(p1[8 * s + 6], p1[8 * s + 7])}; }
            const LAS unsigned char* Vb = lds + cur * BUF + KSLOT + ((lane >> 4) & 1) * 32 + (lane & 3) * 8 + (4 * hi + ((lane & 15) >> 2)) * 64;
#pragma unroll
            for (int d0 = 0; d0 < NO; ++d0)
#pragma unroll
                for (int ks = 0; ks < 4; ++ks) {
                    const s16x4 vl = __builtin_bit_cast(s16x4, __builtin_amdgcn_ds_read_tr16_b64_v4i16((LAS s16x4*)(Vb + d0 * 4096 + ks * 1024)));
                    const s16x4 vh = __builtin_bit_cast(s16x4, __builtin_amdgcn_ds_read_tr16_b64_v4i16((LAS s16x4*)(Vb + d0 * 4096 + ks * 1024 + 512)));
                    const bf16x8 vf = (bf16x8){vl[0], vl[1], vl[2], vl[3], vh[0], vh[1], vh[2], vh[3]};
                    o[d0] = __builtin_amdgcn_mfma_f32_32x32x16_bf16(vf, __builtin_bit_cast(bf16x8, pw[ks]), o[d0], 0, 0, 0);
                }
        }
        __syncthreads();
    }
    { auto rr = __builtin_amdgcn_permlane32_swap(__float_as_uint(l), __float_as_uint(l), false, false); l = __uint_as_float(rr[0]) + __uint_as_float(rr[1]); }
    const float inv = 1.0f / l; float ss = 0.f;
    bf16* orow = A.O + (size_t)qrow * A.ldo + 4 * hi;
#pragma unroll
    for (int d0 = 0; d0 < NO; ++d0)
#pragma unroll
        for (int g = 0; g < 4; ++g) { const float a = o[d0][4 * g] * inv, c = o[d0][4 * g + 1] * inv, d = o[d0][4 * g + 2] * inv, e = o[d0][4 * g + 3] * inv;
            ss += (a * a + c * c) + (d * d + e * e);
            u32x2 w; w.x = pk2(a, c); w.y = pk2(d, e); *(u32x2*)(orow + d0 * 32 + 8 * g) = w; }
    if (A.part) { auto rr = __builtin_amdgcn_permlane32_swap(__float_as_uint(ss), __float_as_uint(ss), false, false); ss = __uint_as_float(rr[0]) + __uint_as_float(rr[1]); if (hi == 0) A.part[(size_t)qrow * A.pstride] = ss; }
}
__device__ __forceinline__ void attn_phase_self(LAS unsigned char* lds, const Bufs& b, int vcu) {
    const int bh = vcu >> 2, s = vcu & 3, bb = bh >> 3, h = bh & 7; const size_t r0 = (size_t)bb * S;
    if (vcu >= 256) return;
    AttnPtrs F{b.Qf + r0 * 512 + h * 64, 512, b.Kf + r0 * 512 + h * 64, 512, b.Vf + r0 * 512 + h * 64, 512, b.Omix + r0 * 1024 + h * 64, 1024, b.pfox + r0 * 8 + h, 8, b.cdec + (size_t)bh * S, nullptr, nullptr};
    AttnPtrs M{b.Qm + r0 * 768 + h * 96, 768, b.Km + r0 * 768 + h * 96, 768, b.Vm + r0 * 512 + h * 64, 512, b.Omix + r0 * 1024 + 512 + h * 64, 1024, b.pmla + r0 * 8 + h, 8, nullptr, b.cosT, b.sinT};
    attn_unit<96, 64, 1>(lds, M, 7 - s); attn_unit<64, 64, 0>(lds, F, 7 - s); attn_unit<96, 64, 1>(lds, M, s); attn_unit<64, 64, 0>(lds, F, s);
}
__device__ __forceinline__ void attn_phase_mem(LAS unsigned char* lds, const Bufs& b, int vcu) {
    if (vcu >= 256) return;
    const int bb = vcu >> 5, h = (vcu >> 3) & 3, qb = vcu & 7; const size_t r0 = (size_t)bb * S, m0 = (size_t)bb * MEMT;
    AttnPtrs X{b.Qmem + r0 * 512 + h * 128, 512, b.KVm + m0 * 1024 + h * 128, 1024, b.KVm + m0 * 1024 + 512 + h * 128, 1024, b.Omem + r0 * 512 + h * 128, 512, nullptr, 0, nullptr, nullptr, nullptr};
    attn_unit<128, 128, 2>(lds, X, qb);
}

template <class Base> struct PSched {
    static constexpr bool GATHER = false; Bufs b; int G, c, K, khook;
    __device__ __forceinline__ bool next(int i, Unit& u) const { const int L = i * G + c; if (L >= Base::NUNITS) return false; Base::get(L, u); return true; }
    __device__ __forceinline__ GemmOp op(const Unit& u) const { return Base::op(b, u); }
};
__device__ __forceinline__ void moe_build(LAS MoeTabL* tab, const int* cnt) {
    if (threadIdx.x < 64) {
        const int lane = threadIdx.x; const int c = (lane < 32) ? (int)__hip_atomic_load((const unsigned*)cnt + lane, __ATOMIC_RELAXED, __HIP_MEMORY_SCOPE_AGENT) : 0;
        const int nt = (c + 255) >> 8; int st = nt, so = c;
#pragma unroll
        for (int o = 1; o < 32; o <<= 1) { const int a = __shfl_up(st, o), d = __shfl_up(so, o); if (lane >= o) { st += a; so += d; } }
        if (lane < 32) { tab->ntile[lane] = nt; tab->cumT[lane + 1] = st; tab->off[lane + 1] = so; }
        if (lane == 0) { tab->cumT[0] = 0; tab->off[0] = 0; }
    }
    __syncthreads();
}
template <int WHICH> struct MoeSched {
    Bufs b; LAS MoeTabL* tab; int G, vcu;
    static constexpr int NPN = WHICH == 1 ? 8 : 4, K = 1024, khook = 0; static constexpr bool GATHER = WHICH == 1;
    __device__ __forceinline__ bool next(int i, Unit& u) const {
        const int L = i * G + vcu; const int total = __builtin_amdgcn_readfirstlane(tab->cumT[32]) * NPN; if (L >= total) return false;
        int e = 0;
        for (int j = 1; j < 32; ++j) { if (__builtin_amdgcn_readfirstlane(tab->cumT[j]) * NPN <= L) e = j; }
        const int base = __builtin_amdgcn_readfirstlane(tab->cumT[e]) * NPN, nt = __builtin_amdgcn_readfirstlane(tab->ntile[e]), l = L - base;
        const int cn = __builtin_amdgcn_readfirstlane(tab->off[e + 1]) - __builtin_amdgcn_readfirstlane(tab->off[e]);
        u.kind = 0; u.e = e; u.pn = l / nt; u.pm = l % nt; u.m0 = u.pm * 256; u.rows = min(256, cn - u.m0); return true;
    }
    __device__ __forceinline__ int off_e(const Unit& u) const { return __builtin_amdgcn_readfirstlane(tab->off[u.e]); }
    __device__ __forceinline__ GemmOp op(const Unit& u) const {
        GemmOp g; g.K = 1024; g.khook = 0;
        if (WHICH == 1) { g.A = b.h2; g.rowlist = b.list + u.e * LCAP + u.m0; g.B = b.WguT + ((size_t)u.e * 2048 + (size_t)u.pn * 256) * 1024; }
        else { g.A = b.act + (size_t)(off_e(u) + u.m0) * 1024; g.rowlist = nullptr; g.B = b.WdT + ((size_t)u.e * 1024 + (size_t)u.pn * 256) * 1024; }
        return g;
    }
};

constexpr int RING_BYTES = 131072, MISC_OFF = RING_BYTES, LDS_BYTES = 147456;
constexpr int NPHASE = 12;
__global__ void __launch_bounds__(512, 2) mega(Params p) {
    extern __shared__ __attribute__((aligned(16))) unsigned char lds_raw[];
    LAS unsigned char* lds = (LAS unsigned char*)lds_raw;
    const Bufs b = make_bufs(p.ws);
    const int tid = threadIdx.x, lane = tid & 63, wave = __builtin_amdgcn_readfirstlane(tid >> 6);
    const int G = gridDim.x, bx = blockIdx.x, vcu = (G % 8 == 0) ? (bx % 8) * (G / 8) + bx / 8 : bx;
    LAS MoeTabL* tab = (LAS MoeTabL*)(lds + MISC_OFF);
    const int lo = p.ph_lo, hi = p.ph_hi;
#define SEAM(k) do { if (IN(k) && IN((k) + 1)) cooperative_groups::this_grid().sync(); } while (0)
#ifdef ONLY
#define IN(k) ((k) == ONLY && lo <= (k) && (k) < hi)
#else
#define IN(k) (lo <= (k) && (k) < hi)
#endif
    if (IN(0)) { prep_phase(p, b, lds_raw, bx, G); }
    SEAM(0);
    if (IN(1)) { PSched<SchedIn> S{b, G, bx, 1024, 0}; EpiIn E{p, b}; pg8::gemm_phase(lds, S, E); }
    SEAM(1);
    if (IN(2)) { EpiUp E{p, b}; { PSched<SchedUpQ> S{b, G, bx, 384, 0}; pg8::gemm_phase(lds, S, E); } { PSched<SchedUpKV> S{b, G, bx, 256, 0}; pg8::gemm_phase(lds, S, E); }
                 kpe_task(b, bx * 512 + tid, G * 512); scan_task(b, bx * 8 + wave, G * 8, lane); }
    SEAM(2);
    if (IN(3)) { attn_phase_self(lds, b, vcu); }
    SEAM(3);
    if (IN(4)) { PSched<SchedOut> S{b, G, bx, 1024, 512}; EpiOut E{p, b}; pg8::gemm_phase(lds, S, E); }
    SEAM(4);
    if (IN(5)) { PSched<SchedMq> S{b, G, bx, 1024, 0}; EpiMq E{p, b}; pg8::gemm_phase(lds, S, E); }
    SEAM(5);
    if (IN(6)) { attn_phase_mem(lds, b, vcu); }
    SEAM(6);
    if (IN(7)) { PSched<SchedMo> S{b, G, bx, 512, 0}; EpiMo E{p, b}; pg8::gemm_phase(lds, S, E); }
    SEAM(7);
    if (IN(8)) { float* lgs = (float*)lds_raw + wave * 32; float* rowb = (float*)lds_raw + 256 + wave * 1024;
                 for (int tok = bx * 8 + wave; tok < T; tok += G * 8) router_token(p, b, tok, lane, lgs, rowb); }
    SEAM(8);
    if (IN(9)) { moe_build(tab, b.cnt); MoeSched<1> S{b, tab, G, vcu}; EpiG1 E{p, b, tab, 0}; pg8::gemm_phase(lds, S, E); }
    SEAM(9);
    if (IN(10)) { moe_build(tab, b.cnt); MoeSched<2> S{b, tab, G, vcu}; EpiG2 E{p, b, tab, 0}; pg8::gemm_phase(lds, S, E); }
    SEAM(10);
    if (IN(11)) { moe_build(tab, b.cnt); for (int tok = bx * 8 + wave; tok < T; tok += G * 8) final_token(p, b, tok, lane, (const int*)tab->off); }
#undef IN
#undef SEAM
}

extern "C" void kernel_launch(void* const* d_in, const int* in_sizes, int n_in, void* d_out, int out_size, void* d_ws, size_t ws_size, hipStream_t stream) {
    static int inited = 0; static int grid = 256;
    if (!inited) {
        if (n_in != 25 || ws_size < WS_END) { fprintf(stderr, "kernel_launch: unexpected n_in %d / ws_size %zu\n", n_in, ws_size); inited = -1; return; }
        (void)hipFuncSetAttribute((const void*)k_prep, hipFuncAttributeMaxDynamicSharedMemorySize, TP_LDS);
        (void)hipFuncSetAttribute((const void*)mega, hipFuncAttributeMaxDynamicSharedMemorySize, LDS_BYTES);
        int dev = 0, cus = 0; (void)hipGetDevice(&dev); (void)hipDeviceGetAttribute(&cus, hipDeviceAttributeMultiprocessorCount, dev); int per_cu = 0; (void)hipOccupancyMaxActiveBlocksPerMultiprocessor(&per_cu, (const void*)mega, 512, LDS_BYTES); grid = (cus > 0 ? cus : 256) * (per_cu > 0 ? 1 : 1);
        if (per_cu < 1) fprintf(stderr, "kernel_launch: occupancy query reports %d blocks per CU\n", per_cu);
        inited = 1;
    }
    if (inited < 0) return;
    Params p{};
    const float** pp = (const float**)&p;
    for (int i = 0; i < 25; ++i) pp[i] = (const float*)d_in[i];
    p.out = (float*)d_out; p.ws = (unsigned char*)d_ws; p.ph_lo = 0; p.ph_hi = 0;
    (void)hipMemsetAsync((char*)d_ws + WS_CTL, 0, 65536, stream);
    p.ph_lo = 0; p.ph_hi = NPHASE;
    void* args[] = {&p};
    hipError_t e = hipLaunchCooperativeKernel((const void*)mega, dim3(grid), dim3(512), args, LDS_BYTES, stream);
    if (e != hipSuccess) fprintf(stderr, "cooperative launch failed: %s (grid %d)\n", hipGetErrorString(e), grid);
}
```

```cpp
#include <hip/hip_runtime.h>
#include <hip/hip_cooperative_groups.h>
#include <cstdio>
#include <cstdint>

constexpr int NB = 8, S = 2048, D = 1024, T = NB * S;
constexpr int IN_PAD = 2304;
constexpr int MEMT = 256, MROWS = NB * MEMT;
constexpr int NE = 32, TOPK = 4, NPAIR = T * TOPK;
constexpr int LCAP = T;
constexpr float EPS = 1e-6f;
constexpr float LOG2E = 1.4426950408889634f;
constexpr float QS_FOX = 0.125f * LOG2E;
constexpr float QS_MLA = 0.10206207261596577f * LOG2E;
constexpr float QS_MEM = 0.08838834764831845f * LOG2E;

typedef unsigned short bf16;
typedef float f32x4 __attribute__((ext_vector_type(4)));
typedef unsigned u32x4 __attribute__((ext_vector_type(4)));
typedef unsigned u32x2 __attribute__((ext_vector_type(2)));

constexpr size_t MiB = 1u << 20;
constexpr size_t WS_CTL = 0;
constexpr size_t WS_CNT = 64 * 1024;
constexpr size_t WS_RS1 = 1 * MiB + 5 * 65536, WS_RS3 = 1 * MiB + 6 * 65536, WS_RSMEM = 1 * MiB + 7 * 65536;
constexpr size_t WS_PQ = 11 * MiB, WS_PKV = 12 * MiB, WS_PFOX = 12 * MiB + 524288, WS_PMLA = 13 * MiB, WS_P2 = 14 * MiB;
constexpr size_t WS_COS = 2 * MiB, WS_SIN = 2 * MiB + 131072, WS_WR = 2 * MiB + 262144, WS_LOGF = 3 * MiB, WS_CDEC = 3 * MiB + 524288, WS_KROPE = 4 * MiB;
constexpr size_t WS_TOKE = 6 * MiB, WS_TOKP = 6 * MiB + 262144, WS_LIST = 7 * MiB, WS_GATEV = 9 * MiB;
constexpr size_t WS_WIN = 16 * MiB, WS_WUQ = 21 * MiB, WS_WUKV = 22 * MiB, WS_WO = 23 * MiB, WS_WMQ = 25 * MiB, WS_WMKV = 26 * MiB, WS_WMO = 28 * MiB;
constexpr size_t WS_RSL = 30 * MiB;
constexpr size_t WS_WGU = 32 * MiB, WS_WD = 160 * MiB;
constexpr size_t WS_XB = 224 * MiB, WS_MEMB = 256 * MiB, WS_KVM = 260 * MiB, WS_QF = 264 * MiB, WS_KF = 280 * MiB, WS_VF = 296 * MiB;
constexpr size_t WS_QLAT = 312 * MiB, WS_KVLAT = 324 * MiB, WS_QM = 332 * MiB, WS_KM = 356 * MiB, WS_VM = 380 * MiB, WS_OMIX = 396 * MiB;
constexpr size_t WS_H1 = 428 * MiB, WS_QMEM = 460 * MiB, WS_OMEM = 476 * MiB, WS_H2 = 492 * MiB, WS_ACT = 524 * MiB, WS_YP = 653 * MiB, WS_END = 782 * MiB;

struct Params {
    const float *x, *mem, *g_mix, *w_in, *b_f, *g_q_lat, *w_uq, *g_kv_lat, *w_ukv, *g_fox_out, *g_mla_out, *w_o, *g_mem_q, *w_mem_q, *g_mem_kv, *w_mem_kv, *w_mem_o,
        *g_ffn, *w_router, *b_router, *w_gate_up, *b_gate_up, *w_down, *b_down, *g_final;
    float* out; unsigned char* ws;
    int ph_lo, ph_hi;
};
struct Bufs {
    int* cnt; float *pq, *pkv, *pfox, *pmla, *p2, *rs1, *rs3, *rsmem, *cosT, *sinT, *wr, *logf, *cdec, *krope, *gatev, *rsl;
    int *toke, *tokp, *list;
    bf16 *WinT, *WuqT, *WukvT, *WoT, *WmqT, *WmkvT, *WmoT, *WguT, *WdT;
    bf16 *xb, *memb, *KVm, *Qf, *Kf, *Vf, *qlat, *kvlat, *Qm, *Km, *Vm, *Omix, *h1, *Qmem, *Omem, *h2, *act, *yp;
};
__host__ __device__ __forceinline__ Bufs make_bufs(unsigned char* ws) {
    Bufs b;
    b.cnt = (int*)(ws + WS_CNT);
    b.pq = (float*)(ws + WS_PQ); b.pkv = (float*)(ws + WS_PKV); b.pfox = (float*)(ws + WS_PFOX); b.pmla = (float*)(ws + WS_PMLA);
    b.p2 = (float*)(ws + WS_P2); b.rs1 = (float*)(ws + WS_RS1); b.rs3 = (float*)(ws + WS_RS3); b.rsmem = (float*)(ws + WS_RSMEM);
    b.cosT = (float*)(ws + WS_COS); b.sinT = (float*)(ws + WS_SIN); b.wr = (float*)(ws + WS_WR); b.logf = (float*)(ws + WS_LOGF); b.cdec = (float*)(ws + WS_CDEC);
    b.krope = (float*)(ws + WS_KROPE); b.gatev = (float*)(ws + WS_GATEV); b.rsl = (float*)(ws + WS_RSL);
    b.toke = (int*)(ws + WS_TOKE); b.tokp = (int*)(ws + WS_TOKP); b.list = (int*)(ws + WS_LIST);
    b.WinT = (bf16*)(ws + WS_WIN); b.WuqT = (bf16*)(ws + WS_WUQ); b.WukvT = (bf16*)(ws + WS_WUKV); b.WoT = (bf16*)(ws + WS_WO); b.WmqT = (bf16*)(ws + WS_WMQ);
    b.WmkvT = (bf16*)(ws + WS_WMKV); b.WmoT = (bf16*)(ws + WS_WMO); b.WguT = (bf16*)(ws + WS_WGU); b.WdT = (bf16*)(ws + WS_WD);
    b.xb = (bf16*)(ws + WS_XB); b.memb = (bf16*)(ws + WS_MEMB); b.KVm = (bf16*)(ws + WS_KVM); b.Qf = (bf16*)(ws + WS_QF); b.Kf = (bf16*)(ws + WS_KF); b.Vf = (bf16*)(ws + WS_VF);
    b.qlat = (bf16*)(ws + WS_QLAT); b.kvlat = (bf16*)(ws + WS_KVLAT); b.Qm = (bf16*)(ws + WS_QM); b.Km = (bf16*)(ws + WS_KM); b.Vm = (bf16*)(ws + WS_VM);
    b.Omix = (bf16*)(ws + WS_OMIX); b.h1 = (bf16*)(ws + WS_H1); b.Qmem = (bf16*)(ws + WS_QMEM); b.Omem = (bf16*)(ws + WS_OMEM); b.h2 = (bf16*)(ws + WS_H2);
    b.act = (bf16*)(ws + WS_ACT); b.yp = (bf16*)(ws + WS_YP);
    return b;
}

__device__ __forceinline__ unsigned f2bf(float f) { unsigned u = __builtin_bit_cast(unsigned, f); return (u + 0x7fffu + ((u >> 16) & 1u)) >> 16; }
__device__ __forceinline__ unsigned pk2(float lo, float hi) { return f2bf(lo) | (f2bf(hi) << 16); }
__device__ __forceinline__ float bf2f(unsigned short h) { return __builtin_bit_cast(float, (unsigned)h << 16); }
__device__ __forceinline__ float bflo(unsigned w) { return __builtin_bit_cast(float, w << 16); }
__device__ __forceinline__ float bfhi(unsigned w) { return __builtin_bit_cast(float, w & 0xffff0000u); }
__device__ __forceinline__ float wave_sum(float v) {
#pragma unroll
    for (int o = 1; o < 64; o <<= 1) v += __shfl_xor(v, o);
    return v;
}
__device__ __forceinline__ float wave_max(float v) {
#pragma unroll
    for (int o = 1; o < 64; o <<= 1) v = fmaxf(v, __shfl_xor(v, o));
    return v;
}
__device__ __forceinline__ void unpack8(const u32x4 w, float (&f)[8]) {
    f[0] = bflo(w.x); f[1] = bfhi(w.x); f[2] = bflo(w.y); f[3] = bfhi(w.y); f[4] = bflo(w.z); f[5] = bfhi(w.z); f[6] = bflo(w.w); f[7] = bfhi(w.w);
}
__device__ __forceinline__ u32x4 pack8(const float (&f)[8]) { u32x4 w; w.x = pk2(f[0], f[1]); w.y = pk2(f[2], f[3]); w.z = pk2(f[4], f[5]); w.w = pk2(f[6], f[7]); return w; }

constexpr int TP_LDS = 64 * 257 * 4;
struct TItem { const float* W; int ldw, Nsrc, K; const float* gain; const float* gain2; bf16* WT; int mapkind; int k0, n0; };
__device__ __forceinline__ int map_row(int kind, int n) {
    if (kind == 0) return n;
    if (kind == 1) {
        if (n < 1536) return n;
        if (n < 1544) return 2208 + (n - 1536);
        if (n < 1928) return 1536 + (n - 1544);
        if (n < 2184) return 1920 + (n - 1928);
        return 2176 + (n - 2184);
    }
    return ((n & 1023) >> 7) * 256 + (n >> 10) * 128 + (n & 127);
}
struct TRegs { f32x4 v[8]; };
__device__ __forceinline__ void titem_load(const TItem& it, TRegs& R) {
    const int tid = threadIdx.x;
#pragma unroll
    for (int j = 0; j < 8; ++j) {
        const int kr = (tid >> 6) + 8 * j, n = it.n0 + (tid & 63) * 4, k = it.k0 + kr;
        R.v[j] = (f32x4){0.f, 0.f, 0.f, 0.f};
        if (n < it.Nsrc) R.v[j] = __builtin_nontemporal_load((const f32x4*)(it.W + (size_t)k * it.ldw + n));
    }
}
__device__ __forceinline__ void titem_to_lds(const TItem& it, const TRegs& R, float* Sm) {
    const int tid = threadIdx.x;
#pragma unroll
    for (int j = 0; j < 8; ++j) {
        const int kr = (tid >> 6) + 8 * j, n4 = (tid & 63) * 4, k = it.k0 + kr;
        float g = 1.f;
        if (it.gain) g = (it.gain2 && k >= 512) ? it.gain2[k - 512] : it.gain[k];
        float* s = Sm + kr * 257 + n4;
        s[0] = R.v[j].x * g; s[1] = R.v[j].y * g; s[2] = R.v[j].z * g; s[3] = R.v[j].w * g;
    }
}
__device__ __forceinline__ void titem_store(const TItem& it, const float* Sm) {
    const int tid = threadIdx.x;
#pragma unroll
    for (int j = 0; j < 4; ++j) {
        const int r = (tid >> 3) + 64 * j, c = tid & 7, n = it.n0 + r;
        if (n < it.Nsrc) {
            const int row = map_row(it.mapkind, n);
            const float* s = Sm + (8 * c) * 257 + r;
            u32x4 o; o.x = pk2(s[0], s[257]); o.y = pk2(s[2 * 257], s[3 * 257]); o.z = pk2(s[4 * 257], s[5 * 257]); o.w = pk2(s[6 * 257], s[7 * 257]);
            *(u32x4*)(it.WT + (size_t)row * it.K + it.k0 + 8 * c) = o;
        }
    }
}
constexpr int TI_WIN = 16 * 9, TI_WUQ = 6 * 3, TI_WUKV = 4 * 4, TI_WO = 16 * 4, TI_WMQ = 16 * 2, TI_WMKV = 16 * 4, TI_WMO = 8 * 4, TI_WGU = 32 * 16 * 8, TI_WD = 32 * 16 * 4;
constexpr int TI_TOTAL = TI_WIN + TI_WUQ + TI_WUKV + TI_WO + TI_WMQ + TI_WMKV + TI_WMO + TI_WGU + TI_WD;
__device__ __forceinline__ TItem get_titem(const Params& p, const Bufs& b, int i) {
    TItem t; t.gain2 = nullptr; t.mapkind = 0;
    auto fill = [&](const float* W, int ldw, int Nsrc, int K, const float* g, bf16* WT, int li) { const int nn = (Nsrc + 255) / 256; t.W = W; t.ldw = ldw; t.Nsrc = Nsrc; t.K = K; t.gain = g; t.WT = WT; t.k0 = (li / nn) * 64; t.n0 = (li % nn) * 256; };
    if (i < TI_WIN) { fill(p.w_in, 2216, 2216, 1024, p.g_mix, b.WinT, i); t.mapkind = 1; return t; } i -= TI_WIN;
    if (i < TI_WUQ) { fill(p.w_uq, 768, 768, 384, p.g_q_lat, b.WuqT, i); return t; } i -= TI_WUQ;
    if (i < TI_WUKV) { fill(p.w_ukv, 1024, 1024, 256, p.g_kv_lat, b.WukvT, i); return t; } i -= TI_WUKV;
    if (i < TI_WO) { fill(p.w_o, 1024, 1024, 1024, p.g_fox_out, b.WoT, i); t.gain2 = p.g_mla_out; return t; } i -= TI_WO;
    if (i < TI_WMQ) { fill(p.w_mem_q, 512, 512, 1024, p.g_mem_q, b.WmqT, i); return t; } i -= TI_WMQ;
    if (i < TI_WMKV) { fill(p.w_mem_kv, 1024, 1024, 1024, p.g_mem_kv, b.WmkvT, i); return t; } i -= TI_WMKV;
    if (i < TI_WMO) { fill(p.w_mem_o, 1024, 1024, 512, nullptr, b.WmoT, i); return t; } i -= TI_WMO;
    if (i < TI_WGU) { const int e = i / 128; fill(p.w_gate_up + (size_t)e * 1024 * 2048, 2048, 2048, 1024, p.g_ffn, b.WguT + (size_t)e * 2048 * 1024, i % 128); t.mapkind = 2; return t; } i -= TI_WGU;
    { const int e = i / 64; fill(p.w_down + (size_t)e * 1024 * 1024, 1024, 1024, 1024, nullptr, b.WdT + (size_t)e * 1024 * 1024, i % 64); return t; }
}
__device__ __forceinline__ void row_to_bf16(const float* xrow, bf16* orow, float* rs_out, int lane) {
    const f32x4* xr = (const f32x4*)xrow + lane;
    f32x4 v[4]; float s = 0.f;
#pragma unroll
    for (int j = 0; j < 4; ++j) { v[j] = xr[64 * j]; s += (v[j].x * v[j].x + v[j].y * v[j].y) + (v[j].z * v[j].z + v[j].w * v[j].w); }
    s = wave_sum(s);
    if (lane == 0) *rs_out = 1.0f / sqrtf(s * (1.0f / 1024.0f) + EPS);
    u32x2* o8 = (u32x2*)orow + lane;
#pragma unroll
    for (int j = 0; j < 4; ++j) { u32x2 w; w.x = pk2(v[j].x, v[j].y); w.y = pk2(v[j].z, v[j].w); o8[64 * j] = w; }
}
__device__ __forceinline__ void prep_phase(const Params& p, const Bufs& b, unsigned char* lds, int vblock, int nblocks) {
    const int tid = threadIdx.x, lane = tid & 63, wave = tid >> 6;
    float* Sm = (float*)lds;
    {
        int i = vblock; TRegs R;
        if (i < TI_TOTAL) { const TItem t0 = get_titem(p, b, i); titem_load(t0, R); }
        for (; i < TI_TOTAL; i += nblocks) {
            const TItem t = get_titem(p, b, i);
            titem_to_lds(t, R, Sm);
            __syncthreads();
            if (i + nblocks < TI_TOTAL) { const TItem tn = get_titem(p, b, i + nblocks); titem_load(tn, R); }
            titem_store(t, Sm);
            __syncthreads();
        }
    }
    const int gw = vblock * 8 + wave, ngw = nblocks * 8;
    for (int r = gw; r < T; r += ngw) row_to_bf16(p.x + (size_t)r * D, b.xb + (size_t)r * D, b.rs1 + r, lane);
    for (int r = gw; r < MROWS; r += ngw) row_to_bf16(p.mem + (size_t)r * D, b.memb + (size_t)r * D, b.rsmem + r, lane);
    const int gt = vblock * 512 + tid, ngt = nblocks * 512;
    for (int i = gt; i < S * 16; i += ngt) {
        const int s = i >> 4, j = i & 15; const double inv = pow(10000.0, -(double)j / 16.0), ang = (double)s * inv;
        b.cosT[i] = (float)cos(ang); b.sinT[i] = (float)sin(ang);
    }
    for (int i = gt; i < 1024 * 32; i += ngt) { const int e = i >> 10, k = i & 1023; const float w = p.w_router[k * 32 + e] * p.g_ffn[k]; const unsigned h = f2bf(w);
        ((bf16*)b.wr)[i] = (bf16)h; ((bf16*)b.wr)[32768 + i] = (bf16)f2bf(w - bf2f((unsigned short)h)); }
    for (int i = gt; i < (int)(5 * MiB / 16); i += ngt) ((u32x4*)(p.ws + WS_PQ))[i] = (u32x4){0u, 0u, 0u, 0u};
    for (int i = gt; i < 32; i += ngt) b.cnt[i] = 0;
    for (int i = gt; i < (IN_PAD - 2216) * 1024 / 8; i += ngt) ((u32x4*)(b.WinT + (size_t)2216 * 1024))[i] = (u32x4){0u, 0u, 0u, 0u};
}

struct Unit { int kind, pm, pn, e, m0, rows; };
struct GemmOp { const bf16* A; const int* rowlist; const bf16* B; int K; int khook; };

__device__ __forceinline__ void dense_map(int L, int nM, int nN, int& pm, int& pn) {
    const int nwg = nM * nN; int wgid = L; { const int q = nwg / 8, r = nwg % 8, xcd = wgid % 8, off = wgid / 8; wgid = (xcd < r ? xcd * (q + 1) : r * (q + 1) + (xcd - r) * q) + off; }
    const int nig = 8 * nN, gid = wgid / nig, fm = gid * 8, gsz = (nM - fm) < 8 ? (nM - fm) : 8;
    pm = fm + ((wgid % nig) % gsz); pn = (wgid % nig) / gsz;
}
struct SchedIn {
    static constexpr int NUNITS = 64 * 9 + 8 * 4;
    __device__ __forceinline__ static void get(int i, Unit& u) { if (i < 576) { u.kind = 0; dense_map(i, 64, 9, u.pm, u.pn); } else { i -= 576; u.kind = 1; u.pm = i / 4; u.pn = i % 4; } u.e = 0; u.m0 = 0; u.rows = 256; }
    __device__ __forceinline__ static GemmOp op(const Bufs& b, const Unit& u) {
        GemmOp g; g.rowlist = nullptr; g.K = 1024; g.khook = 0;
        if (u.kind == 0) { g.A = b.xb + (size_t)u.pm * 256 * 1024; g.B = b.WinT + (size_t)u.pn * 256 * 1024; }
        else { g.A = b.memb + (size_t)u.pm * 256 * 1024; g.B = b.WmkvT + (size_t)u.pn * 256 * 1024; }
        return g;
    }
};
struct EpiIn {
    static constexpr bool HOOK = false, PAIRED = false; Params p; Bufs b;
    template <bool FAST> __device__ __forceinline__ void operator()(const Unit& u, int r, int c, float (&v)[8]) const {
        const int row = u.pm * 256 + r, gc = u.pn * 256 + c;
        if (u.kind == 1) { const float s = b.rsmem[row];
#pragma unroll
            for (int i = 0; i < 8; ++i) v[i] *= s;
            *(u32x4*)(b.KVm + (size_t)row * 1024 + gc) = pack8(v); return; }
        const float s = b.rs1[row];
#pragma unroll
        for (int i = 0; i < 8; ++i) v[i] *= s;
        if (gc < 1536) {
            bf16* dst = b.Qf + (size_t)(gc >> 9) * (8u << 20);
            if (gc < 512) {
#pragma unroll
                for (int i = 0; i < 8; ++i) v[i] *= QS_FOX;
            }
            *(u32x4*)(dst + (size_t)row * 512 + (gc & 511)) = pack8(v);
        } else if (gc < 2176) {
            const bool isq = gc < 1920;
            float ss = 0.f;
#pragma unroll
            for (int i = 0; i < 8; ++i) ss += v[i] * v[i];
            if (isq) *(u32x4*)(b.qlat + (size_t)row * 384 + (gc - 1536)) = pack8(v);
            else *(u32x4*)(b.kvlat + (size_t)row * 256 + (gc - 1920)) = pack8(v);
            float* dst = isq ? b.pq + (size_t)row * 12 + ((gc - 1536) >> 5) : b.pkv + (size_t)row * 8 + ((gc - 1920) >> 5);
            if (FAST) { ss += __shfl_xor(ss, 16); ss += __shfl_xor(ss, 32); if ((threadIdx.x & 63) < 16) *dst = ss; }
            else *dst += ss;
        } else if (gc < 2208) {
            float* dst = b.krope + (size_t)row * 32 + (gc - 2176);
            *(f32x4*)dst = (f32x4){v[0], v[1], v[2], v[3]}; *(f32x4*)(dst + 4) = (f32x4){v[4], v[5], v[6], v[7]};
        } else if (gc == 2208) {
            float o[8];
#pragma unroll
            for (int i = 0; i < 8; ++i) { const float z = v[i] + p.b_f[i]; o[i] = fminf(z, 0.f) - logf(1.0f + expf(-fabsf(z))); }
            float* dst = b.logf + (size_t)row * 8;
            *(f32x4*)dst = (f32x4){o[0], o[1], o[2], o[3]}; *(f32x4*)(dst + 4) = (f32x4){o[4], o[5], o[6], o[7]};
        }
    }
};
struct SchedUp {
    static constexpr int NUNITS = 64 * 3 + 64 * 4;
    __device__ __forceinline__ static void get(int i, Unit& u) { if (i < 192) { u.kind = 0; dense_map(i, 64, 3, u.pm, u.pn); } else { i -= 192; u.kind = 1; dense_map(i, 64, 4, u.pm, u.pn); } u.e = 0; u.m0 = 0; u.rows = 256; }
    __device__ __forceinline__ static GemmOp op(const Bufs& b, const Unit& u) {
        GemmOp g; g.rowlist = nullptr; g.khook = 0;
        if (u.kind == 0) { g.K = 384; g.A = b.qlat + (size_t)u.pm * 256 * 384; g.B = b.WuqT + (size_t)u.pn * 256 * 384; }
        else { g.K = 256; g.A = b.kvlat + (size_t)u.pm * 256 * 256; g.B = b.WukvT + (size_t)u.pn * 256 * 256; }
        return g;
    }
};
struct SchedUpQ { static constexpr int NUNITS = 192; __device__ __forceinline__ static void get(int i, Unit& u) { SchedUp::get(i, u); } __device__ __forceinline__ static GemmOp op(const Bufs& b, const Unit& u) { return SchedUp::op(b, u); } };
struct SchedUpKV { static constexpr int NUNITS = 256; __device__ __forceinline__ static void get(int i, Unit& u) { SchedUp::get(192 + i, u); } __device__ __forceinline__ static GemmOp op(const Bufs& b, const Unit& u) { return SchedUp::op(b, u); } };
struct EpiUp {
    static constexpr bool HOOK = false, PAIRED = false; Params p; Bufs b;
    template <bool FAST> __device__ __forceinline__ void operator()(const Unit& u, int r, int c, float (&v)[8]) const {
        const int row = u.pm * 256 + r, gc = u.pn * 256 + c;
        if (u.kind == 0) {
            float q = 0.f;
#pragma unroll
            for (int i = 0; i < 12; ++i) q += b.pq[(size_t)row * 12 + i];
            const float s = (1.0f / sqrtf(q * (1.0f / 384.0f) + EPS)) * QS_MLA;
#pragma unroll
            for (int i = 0; i < 8; ++i) v[i] *= s;
            *(u32x4*)(b.Qm + (size_t)row * 768 + gc) = pack8(v);
        } else {
            float q = 0.f;
#pragma unroll
            for (int i = 0; i < 8; ++i) q += b.pkv[(size_t)row * 8 + i];
            const float s = 1.0f / sqrtf(q * (1.0f / 256.0f) + EPS);
#pragma unroll
            for (int i = 0; i < 8; ++i) v[i] *= s;
            const int h = gc >> 7, w = gc & 127;
            if (w < 64) *(u32x4*)(b.Km + (size_t)row * 768 + h * 96 + w) = pack8(v);
            else *(u32x4*)(b.Vm + (size_t)row * 512 + h * 64 + (w - 64)) = pack8(v);
        }
    }
};
struct SchedOut {
    static constexpr int NUNITS = 64 * 4;
    __device__ __forceinline__ static void get(int i, Unit& u) { u.kind = 0; dense_map(i, 64, 4, u.pm, u.pn); u.e = 0; u.m0 = 0; u.rows = 256; }
    __device__ __forceinline__ static GemmOp op(const Bufs& b, const Unit& u) { GemmOp g; g.rowlist = nullptr; g.K = 1024; g.khook = 512; g.A = b.Omix + (size_t)u.pm * 256 * 1024; g.B = b.WoT + (size_t)u.pn * 256 * 1024; return g; }
};
__device__ __forceinline__ float rs_of(float ssq, float n) { return 1.0f / sqrtf(ssq / n + EPS); }
__device__ __forceinline__ float sum8(const float* q) { const f32x4 a = *(const f32x4*)q, c = *(const f32x4*)(q + 4); return ((a.x + a.y) + (a.z + a.w)) + ((c.x + c.y) + (c.z + c.w)); }
struct EpiOut {
    static constexpr bool HOOK = true, PAIRED = false; Params p; Bufs b;
    __device__ __forceinline__ float hook_ratio(const Unit& u, int r) const { const int row = u.pm * 256 + r; return rs_of(sum8(b.pfox + (size_t)row * 8), 512.f) / rs_of(sum8(b.pmla + (size_t)row * 8), 512.f); }
    template <bool FAST> __device__ __forceinline__ void operator()(const Unit& u, int r, int c, float (&v)[8]) const {
        const int row = u.pm * 256 + r, gc = u.pn * 256 + c;
        const float s = rs_of(sum8(b.pmla + (size_t)row * 8), 512.f);
        const float* xr = p.x + (size_t)row * D + gc; const f32x4 x0 = *(const f32x4*)xr, x1 = *(const f32x4*)(xr + 4);
        v[0] = x0.x + v[0] * s; v[1] = x0.y + v[1] * s; v[2] = x0.z + v[2] * s; v[3] = x0.w + v[3] * s;
        v[4] = x1.x + v[4] * s; v[5] = x1.y + v[5] * s; v[6] = x1.z + v[6] * s; v[7] = x1.w + v[7] * s;
        float ss = 0.f;
#pragma unroll
        for (int i = 0; i < 8; ++i) ss += v[i] * v[i];
        *(u32x4*)(b.h1 + (size_t)row * D + gc) = pack8(v);
        float* dst = b.p2 + (size_t)row * 32 + (gc >> 5);
        if (FAST) { ss += __shfl_xor(ss, 16); ss += __shfl_xor(ss, 32); if ((threadIdx.x & 63) < 16) *dst = ss; }
        else *dst += ss;
    }
};
struct SchedMq {
    static constexpr int NUNITS = 64 * 2;
    __device__ __forceinline__ static void get(int i, Unit& u) { u.kind = 0; dense_map(i, 64, 2, u.pm, u.pn); u.e = 0; u.m0 = 0; u.rows = 256; }
    __device__ __forceinline__ static GemmOp op(const Bufs& b, const Unit& u) { GemmOp g; g.rowlist = nullptr; g.K = 1024; g.khook = 0; g.A = b.h1 + (size_t)u.pm * 256 * 1024; g.B = b.WmqT + (size_t)u.pn * 256 * 1024; return g; }
};
struct EpiMq {
    static constexpr bool HOOK = false, PAIRED = false; Params p; Bufs b;
    template <bool FAST> __device__ __forceinline__ void operator()(const Unit& u, int r, int c, float (&v)[8]) const {
        const int row = u.pm * 256 + r, gc = u.pn * 256 + c; float q = 0.f;
#pragma unroll
        for (int i = 0; i < 4; ++i) q += sum8(b.p2 + (size_t)row * 32 + 8 * i);
        const float s = rs_of(q, 1024.f) * QS_MEM;
#pragma unroll
        for (int i = 0; i < 8; ++i) v[i] *= s;
        *(u32x4*)(b.Qmem + (size_t)row * 512 + gc) = pack8(v);
    }
};
struct SchedMo {
    static constexpr int NUNITS = 64 * 4;
    __device__ __forceinline__ static void get(int i, Unit& u) { u.kind = 0; dense_map(i, 64, 4, u.pm, u.pn); u.e = 0; u.m0 = 0; u.rows = 256; }
    __device__ __forceinline__ static GemmOp op(const Bufs& b, const Unit& u) { GemmOp g; g.rowlist = nullptr; g.K = 512; g.khook = 0; g.A = b.Omem + (size_t)u.pm * 256 * 512; g.B = b.WmoT + (size_t)u.pn * 256 * 512; return g; }
};
struct EpiMo {
    static constexpr bool HOOK = false, PAIRED = false; Params p; Bufs b;
    template <bool FAST> __device__ __forceinline__ void operator()(const Unit& u, int r, int c, float (&v)[8]) const {
        const int row = u.pm * 256 + r, gc = u.pn * 256 + c; float h[8]; unpack8(*(const u32x4*)(b.h1 + (size_t)row * D + gc), h);
#pragma unroll
        for (int i = 0; i < 8; ++i) v[i] += h[i];
        *(u32x4*)(b.h2 + (size_t)row * D + gc) = pack8(v);
    }
};
#define LAS __attribute__((address_space(3)))
struct MoeTabL { int ntile[32]; int cumT[33]; int off[33]; };
__device__ __forceinline__ void moe_unit(const int* cnt, int npn, int i, Unit& u, int& valid) {
    int base = 0; valid = 0;
    for (int e = 0; e < NE; ++e) { const int c = cnt[e], nt = (c + 255) >> 8, nu = nt * npn; if (i < base + nu) { const int l = i - base; u.kind = 0; u.e = e; u.pn = l / nt; u.pm = l % nt; u.m0 = u.pm * 256; u.rows = min(256, c - u.m0); valid = 1; return; } base += nu; }
}
__device__ __forceinline__ int moe_off(const int* cnt, int e) { int o = 0; for (int i = 0; i < e; ++i) o += cnt[i]; return o; }
struct EpiG1 {
    static constexpr bool HOOK = false, PAIRED = true; Params p; Bufs b; LAS MoeTabL* tab; int off_fixed;
    __device__ __forceinline__ void pair(const Unit& u, int r, int c, float (&vg)[8], float (&vu)[8]) const {
        if (r >= u.rows) return;
        const int off_e = tab ? tab->off[u.e] : off_fixed;
        const float rs = b.rsl[u.e * LCAP + u.m0 + r];
        const int col = u.pn * 128 + c; const float* bg = p.b_gate_up + (size_t)u.e * 2048 + col;
        float o[8];
#pragma unroll
        for (int i = 0; i < 8; ++i) { float g = vg[i] * rs + bg[i], uu = vu[i] * rs + bg[1024 + i]; g = fminf(g, 7.0f); uu = fminf(fmaxf(uu, -7.0f), 7.0f);
            o[i] = g * (1.0f / (1.0f + __expf(-1.702f * g))) * (uu + 1.0f); }
        *(u32x4*)(b.act + (size_t)(off_e + u.m0 + r) * 1024 + col) = pack8(o);
    }
};
struct EpiG2 {
    static constexpr bool HOOK = false, PAIRED = false; Params p; Bufs b; LAS MoeTabL* tab; int off_fixed;
    template <bool FAST> __device__ __forceinline__ void operator()(const Unit& u, int r, int c, float (&v)[8]) const {
        if (r >= u.rows) return;
        const int off_e = tab ? tab->off[u.e] : off_fixed;
        const int col = u.pn * 256 + c; const float gw = b.gatev[u.e * LCAP + u.m0 + r]; const float* bd = p.b_down + (size_t)u.e * 1024 + col;
#pragma unroll
        for (int i = 0; i < 8; ++i) v[i] = (v[i] + bd[i]) * gw;
        *(u32x4*)(b.yp + (size_t)(off_e + u.m0 + r) * 1024 + col) = pack8(v);
    }
};

__device__ __forceinline__ void naive_dot8(const bf16* arow, const bf16* Bbase, int K, int c, int khook, float ratio, float (&acc)[8]) {
#pragma unroll
    for (int i = 0; i < 8; ++i) acc[i] = 0.f;
    for (int k = 0; k < K; k += 8) {
        if (khook && k == khook) {
#pragma unroll
            for (int i = 0; i < 8; ++i) acc[i] *= ratio;
        }
        float a[8]; unpack8(*(const u32x4*)(arow + k), a);
#pragma unroll
        for (int i = 0; i < 8; ++i) { float w[8]; unpack8(*(const u32x4*)(Bbase + (size_t)(c + i) * K + k), w);
#pragma unroll
            for (int j = 0; j < 8; ++j) acc[i] += a[j] * w[j]; }
    }
}
template <class Sched, class Epi> __global__ void __launch_bounds__(512) k_naive_gemm(Params p) {
    const Bufs b = make_bufs(p.ws); const Epi E{p, b};
    Unit u; Sched::get(blockIdx.x, u); const GemmOp g = Sched::op(b, u);
    const int tid = threadIdx.x, r = tid >> 1, ch = (tid & 1) * 128;
    const bf16* arow = g.A + (size_t)r * g.K;
    float ratio = 1.f; if constexpr (Epi::HOOK) ratio = E.hook_ratio(u, r);
    for (int cg = 0; cg < 16; ++cg) { const int c = ch + cg * 8; float acc[8]; naive_dot8(arow, g.B, g.K, c, g.khook, ratio, acc); E.template operator()<false>(u, r, c, acc); }
}
template <int WHICH> __global__ void __launch_bounds__(512) k_naive_moe(Params p) {
    const Bufs b = make_bufs(p.ws);
    Unit u; int valid; moe_unit(b.cnt, WHICH == 1 ? 8 : 4, blockIdx.x, u, valid); if (!valid) return;
    const int off_e = moe_off(b.cnt, u.e);
    const int tid = threadIdx.x, r = tid >> 1;
    const int rr = r < u.rows ? r : 0;
    if (WHICH == 1) {
        const bf16* arow = b.h2 + (size_t)b.list[u.e * LCAP + u.m0 + rr] * 1024; const bf16* B = b.WguT + (size_t)u.e * 2048 * 1024 + (size_t)u.pn * 256 * 1024;
        EpiG1 E{p, b, nullptr, off_e};
        for (int cg = 0; cg < 8; ++cg) { const int c = (tid & 1) * 64 + cg * 8; float ag[8], au[8]; naive_dot8(arow, B, 1024, c, 0, 1.f, ag); naive_dot8(arow, B, 1024, 128 + c, 0, 1.f, au); E.pair(u, r, c, ag, au); }
    } else {
        const bf16* arow = b.act + (size_t)(off_e + u.m0 + rr) * 1024; const bf16* B = b.WdT + (size_t)u.e * 1024 * 1024 + (size_t)u.pn * 256 * 1024;
        EpiG2 E{p, b, nullptr, off_e};
        for (int cg = 0; cg < 16; ++cg) { const int c = (tid & 1) * 128 + cg * 8; float acc[8]; naive_dot8(arow, B, 1024, c, 0, 1.f, acc); E.template operator()<false>(u, r, c, acc); }
    }
}

__device__ __forceinline__ void kpe_task(const Bufs& b, int gt, int ngt) {
    for (int i = gt; i < T * 8; i += ngt) {
        const int row = i >> 3, h = i & 7, pos = row & (S - 1);
        const float* kr = b.krope + (size_t)row * 32; const float* cs = b.cosT + pos * 16; const float* sn = b.sinT + pos * 16;
        float y1[16], y2[16];
#pragma unroll
        for (int q = 0; q < 4; ++q) { const f32x4 x1 = *(const f32x4*)(kr + 4 * q), x2 = *(const f32x4*)(kr + 16 + 4 * q), c = *(const f32x4*)(cs + 4 * q), sv = *(const f32x4*)(sn + 4 * q);
#pragma unroll
            for (int j = 0; j < 4; ++j) { y1[4 * q + j] = x1[j] * c[j] - x2[j] * sv[j]; y2[4 * q + j] = x2[j] * c[j] + x1[j] * sv[j]; } }
        u32x4* dst = (u32x4*)(b.Km + (size_t)row * 768 + h * 96 + 64);
        dst[0] = (u32x4){pk2(y1[0], y1[1]), pk2(y1[2], y1[3]), pk2(y1[4], y1[5]), pk2(y1[6], y1[7])}; dst[1] = (u32x4){pk2(y1[8], y1[9]), pk2(y1[10], y1[11]), pk2(y1[12], y1[13]), pk2(y1[14], y1[15])};
        dst[2] = (u32x4){pk2(y2[0], y2[1]), pk2(y2[2], y2[3]), pk2(y2[4], y2[5]), pk2(y2[6], y2[7])}; dst[3] = (u32x4){pk2(y2[8], y2[9]), pk2(y2[10], y2[11]), pk2(y2[12], y2[13]), pk2(y2[14], y2[15])};
    }
}
__device__ __forceinline__ void scan_task(const Bufs& b, int gw, int ngw, int lane) {
    for (int q = gw; q < NB * 8; q += ngw) {
        const int bb = q >> 3, h = q & 7; const float* src = b.logf + (size_t)(bb * S + lane * 32) * 8 + h;
        float v[32];
#pragma unroll
        for (int i = 0; i < 32; ++i) v[i] = src[i * 8];
#pragma unroll
        for (int i = 1; i < 32; ++i) v[i] += v[i - 1];
        float tot = v[31], ex = tot;
#pragma unroll
        for (int o = 1; o < 64; o <<= 1) { const float t = __shfl_up(ex, o); if (lane >= o) ex += t; }
        ex -= tot;
        f32x4* dst = (f32x4*)(b.cdec + (size_t)q * S + lane * 32);
#pragma unroll
        for (int i = 0; i < 8; ++i) dst[i] = (f32x4){(ex + v[4 * i]) * LOG2E, (ex + v[4 * i + 1]) * LOG2E, (ex + v[4 * i + 2]) * LOG2E, (ex + v[4 * i + 3]) * LOG2E};
    }
}
__global__ void __launch_bounds__(512) k_side2(Params p) {
    const Bufs b = make_bufs(p.ws);
    kpe_task(b, blockIdx.x * 512 + threadIdx.x, gridDim.x * 512);
    scan_task(b, blockIdx.x * 8 + (threadIdx.x >> 6), gridDim.x * 8, threadIdx.x & 63);
}

template <int MODE> __global__ void __launch_bounds__(256) k_naive_attn(Params p) {
    constexpr int DK = MODE == 0 ? 64 : (MODE == 1 ? 96 : 128), DV = MODE == 2 ? 128 : 64, NH = MODE == 2 ? 4 : 8;
    __shared__ float lg[4][2048]; __shared__ float qs[4][128];
    const Bufs b = make_bufs(p.ws);
    const int lane = threadIdx.x & 63, w = threadIdx.x >> 6;
    const int item = blockIdx.x * 4 + w;
    const int t = item % S, h = (item / S) % NH, bb = item / (S * NH);
    const int row = bb * S + t;
    const bf16* Q = MODE == 0 ? b.Qf + (size_t)row * 512 + h * 64 : (MODE == 1 ? b.Qm + (size_t)row * 768 + h * 96 : b.Qmem + (size_t)row * 512 + h * 128);
    for (int d = lane; d < DK; d += 64) qs[w][d] = bf2f(Q[d]);
    __syncthreads();
    if (MODE == 1 && lane < 16) { const float x1 = qs[w][64 + lane], x2 = qs[w][80 + lane], c = b.cosT[t * 16 + lane], sn = b.sinT[t * 16 + lane];
        qs[w][64 + lane] = bf2f((bf16)f2bf(x1 * c - x2 * sn)); qs[w][80 + lane] = bf2f((bf16)f2bf(x2 * c + x1 * sn)); }
    __syncthreads();
    const int limit = MODE == 0 ? t + 1 : (MODE == 1 ? 64 * (t / 64 + 1) : MEMT);
    const bf16* Kb = MODE == 0 ? b.Kf + (size_t)bb * S * 512 + h * 64 : (MODE == 1 ? b.Km + (size_t)bb * S * 768 + h * 96 : b.KVm + (size_t)bb * MEMT * 1024 + h * 128);
    const int ldk = MODE == 0 ? 512 : (MODE == 1 ? 768 : 1024);
    const bf16* Vb = MODE == 0 ? b.Vf + (size_t)bb * S * 512 + h * 64 : (MODE == 1 ? b.Vm + (size_t)bb * S * 512 + h * 64 : b.KVm + (size_t)bb * MEMT * 1024 + 512 + h * 128);
    const int ldv = MODE == 2 ? 1024 : 512;
    const float* cd = b.cdec + (size_t)(bb * 8 + h) * S;
    float mx = -INFINITY;
    for (int s = lane; s < limit; s += 64) {
        float dot = 0.f;
        for (int d = 0; d < DK; d += 8) { float kk[8]; unpack8(*(const u32x4*)(Kb + (size_t)s * ldk + d), kk);
#pragma unroll
            for (int i = 0; i < 8; ++i) dot += qs[w][d + i] * kk[i]; }
        if (MODE == 0) dot += cd[t] - cd[s];
        lg[w][s] = dot; mx = fmaxf(mx, dot);
    }
    mx = wave_max(mx);
    float sum = 0.f;
    for (int s = lane; s < limit; s += 64) { const float e = exp2f(lg[w][s] - mx); lg[w][s] = e; sum += e; }
    sum = wave_sum(sum);
    __syncthreads();
    float o0 = 0.f, o1 = 0.f;
    for (int s = 0; s < limit; ++s) { const float pp = lg[w][s]; o0 += pp * bf2f(Vb[(size_t)s * ldv + lane]); if (DV == 128) o1 += pp * bf2f(Vb[(size_t)s * ldv + 64 + lane]); }
    const float inv = 1.0f / sum; o0 *= inv; o1 *= inv;
    if (MODE == 0) { b.Omix[(size_t)row * 1024 + h * 64 + lane] = (bf16)f2bf(o0); const float ss = wave_sum(o0 * o0); if (lane == 0) b.pfox[(size_t)row * 8 + h] = ss; }
    else if (MODE == 1) { b.Omix[(size_t)row * 1024 + 512 + h * 64 + lane] = (bf16)f2bf(o0); const float ss = wave_sum(o0 * o0); if (lane == 0) b.pmla[(size_t)row * 8 + h] = ss; }
    else { b.Omem[(size_t)row * 512 + h * 128 + lane] = (bf16)f2bf(o0); b.Omem[(size_t)row * 512 + h * 128 + 64 + lane] = (bf16)f2bf(o1); }
}

__device__ __forceinline__ void router_token(const Params& p, const Bufs& b, int tok, int lane, float* lgs  , float* rowb  ) {
    float ss = 0.f;
    { const u32x4* hr = (const u32x4*)(b.h2 + (size_t)tok * D + lane * 16); float a[8], c[8]; unpack8(hr[0], a); unpack8(hr[1], c);
#pragma unroll
      for (int i = 0; i < 8; ++i) { ss += a[i] * a[i] + c[i] * c[i]; }
      f32x4* dst = (f32x4*)(rowb + lane * 16);
      dst[0] = (f32x4){a[0], a[1], a[2], a[3]}; dst[1] = (f32x4){a[4], a[5], a[6], a[7]}; dst[2] = (f32x4){c[0], c[1], c[2], c[3]}; dst[3] = (f32x4){c[4], c[5], c[6], c[7]}; }
    ss = wave_sum(ss);
    const float rs = 1.0f / sqrtf(ss * (1.0f / 1024.0f) + EPS);
    __builtin_amdgcn_s_waitcnt(0xc07f); __builtin_amdgcn_wave_barrier();
    {
        const int e = lane & 31, k0 = (lane >> 5) * 512; const float* wr = b.wr + (size_t)k0 * 32 + e; const float* xr = rowb + k0;
        float a0 = 0.f, a1 = 0.f, a2 = 0.f, a3 = 0.f;
#pragma unroll 4
        for (int k = 0; k < 512; k += 4) { const f32x4 xv = *(const f32x4*)(xr + k); a0 += xv.x * wr[(k + 0) * 32]; a1 += xv.y * wr[(k + 1) * 32]; a2 += xv.z * wr[(k + 2) * 32]; a3 += xv.w * wr[(k + 3) * 32]; }
        float acc = (a0 + a1) + (a2 + a3);
        acc += __shfl_xor(acc, 32);
        if (lane < 32) lgs[e] = acc * rs + p.b_router[e];
    }
    __builtin_amdgcn_s_waitcnt(0xc07f); __builtin_amdgcn_wave_barrier();
    {
        unsigned taken = 0u; float tv0 = 0.f, tv1 = 0.f, tv2 = 0.f, tv3 = 0.f; int ti0 = 0, ti1 = 0, ti2 = 0, ti3 = 0;
#pragma unroll
        for (int k = 0; k < 4; ++k) {
            float best = -INFINITY; int bi = 0;
            for (int e = 0; e < 32; ++e) { const float x = lgs[e]; if (!((taken >> e) & 1u) && x > best) { best = x; bi = e; } }
            taken |= 1u << bi;
            if (k == 0) { tv0 = best; ti0 = bi; } else if (k == 1) { tv1 = best; ti1 = bi; } else if (k == 2) { tv2 = best; ti2 = bi; } else { tv3 = best; ti3 = bi; }
        }
        const float e0 = 1.0f, e1 = expf(tv1 - tv0), e2 = expf(tv2 - tv0), e3 = expf(tv3 - tv0), inv = 1.0f / (e0 + e1 + e2 + e3);
        if (lane < 4) {
            const int e = lane == 0 ? ti0 : (lane == 1 ? ti1 : (lane == 2 ? ti2 : ti3));
            const float w = (lane == 0 ? e0 : (lane == 1 ? e1 : (lane == 2 ? e2 : e3))) * inv;
            const int pos = atomicAdd(b.cnt + e, 1); b.list[e * LCAP + pos] = tok; b.gatev[e * LCAP + pos] = w; b.toke[tok * 4 + lane] = e; b.tokp[tok * 4 + lane] = pos;
        }
        if (lane == 0) b.rs3[tok] = rs;
    }
    __builtin_amdgcn_wave_barrier();
}
__global__ void __launch_bounds__(512) k_router(Params p) {
    __shared__ float lgs[8][32]; __shared__ __attribute__((aligned(16))) float rowb[8][1024];
    const Bufs b = make_bufs(p.ws); const int lane = threadIdx.x & 63, w = threadIdx.x >> 6;
    for (int tok = blockIdx.x * 8 + w; tok < T; tok += gridDim.x * 8) router_token(p, b, tok, lane, lgs[w], rowb[w]);
}
__device__ __forceinline__ void final_token(const Params& p, const Bufs& b, int tok, int lane, const int* offs  ) {
    float v[16];
#pragma unroll
    for (int hf = 0; hf < 2; ++hf) { float a[8]; unpack8(*(const u32x4*)(b.h2 + (size_t)tok * D + hf * 512 + lane * 8), a);
#pragma unroll
        for (int i = 0; i < 8; ++i) v[hf * 8 + i] = a[i]; }
#pragma unroll
    for (int k = 0; k < 4; ++k) { const int e = b.toke[tok * 4 + k], slot = offs[e] + b.tokp[tok * 4 + k];
#pragma unroll
        for (int hf = 0; hf < 2; ++hf) { float a[8]; unpack8(*(const u32x4*)(b.yp + (size_t)slot * D + hf * 512 + lane * 8), a);
#pragma unroll
            for (int i = 0; i < 8; ++i) v[hf * 8 + i] += a[i]; } }
    float ss = 0.f;
#pragma unroll
    for (int i = 0; i < 16; ++i) ss += v[i] * v[i];
    ss = wave_sum(ss);
    const float rs = 1.0f / sqrtf(ss * (1.0f / 1024.0f) + EPS);
#pragma unroll
    for (int hf = 0; hf < 2; ++hf) { const float* g = p.g_final + hf * 512 + lane * 8; float* o = p.out + (size_t)tok * D + hf * 512 + lane * 8;
        const f32x4 g0 = *(const f32x4*)g, g1 = *(const f32x4*)(g + 4);
        *(f32x4*)o = (f32x4){v[hf * 8 + 0] * rs * g0.x, v[hf * 8 + 1] * rs * g0.y, v[hf * 8 + 2] * rs * g0.z, v[hf * 8 + 3] * rs * g0.w};
        *(f32x4*)(o + 4) = (f32x4){v[hf * 8 + 4] * rs * g1.x, v[hf * 8 + 5] * rs * g1.y, v[hf * 8 + 6] * rs * g1.z, v[hf * 8 + 7] * rs * g1.w}; }
}
__global__ void __launch_bounds__(512) k_final(Params p) {
    __shared__ int offs[32];
    const Bufs b = make_bufs(p.ws); const int lane = threadIdx.x & 63, w = threadIdx.x >> 6;
    if (threadIdx.x < 32) offs[threadIdx.x] = moe_off(b.cnt, threadIdx.x);
    __syncthreads();
    for (int tok = blockIdx.x * 8 + w; tok < T; tok += gridDim.x * 8) final_token(p, b, tok, lane, offs);
}
__global__ void __launch_bounds__(512) k_prep(Params p) {
    extern __shared__ __attribute__((aligned(16))) unsigned char lds[];
    const Bufs b = make_bufs(p.ws);
    prep_phase(p, b, lds, blockIdx.x, gridDim.x);
}

typedef short bf16x8 __attribute__((ext_vector_type(8)));
namespace pg8 {
constexpr int BM = 256, BK = 64, HALF = 128, HTB = HALF * BK * 2, STAGE_BYTES = 8 * HTB;
__host__ __device__ __forceinline__ int lds_byte(int r, int c) { const int st = (r >> 4) * 2 + (c >> 5), rr = r & 15, cc = c & 31, ob = rr * 64 + cc * 2; return st * 1024 + (ob ^ (((ob >> 9) & 1) << 5)); }
__host__ __device__ __forceinline__ void stage_rc(int b, int& R, int& C) { const int st = b / 1024, sb = b % 1024, swz = sb ^ (((sb >> 9) & 1) << 5); R = (st >> 1) * 16 + swz / 64; C = (st & 1) * 32 + (swz % 64) / 2; }
__host__ __device__ __forceinline__ int perm32(int rho) { const int n = rho >> 4, i = rho & 15; return 8 * (i >> 2) + 4 * n + (i & 3); }

template <class Sched, class Epi>
__device__ __forceinline__ void gemm_phase(LAS unsigned char* lds, const Sched& S, const Epi& E) {
    const int tid = threadIdx.x, wid = __builtin_amdgcn_readfirstlane(tid >> 6), lane = tid & 63, wr = wid >> 2, wc = wid & 3, fr = lane & 15, fq = lane >> 4;
    int RA[2], CA[2], RB[2];
#pragma unroll
    for (int i = 0; i < 2; ++i) { int R, C; stage_rc(tid * 16 + i * 8192, R, C); RA[i] = R; CA[i] = C; RB[i] = (R & ~31) + perm32(R & 31); }
    const unsigned ldsw = (unsigned)wid * 1024u;
    const int aoff = lds_byte(wr * 64 + fr, fq * 8), boff = lds_byte(wc * 32 + fr, fq * 8);
#define PG8_SA(b, h) (((b) * 2 + (h)) * HTB)
#define PG8_SB(b, h) ((4 + (b) * 2 + (h)) * HTB)
#define PG8_STAGE(bufoff, gbase, v0, v1) do { \
        __builtin_amdgcn_global_load_lds((const unsigned*)((gbase) + (v0)), (LAS unsigned*)(lds + (bufoff) + ldsw), 16, 0, 0); \
        __builtin_amdgcn_global_load_lds((const unsigned*)((gbase) + (v1)), (LAS unsigned*)(lds + (bufoff) + ldsw + 8192), 16, 0, 0); } while (0)
#define PG8_LDA(dst, b, h) do { _Pragma("unroll") for (int m = 0; m < 4; ++m) _Pragma("unroll") for (int k = 0; k < 2; ++k) dst[m][k] = *(const LAS bf16x8*)(lds + PG8_SA(b, h) + aoff + m * 2048 + k * 1024); } while (0)
#define PG8_LDB(dst, b, h) do { _Pragma("unroll") for (int n = 0; n < 2; ++n) _Pragma("unroll") for (int k = 0; k < 2; ++k) dst[n][k] = *(const LAS bf16x8*)(lds + PG8_SB(b, h) + boff + n * 2048 + k * 1024); } while (0)
#define PG8_MMA(ai, bj, At, Bt) do { __builtin_amdgcn_s_setprio(1); _Pragma("unroll") for (int m = 0; m < 4; ++m) _Pragma("unroll") for (int n = 0; n < 2; ++n) _Pragma("unroll") for (int k = 0; k < 2; ++k) \
        acc[ai][bj][m][n] = __builtin_amdgcn_mfma_f32_16x16x32_bf16(Bt[n][k], At[m][k], acc[ai][bj][m][n], 0, 0, 0); __builtin_amdgcn_s_setprio(0); } while (0)
#define PG8_WAIT_V(n) asm volatile("s_waitcnt vmcnt(" #n ")" ::: "memory")
#define PG8_WAIT_L(n) asm volatile("s_waitcnt lgkmcnt(" #n ")" ::: "memory")
#define PG8_BAR __builtin_amdgcn_s_barrier()
#define PG8_SCHED __builtin_amdgcn_sched_barrier(0)
    Unit cur, nxt; int ui = 0;
    if (!S.next(0, cur)) return;
    f32x4 acc[2][2][4][2];
#pragma unroll
    for (int a = 0; a < 2; ++a)
#pragma unroll
        for (int b = 0; b < 2; ++b)
#pragma unroll
            for (int m = 0; m < 4; ++m)
#pragma unroll
                for (int n = 0; n < 2; ++n) acc[a][b][m][n] = (f32x4){0.f, 0.f, 0.f, 0.f};
    bf16x8 At[4][2], B0[2][2], B1[2][2];
    const int K = S.K, nt = K / BK, khook_t = S.khook ? S.khook / BK : -1;
    const unsigned vB0 = (unsigned)(RB[0] * K + CA[0]) * 2u, vB1 = (unsigned)(RB[1] * K + CA[1]) * 2u;
    const size_t hstep = (size_t)HALF * K * 2;
    constexpr size_t kstep = (size_t)(BK * 2);
    const char *cA, *cB, *nA, *nB;
    unsigned vA00 = (unsigned)(RA[0] * K + CA[0]) * 2u, vA01 = (unsigned)(RA[1] * K + CA[1]) * 2u, vA10 = vA00 + (unsigned)hstep, vA11 = vA01 + (unsigned)hstep;
    unsigned nvA00 = vA00, nvA01 = vA01, nvA10 = vA10, nvA11 = vA11;
#define PG8_SETUP(u, pA, pB, a00, a01, a10, a11) do { const GemmOp g_ = S.op(u); pA = (const char*)g_.A; pB = (const char*)g_.B; \
        if constexpr (Sched::GATHER) { const int mx_ = (u).rows - 1; const int r00 = g_.rowlist[min(RA[0], mx_)], r01 = g_.rowlist[min(RA[1], mx_)], r10 = g_.rowlist[min(HALF + RA[0], mx_)], r11 = g_.rowlist[min(HALF + RA[1], mx_)]; \
            a00 = (unsigned)(r00 * K + CA[0]) * 2u; a01 = (unsigned)(r01 * K + CA[1]) * 2u; a10 = (unsigned)(r10 * K + CA[0]) * 2u; a11 = (unsigned)(r11 * K + CA[1]) * 2u; } } while (0)
    PG8_SETUP(cur, cA, cB, vA00, vA01, vA10, vA11);
    PG8_STAGE(PG8_SB(0, 0), cB, vB0, vB1); PG8_STAGE(PG8_SB(0, 1), cB + hstep, vB0, vB1); PG8_STAGE(PG8_SA(0, 0), cA, vA00, vA01); PG8_STAGE(PG8_SA(0, 1), cA, vA10, vA11);
    if (wr == 1) PG8_BAR;
    PG8_WAIT_V(2); PG8_BAR;
    PG8_STAGE(PG8_SB(1, 0), cB + kstep, vB0, vB1); PG8_STAGE(PG8_SA(1, 0), cA + kstep, vA00, vA01); PG8_STAGE(PG8_SB(1, 1), cB + hstep + kstep, vB0, vB1);
    PG8_WAIT_V(6); PG8_BAR;
    for (;;) {
        const bool has_next = S.next(ui + 1, nxt);
        if (has_next) PG8_SETUP(nxt, nA, nB, nvA00, nvA01, nvA10, nvA11);
        else { nA = cA; nB = cB; if constexpr (Sched::GATHER) { nvA00 = vA00; nvA01 = vA01; nvA10 = vA10; nvA11 = vA11; } }
        for (int t = 0; t < nt; t += 2) {
            const bool last = (t == nt - 2);
            if constexpr (Epi::HOOK) { if (t == khook_t) {
#pragma unroll
                for (int ai = 0; ai < 2; ++ai)
#pragma unroll
                    for (int m = 0; m < 4; ++m) { int rh = ai * HALF + wr * 64 + m * 16 + fr; asm volatile("" : "+v"(rh)); const float rt = E.hook_ratio(cur, rh);
#pragma unroll
                        for (int bj = 0; bj < 2; ++bj)
#pragma unroll
                            for (int n = 0; n < 2; ++n) acc[ai][bj][m][n] = acc[ai][bj][m][n] * rt;
                        asm volatile("" ::: "memory"); } } }
            const char* a1 = cA + (size_t)(t + 1) * kstep;
            const char* a2 = last ? nA : cA + (size_t)(t + 2) * kstep; const char* b2 = last ? nB : cB + (size_t)(t + 2) * kstep;
            const char* a3 = a2 + kstep; const char* b3 = b2 + kstep;
            unsigned wA00 = vA00, wA01 = vA01, wA10 = vA10, wA11 = vA11;
            if constexpr (Sched::GATHER) { wA00 = last ? nvA00 : vA00; wA01 = last ? nvA01 : vA01; wA10 = last ? nvA10 : vA10; wA11 = last ? nvA11 : vA11; }
            PG8_LDB(B0, 0, 0); PG8_LDB(B1, 0, 1); PG8_SCHED; PG8_LDA(At, 0, 0); PG8_STAGE(PG8_SA(1, 1), a1, vA10, vA11);
            PG8_WAIT_V(8); PG8_WAIT_L(0); PG8_BAR; PG8_MMA(0, 0, At, B0); PG8_MMA(0, 1, At, B1); PG8_BAR; PG8_SCHED;
            PG8_LDA(At, 0, 1); PG8_STAGE(PG8_SB(0, 0), b2, vB0, vB1); PG8_STAGE(PG8_SB(0, 1), b2 + hstep, vB0, vB1); PG8_STAGE(PG8_SA(0, 0), a2, wA00, wA01);
            PG8_WAIT_V(8); PG8_WAIT_L(0); PG8_BAR; PG8_MMA(1, 0, At, B0); PG8_MMA(1, 1, At, B1); PG8_BAR; PG8_SCHED;
            PG8_LDB(B0, 1, 0); PG8_LDB(B1, 1, 1); PG8_SCHED; PG8_LDA(At, 1, 0); PG8_STAGE(PG8_SA(0, 1), a2, wA10, wA11);
            PG8_WAIT_V(8); PG8_WAIT_L(0); PG8_BAR; PG8_MMA(0, 0, At, B0); PG8_MMA(0, 1, At, B1); PG8_BAR; PG8_SCHED;
            PG8_LDA(At, 1, 1); PG8_STAGE(PG8_SB(1, 0), b3, vB0, vB1); PG8_STAGE(PG8_SB(1, 1), b3 + hstep, vB0, vB1); PG8_STAGE(PG8_SA(1, 0), a3, wA00, wA01);
            PG8_WAIT_V(8); PG8_WAIT_L(0); PG8_BAR; PG8_MMA(1, 0, At, B0); PG8_MMA(1, 1, At, B1); PG8_BAR; PG8_SCHED;
        }
        if (wr == 0) PG8_BAR;
#pragma unroll
        for (int ai = 0; ai < 2; ++ai)
#pragma unroll
            for (int m = 0; m < 4; ++m) {
                int r = ai * HALF + wr * 64 + m * 16 + fr; asm volatile("" : "+v"(r));
                if constexpr (Epi::PAIRED) {
                    float vg[8], vu[8];
#pragma unroll
                    for (int j = 0; j < 4; ++j) { vg[j] = acc[ai][0][m][0][j]; vg[4 + j] = acc[ai][0][m][1][j]; vu[j] = acc[ai][1][m][0][j]; vu[4 + j] = acc[ai][1][m][1][j]; }
                    E.pair(cur, r, wc * 32 + 8 * fq, vg, vu);
                } else {
#pragma unroll
                    for (int bj = 0; bj < 2; ++bj) { float v[8];
#pragma unroll
                        for (int j = 0; j < 4; ++j) { v[j] = acc[ai][bj][m][0][j]; v[4 + j] = acc[ai][bj][m][1][j]; }
                        E.template operator()<true>(cur, r, bj * HALF + wc * 32 + 8 * fq, v); }
                }
                if constexpr (Epi::HOOK) asm volatile("" ::: "memory");
            }
        if (!has_next) break;
#pragma unroll
        for (int a = 0; a < 2; ++a)
#pragma unroll
            for (int b = 0; b < 2; ++b)
#pragma unroll
                for (int m = 0; m < 4; ++m)
#pragma unroll
                    for (int n = 0; n < 2; ++n) acc[a][b][m][n] = (f32x4){0.f, 0.f, 0.f, 0.f};
        cur = nxt; cA = nA; cB = nB; if constexpr (Sched::GATHER) { vA00 = nvA00; vA01 = nvA01; vA10 = nvA10; vA11 = nvA11; } ++ui;
        if (wr == 1) PG8_BAR;
    }
    PG8_WAIT_V(0);
    PG8_BAR;
#undef PG8_SA
#undef PG8_SB
#undef PG8_STAGE
#undef PG8_LDA
#undef PG8_LDB
#undef PG8_MMA
#undef PG8_WAIT_V
#undef PG8_WAIT_L
#undef PG8_BAR
#undef PG8_SCHED
#undef PG8_SETUP
}
}

typedef float f32x16 __attribute__((ext_vector_type(16)));
typedef short s16x4 __attribute__((ext_vector_type(4)));
typedef float f32x2_t __attribute__((ext_vector_type(2)));
typedef __bf16 bf16x2_t __attribute__((ext_vector_type(2)));
__device__ __forceinline__ unsigned cvtpk(float lo, float hi) { f32x2_t v = {lo, hi}; bf16x2_t b = __builtin_convertvector(v, bf16x2_t); return __builtin_bit_cast(unsigned, b); }
__device__ __forceinline__ int crow(int r, int hi) { return (r & 3) + 8 * (r >> 2) + 4 * hi; }
struct AttnPtrs { const bf16* Q; int ldq; const bf16* K; int ldk; const bf16* V; int ldv; bf16* O; int ldo; float* part; int pstride; const float* cd; const float* cosT; const float* sinT; };
template <int DK, int DV, int MODE>
__device__ __forceinline__ void attn_unit(LAS unsigned char* lds, const AttnPtrs& A, int qb) {
    constexpr int KSLOT = DK * 128, VSLOT = DV * 128, NKP = DK / 8, NVP = DV / 8, BUF = KSLOT + VSLOT, ND = DK / 16, NO = DV / 32;
    const int tid = threadIdx.x, lane = tid & 63, r32 = lane & 31, hi = lane >> 5; const int wid = __builtin_amdgcn_readfirstlane(tid >> 6);
    const int q0 = qb * 256, qrow = q0 + wid * 32 + r32;
    const int NT = MODE == 2 ? 4 : 4 * qb + 4, NTw = MODE == 2 ? 4 : 4 * qb + (wid >> 1) + 1;
    auto issue = [&](int t, int buf) {
        LAS unsigned char* base = lds + buf * BUF;
        for (int pi = wid; pi < NKP + NVP; pi += 8) {
            if (pi < NKP) { const bf16* src = A.K + (size_t)(t * 64 + lane) * A.ldk + pi * 8; __builtin_amdgcn_global_load_lds((const unsigned*)src, (LAS unsigned*)(base + pi * 1024), 16, 0, 0); }
            else { const int v = pi - NKP, dh = v >> 2, kg = v & 3; const bf16* src = A.V + (size_t)(t * 64 + 16 * kg + (lane >> 2)) * A.ldv + dh * 32 + (lane & 3) * 8;
                   __builtin_amdgcn_global_load_lds((const unsigned*)src, (LAS unsigned*)(base + KSLOT + v * 1024), 16, 0, 0); }
        }
    };
    issue(0, 0);
    bf16x8 qr[ND];
#pragma unroll
    for (int d0 = 0; d0 < ND; ++d0) qr[d0] = *(const bf16x8*)(A.Q + (size_t)qrow * A.ldq + d0 * 16 + hi * 8);
    if constexpr (MODE == 1) {
        const float* cp = A.cosT + qrow * 16 + hi * 8; const float* sp = A.sinT + qrow * 16 + hi * 8;
        bf16x8 a = qr[4], c = qr[5];
#pragma unroll
        for (int i = 0; i < 8; ++i) { const float x1 = bf2f((unsigned short)a[i]), x2 = bf2f((unsigned short)c[i]), cs = cp[i], sn = sp[i];
            a[i] = (short)f2bf(x1 * cs - x2 * sn); c[i] = (short)f2bf(x2 * cs + x1 * sn); }
        qr[4] = a; qr[5] = c;
    }
    float m = -INFINITY, l = 0.f; f32x16 o[NO];
#pragma unroll
    for (int i = 0; i < NO; ++i) o[i] = f32x16{};
    float cq = 0.f; if constexpr (MODE == 0) cq = A.cd[qrow];
    __syncthreads();
    for (int t = 0; t < NT; ++t) {
        const int cur = t & 1;
        if (t + 1 < NT) issue(t + 1, cur ^ 1);
        if (t < NTw) {
            const LAS unsigned char* Kb = lds + cur * BUF + hi * 1024 + r32 * 16;
            f32x16 p0, p1;
            if constexpr (MODE == 0) {
                const float* ck = A.cd + t * 64 + 4 * hi;
#pragma unroll
                for (int g = 0; g < 4; ++g) { const f32x4 c0 = *(const f32x4*)(ck + 8 * g), c1 = *(const f32x4*)(ck + 32 + 8 * g);
#pragma unroll
                    for (int i = 0; i < 4; ++i) { p0[4 * g + i] = cq - c0[i]; p1[4 * g + i] = cq - c1[i]; } }
            } else { p0 = f32x16{}; p1 = f32x16{}; }
#pragma unroll
            for (int d0 = 0; d0 < ND; ++d0) {
                const bf16x8 b0 = *(const LAS bf16x8*)(Kb + d0 * 2048), b1 = *(const LAS bf16x8*)(Kb + d0 * 2048 + 512);
                p0 = __builtin_amdgcn_mfma_f32_32x32x16_bf16(b0, qr[d0], p0, 0, 0, 0); p1 = __builtin_amdgcn_mfma_f32_32x32x16_bf16(b1, qr[d0], p1, 0, 0, 0);
            }
            if constexpr (MODE == 0) { if (t == NTw - 1) {
                const int kb = t * 64 + 4 * hi;
#pragma unroll
                for (int r = 0; r < 16; ++r) { const int kv = kb + (r & 3) + 8 * (r >> 2); if (kv > qrow) p0[r] = -INFINITY; if (kv + 32 > qrow) p1[r] = -INFINITY; } } }
            float rm = fmaxf(p0[0], p1[0]);
#pragma unroll
            for (int r = 1; r < 16; ++r) rm = fmaxf(rm, fmaxf(p0[r], p1[r]));
            { auto rr = __builtin_amdgcn_permlane32_swap(__float_as_uint(rm), __float_as_uint(rm), false, false); rm = fmaxf(__uint_as_float(rr[0]), __uint_as_float(rr[1])); }
            const float mn = fmaxf(m, rm), alpha = __builtin_amdgcn_exp2f(m - mn); m = mn;
            float sum = 0.f;
#pragma unroll
            for (int r = 0; r < 16; ++r) { p0[r] = __builtin_amdgcn_exp2f(p0[r] - mn); p1[r] = __builtin_amdgcn_exp2f(p1[r] - mn); sum += p0[r] + p1[r]; }
            l = l * alpha + sum;
#pragma unroll
            for (int i = 0; i < NO; ++i)
#pragma unroll
                for (int r = 0; r < 16; ++r) o[i][r] *= alpha;
            u32x4 pw[4];
#pragma unroll
            for (int s = 0; s < 2; ++s) { pw[s] = (u32x4){cvtpk(p0[8 * s], p0[8 * s + 1]), cvtpk(p0[8 * s + 2], p0[8 * s + 3]), cvtpk(p0[8 * s + 4], p0[8 * s + 5]), cvtpk(p0[8 * s + 6], p0[8 * s + 7])};
                pw[2 + s] = (u32x4){cvtpk(p1[8 * s], p1[8 * s + 1]), cvtpk(p1[8 * s + 2], p1[8 * s + 3]), cvtpk(p1[8 * s + 4], p1[8 * s + 5]), cvtpk(p1[8 * s + 6], p1[8 * s + 7])}; }
            const LAS unsigned char* Vb = lds + cur * BUF + KSLOT + ((lane >> 4) & 1) * 32 + (lane & 3) * 8 + (4 * hi + ((lane & 15) >> 2)) * 64;
#pragma unroll
            for (int d0 = 0; d0 < NO; ++d0)
#pragma unroll
                for (int ks = 0; ks < 4; ++ks) {
                    const s16x4 vl = __builtin_bit_cast(s16x4, __builtin_amdgcn_ds_read_tr16_b64_v4i16((LAS s16x4*)(Vb + d0 * 4096 + ks * 1024)));
                    const s16x4 vh = __builtin_bit_cast(s16x4, __builtin_amdgcn_ds_read_tr16_b64_v4i16((LAS s16x4*)(Vb + d0 * 4096 + ks * 1024 + 512)));
                    const bf16x8 vf = (bf16x8){vl[0], vl[1], vl[2], vl[3], vh[0], vh[1], vh[2], vh[3]};
                    o[d0] = __builtin_amdgcn_mfma_f32_32x32x16_bf16(vf, __builtin_bit_cast(bf16x8, pw[ks]), o[d0], 0, 0, 0);
                }
        }
        __syncthreads();
    }
    { auto rr = __builtin_amdgcn_permlane32_swap(__float_as_uint(l), __float_as_uint(l), false, false); l = __uint_as_float(rr[0]) + __uint_as_float(rr[1]); }
    const float inv = 1.0f / l; float ss = 0.f;
    bf16* orow = A.O + (size_t)qrow * A.ldo + 4 * hi;
#pragma unroll
    for (int d0 = 0; d0 < NO; ++d0)
#pragma unroll
        for (int g = 0; g < 4; ++g) { const float a = o[d0][4 * g] * inv, c = o[d0][4 * g + 1] * inv, d = o[d0][4 * g + 2] * inv, e = o[d0][4 * g + 3] * inv;
            ss += (a * a + c * c) + (d * d + e * e);
            u32x2 w; w.x = pk2(a, c); w.y = pk2(d, e); *(u32x2*)(orow + d0 * 32 + 8 * g) = w; }
    if (A.part) { auto rr = __builtin_amdgcn_permlane32_swap(__float_as_uint(ss), __float_as_uint(ss), false, false); ss = __uint_as_float(rr[0]) + __uint_as_float(rr[1]); if (hi == 0) A.part[(size_t)qrow * A.pstride] = ss; }
}
__device__ __forceinline__ void attn_phase_self(LAS unsigned char* lds, const Bufs& b, int vcu) {
    const int bh = vcu >> 2, s = vcu & 3, bb = bh >> 3, h = bh & 7; const size_t r0 = (size_t)bb * S;
    if (vcu >= 256) return;
    AttnPtrs F{b.Qf + r0 * 512 + h * 64, 512, b.Kf + r0 * 512 + h * 64, 512, b.Vf + r0 * 512 + h * 64, 512, b.Omix + r0 * 1024 + h * 64, 1024, b.pfox + r0 * 8 + h, 8, b.cdec + (size_t)bh * S, nullptr, nullptr};
    AttnPtrs M{b.Qm + r0 * 768 + h * 96, 768, b.Km + r0 * 768 + h * 96, 768, b.Vm + r0 * 512 + h * 64, 512, b.Omix + r0 * 1024 + 512 + h * 64, 1024, b.pmla + r0 * 8 + h, 8, nullptr, b.cosT, b.sinT};
    attn_unit<96, 64, 1>(lds, M, 7 - s); attn_unit<64, 64, 0>(lds, F, 7 - s); attn_unit<96, 64, 1>(lds, M, s); attn_unit<64, 64, 0>(lds, F, s);
}
__device__ __forceinline__ void attn_phase_mem(LAS unsigned char* lds, const Bufs& b, int vcu) {
    if (vcu >= 256) return;
    const int bb = vcu >> 5, h = (vcu >> 3) & 3, qb = vcu & 7; const size_t r0 = (size_t)bb * S, m0 = (size_t)bb * MEMT;
    AttnPtrs X{b.Qmem + r0 * 512 + h * 128, 512, b.KVm + m0 * 1024 + h * 128, 1024, b.KVm + m0 * 1024 + 512 + h * 128, 1024, b.Omem + r0 * 512 + h * 128, 512, nullptr, 0, nullptr, nullptr, nullptr};
    attn_unit<128, 128, 2>(lds, X, qb);
}

typedef float f32x4v __attribute__((ext_vector_type(4)));
__device__ __forceinline__ void router_tile(const Params& p, const Bufs& b, int tile, int lane, float* lgl  ) {
    const int n = lane & 15, g = lane >> 4, tok0 = tile * 16;
    const bf16* hrow = b.h2 + (size_t)(tok0 + n) * D + 8 * g;
    const bf16* wh0 = (const bf16*)b.wr + (size_t)n * 1024 + 8 * g; const bf16* wh1 = wh0 + 16 * 1024; const bf16* wl0 = wh0 + 32768; const bf16* wl1 = wh1 + 32768;
    f32x4v acc0 = {0.f, 0.f, 0.f, 0.f}, acc1 = {0.f, 0.f, 0.f, 0.f}; float ss = 0.f;
#pragma unroll 4
    for (int j = 0; j < 32; ++j) {
        const u32x4 araw = *(const u32x4*)(hrow + 32 * j); const bf16x8 a = __builtin_bit_cast(bf16x8, araw);
        const bf16x8 h0 = *(const bf16x8*)(wh0 + 32 * j), h1 = *(const bf16x8*)(wh1 + 32 * j), l0 = *(const bf16x8*)(wl0 + 32 * j), l1 = *(const bf16x8*)(wl1 + 32 * j);
        float f[8]; unpack8(araw, f);
#pragma unroll
        for (int i = 0; i < 8; ++i) ss += f[i] * f[i];
        acc0 = __builtin_amdgcn_mfma_f32_16x16x32_bf16(h0, a, acc0, 0, 0, 0); acc0 = __builtin_amdgcn_mfma_f32_16x16x32_bf16(l0, a, acc0, 0, 0, 0);
        acc1 = __builtin_amdgcn_mfma_f32_16x16x32_bf16(h1, a, acc1, 0, 0, 0); acc1 = __builtin_amdgcn_mfma_f32_16x16x32_bf16(l1, a, acc1, 0, 0, 0);
    }
    ss += __shfl_xor(ss, 16); ss += __shfl_xor(ss, 32);
    const float rs = 1.0f / sqrtf(ss * (1.0f / 1024.0f) + EPS);
#pragma unroll
    for (int r = 0; r < 4; ++r) { lgl[n * 33 + 4 * g + r] = acc0[r] * rs + p.b_router[4 * g + r]; lgl[n * 33 + 16 + 4 * g + r] = acc1[r] * rs + p.b_router[16 + 4 * g + r]; }
    __builtin_amdgcn_s_waitcnt(0xc07f); __builtin_amdgcn_wave_barrier();
    if (lane < 16) {
        const float* lg = lgl + lane * 33; const int tok = tok0 + lane;
        unsigned taken = 0u; float tv0 = 0.f, tv1 = 0.f, tv2 = 0.f, tv3 = 0.f; int ti0 = 0, ti1 = 0, ti2 = 0, ti3 = 0;
#pragma unroll
        for (int k = 0; k < 4; ++k) {
            float best = -INFINITY; int bi = 0;
            for (int e = 0; e < 32; ++e) { const float x = lg[e]; if (!((taken >> e) & 1u) && x > best) { best = x; bi = e; } }
            taken |= 1u << bi;
            if (k == 0) { tv0 = best; ti0 = bi; } else if (k == 1) { tv1 = best; ti1 = bi; } else if (k == 2) { tv2 = best; ti2 = bi; } else { tv3 = best; ti3 = bi; }
        }
        const float e1 = expf(tv1 - tv0), e2 = expf(tv2 - tv0), e3 = expf(tv3 - tv0), inv = 1.0f / (1.0f + e1 + e2 + e3);
        const int p0 = atomicAdd(b.cnt + ti0, 1), p1 = atomicAdd(b.cnt + ti1, 1), p2 = atomicAdd(b.cnt + ti2, 1), p3 = atomicAdd(b.cnt + ti3, 1);
        b.list[ti0 * LCAP + p0] = tok; b.list[ti1 * LCAP + p1] = tok; b.list[ti2 * LCAP + p2] = tok; b.list[ti3 * LCAP + p3] = tok;
        b.gatev[ti0 * LCAP + p0] = inv; b.gatev[ti1 * LCAP + p1] = e1 * inv; b.gatev[ti2 * LCAP + p2] = e2 * inv; b.gatev[ti3 * LCAP + p3] = e3 * inv;
        b.rsl[ti0 * LCAP + p0] = rs; b.rsl[ti1 * LCAP + p1] = rs; b.rsl[ti2 * LCAP + p2] = rs; b.rsl[ti3 * LCAP + p3] = rs;
        *(int4*)(b.toke + tok * 4) = make_int4(ti0, ti1, ti2, ti3); *(int4*)(b.tokp + tok * 4) = make_int4(p0, p1, p2, p3);
        b.rs3[tok] = rs;
    }
    __builtin_amdgcn_wave_barrier();
}

template <class Base> struct PSched {
    static constexpr bool GATHER = false; Bufs b; int G, c, K, khook;
    __device__ __forceinline__ bool next(int i, Unit& u) const { const int L = i * G + c; if (L >= Base::NUNITS) return false; Base::get(L, u); return true; }
    __device__ __forceinline__ GemmOp op(const Unit& u) const { return Base::op(b, u); }
};
__device__ __forceinline__ void moe_build(LAS MoeTabL* tab, const int* cnt) {
    if (threadIdx.x < 64) {
        const int lane = threadIdx.x; const int c = (lane < 32) ? (int)__hip_atomic_load((const unsigned*)cnt + lane, __ATOMIC_RELAXED, __HIP_MEMORY_SCOPE_AGENT) : 0;
        const int nt = (c + 255) >> 8; int st = nt, so = c;
#pragma unroll
        for (int o = 1; o < 32; o <<= 1) { const int a = __shfl_up(st, o), d = __shfl_up(so, o); if (lane >= o) { st += a; so += d; } }
        if (lane < 32) { tab->ntile[lane] = nt; tab->cumT[lane + 1] = st; tab->off[lane + 1] = so; }
        if (lane == 0) { tab->cumT[0] = 0; tab->off[0] = 0; }
    }
    __syncthreads();
}
template <int WHICH> struct MoeSched {
    Bufs b; LAS MoeTabL* tab; int G, vcu;
    static constexpr int NPN = WHICH == 1 ? 8 : 4, K = 1024, khook = 0; static constexpr bool GATHER = WHICH == 1;
    __device__ __forceinline__ bool next(int i, Unit& u) const {
        const int L = i * G + vcu; const int total = __builtin_amdgcn_readfirstlane(tab->cumT[32]) * NPN; if (L >= total) return false;
        int e = 0;
        for (int j = 1; j < 32; ++j) { if (__builtin_amdgcn_readfirstlane(tab->cumT[j]) * NPN <= L) e = j; }
        const int base = __builtin_amdgcn_readfirstlane(tab->cumT[e]) * NPN, nt = __builtin_amdgcn_readfirstlane(tab->ntile[e]), l = L - base;
        const int cn = __builtin_amdgcn_readfirstlane(tab->off[e + 1]) - __builtin_amdgcn_readfirstlane(tab->off[e]);
        u.kind = 0; u.e = e; u.pn = l / nt; u.pm = l % nt; u.m0 = u.pm * 256; u.rows = min(256, cn - u.m0); return true;
    }
    __device__ __forceinline__ int off_e(const Unit& u) const { return __builtin_amdgcn_readfirstlane(tab->off[u.e]); }
    __device__ __forceinline__ GemmOp op(const Unit& u) const {
        GemmOp g; g.K = 1024; g.khook = 0;
        if (WHICH == 1) { g.A = b.h2; g.rowlist = b.list + u.e * LCAP + u.m0; g.B = b.WguT + ((size_t)u.e * 2048 + (size_t)u.pn * 256) * 1024; }
        else { g.A = b.act + (size_t)(off_e(u) + u.m0) * 1024; g.rowlist = nullptr; g.B = b.WdT + ((size_t)u.e * 1024 + (size_t)u.pn * 256) * 1024; }
        return g;
    }
};

#define XB_TMO      128
#define XB_XCNT(j)  (256  + 64 * (j))
#define XB_XSUB(j)  (1280 + 64 * (j))
#define XB_XGEN(j)  (2304 + 64 * (j))
#define XB_TOP      3328
#define XB_TOPGEN   3392
#define XCD_BAR_WORDS 3456
#define XB_SPIN_CAP (1u << 18)
__device__ __forceinline__ unsigned xb_ld(unsigned* p)              { return __hip_atomic_load(p, __ATOMIC_RELAXED, __HIP_MEMORY_SCOPE_AGENT); }
__device__ __forceinline__ unsigned xb_add(unsigned* p, unsigned v) { return __hip_atomic_fetch_add(p, v, __ATOMIC_RELAXED, __HIP_MEMORY_SCOPE_AGENT); }
__device__ __forceinline__ unsigned xb_xcc_id() { return (unsigned)__builtin_amdgcn_s_getreg((3 << 11) | 20) & 0xFu; }
#define XB_SPIN(cond, bar) do { unsigned _sp = 0; while (cond) { __builtin_amdgcn_s_sleep(1); \
    if ((++_sp & 255u) == 0u) { if (xb_ld(&(bar)[XB_TMO])) break; if (_sp > XB_SPIN_CAP) { atomicAdd(&(bar)[XB_TMO], 1u); break; } } } } while (0)
struct XcdBarrier { unsigned* bar; unsigned x; volatile LAS unsigned* st; };
__device__ __forceinline__ XcdBarrier xcd_barrier_post(unsigned* bar, volatile LAS unsigned* st) {
    XcdBarrier b; b.bar = bar; b.x = xb_xcc_id(); b.st = st;
    if (threadIdx.x == 0) (void)xb_add(&bar[XB_XCNT(b.x)], 1u);
    return b;
}
__device__ __forceinline__ void xcd_barrier_complete(unsigned* bar, unsigned x, unsigned& nloc, unsigned& nx) {
    const unsigned G = gridDim.x * gridDim.y * gridDim.z;
    unsigned sum, cnt, mine, sp = 0u;
    for (;;) {
        sum = 0u; cnt = 0u; mine = 0u;
#pragma unroll
        for (unsigned j = 0; j < 16; ++j) { const unsigned c = xb_ld(&bar[XB_XCNT(j)]); sum += c; cnt += (c > 0u) ? 1u : 0u; mine = (j == x) ? c : mine; }
        if (sum == G) break;
        __builtin_amdgcn_s_sleep(1);
        if ((++sp & 255u) == 0u) { if (xb_ld(&bar[XB_TMO])) break; if (sp > XB_SPIN_CAP) { atomicAdd(&bar[XB_TMO], 1u); break; } }
    }
    nloc = mine > 0u ? mine : 1u; nx = cnt > 0u ? cnt : 1u;
}
__device__ __forceinline__ void xcd_barrier(const XcdBarrier& b) {
    asm volatile("s_waitcnt vmcnt(0)" ::: "memory");
    __syncthreads();
    if (threadIdx.x == 0) {
        unsigned* bar = b.bar;
        __builtin_amdgcn_s_waitcnt(0);
        unsigned nloc = b.st[0], nx = b.st[1];
        if (nloc == 0u) { xcd_barrier_complete(bar, b.x, nloc, nx); b.st[0] = nloc; b.st[1] = nx; }
        const unsigned old = xb_add(&bar[XB_XSUB(b.x)], 1u);
        const unsigned gen = old / nloc;
        if (old + 1u == (gen + 1u) * nloc) {
            __builtin_amdgcn_fence(__ATOMIC_RELEASE, "agent");
            asm volatile("s_waitcnt vmcnt(0)" ::: "memory");
            const unsigned og = xb_add(&bar[XB_TOP], 1u);
            const unsigned tg = og / nx;
            if (og + 1u == (tg + 1u) * nx) xb_add(&bar[XB_TOPGEN], 1u);
            else XB_SPIN(xb_ld(&bar[XB_TOPGEN]) == tg, bar);
            __builtin_amdgcn_fence(__ATOMIC_ACQUIRE, "agent");
            xb_add(&bar[XB_XGEN(b.x)], 1u);
            asm volatile("s_waitcnt vmcnt(0)" ::: "memory");
        } else {
            XB_SPIN(xb_ld(&bar[XB_XGEN(b.x)]) == gen, bar);
            __builtin_amdgcn_fence(__ATOMIC_ACQUIRE, "agent");
            asm volatile("s_waitcnt vmcnt(0)" ::: "memory");
        }
    }
    __syncthreads();
}

constexpr int RING_BYTES = 131072, MISC_OFF = RING_BYTES, LDS_BYTES = 147456;
constexpr int NPHASE = 12;
__global__ void __launch_bounds__(512, 2) mega(Params p) {
    extern __shared__ __attribute__((aligned(16))) unsigned char lds_raw[];
    LAS unsigned char* lds = (LAS unsigned char*)lds_raw;
    const Bufs b = make_bufs(p.ws);
    const int tid = threadIdx.x, lane = tid & 63, wave = __builtin_amdgcn_readfirstlane(tid >> 6);
    const int G = gridDim.x, bx = blockIdx.x, vcu = (G % 8 == 0) ? (bx % 8) * (G / 8) + bx / 8 : bx;
    LAS MoeTabL* tab = (LAS MoeTabL*)(lds + MISC_OFF);
    volatile LAS unsigned* xst = (volatile LAS unsigned*)(lds + MISC_OFF + 512);
    if (tid < 2) xst[tid] = 0u;
    __syncthreads();
    XcdBarrier xbar; xbar.bar = (unsigned*)(p.ws + WS_CTL); xbar.x = 0; xbar.st = xst;
    if (p.ph_hi - p.ph_lo > 1) xbar = xcd_barrier_post((unsigned*)(p.ws + WS_CTL), xst);
    const int lo = p.ph_lo, hi = p.ph_hi;
#ifndef REPK
#define REPK -1
#endif
#define SEAM(k) do { if (IN(k) && IN((k) + 1)) xcd_barrier(xbar); } while (0)
#ifdef ONLY
#define IN(k) ((k) == ONLY && lo <= (k) && (k) < hi)
#else
#define IN(k) (lo <= (k) && (k) < hi)
#endif
#define RUN(k, ...) do { if (IN(k)) { __VA_ARGS__ if (REPK == (k)) { xcd_barrier(xbar); __VA_ARGS__ } } } while (0)
    RUN(0, { prep_phase(p, b, lds_raw, bx, G); });
    SEAM(0);
    RUN(1, { PSched<SchedIn> S{b, G, bx, 1024, 0}; EpiIn E{p, b}; pg8::gemm_phase(lds, S, E); });
    SEAM(1);
    RUN(2, { EpiUp E{p, b}; { PSched<SchedUpQ> S{b, G, bx, 384, 0}; pg8::gemm_phase(lds, S, E); } { PSched<SchedUpKV> S{b, G, bx, 256, 0}; pg8::gemm_phase(lds, S, E); }
                 kpe_task(b, bx * 512 + tid, G * 512); scan_task(b, bx * 8 + wave, G * 8, lane); });
    SEAM(2);
    RUN(3, { attn_phase_self(lds, b, vcu); });
    SEAM(3);
    RUN(4, { PSched<SchedOut> S{b, G, bx, 1024, 512}; EpiOut E{p, b}; pg8::gemm_phase(lds, S, E); });
    SEAM(4);
    RUN(5, { PSched<SchedMq> S{b, G, bx, 1024, 0}; EpiMq E{p, b}; pg8::gemm_phase(lds, S, E); });
    SEAM(5);
    RUN(6, { attn_phase_mem(lds, b, vcu); });
    SEAM(6);
    RUN(7, { PSched<SchedMo> S{b, G, bx, 512, 0}; EpiMo E{p, b}; pg8::gemm_phase(lds, S, E); });
    SEAM(7);
    if (IN(8)) { float* lgl = (float*)lds_raw + wave * 544; if (wave < 4) for (int tile = wave * G + bx; tile < T / 16; tile += 4 * G) router_tile(p, b, tile, lane, lgl); }
    SEAM(8);
    RUN(9, { moe_build(tab, b.cnt); MoeSched<1> S{b, tab, G, vcu}; EpiG1 E{p, b, tab, 0}; pg8::gemm_phase(lds, S, E); });
    SEAM(9);
    RUN(10, { moe_build(tab, b.cnt); MoeSched<2> S{b, tab, G, vcu}; EpiG2 E{p, b, tab, 0}; pg8::gemm_phase(lds, S, E); });
    SEAM(10);
    RUN(11, { moe_build(tab, b.cnt); for (int tok = bx * 8 + wave; tok < T; tok += G * 8) final_token(p, b, tok, lane, (const int*)tab->off); });
#undef RUN
#undef IN
#undef SEAM
}

extern "C" void kernel_launch(void* const* d_in, const int* in_sizes, int n_in, void* d_out, int out_size, void* d_ws, size_t ws_size, hipStream_t stream) {
    static int inited = 0; static int grid = 256;
    if (!inited) {
        if (n_in != 25 || ws_size < WS_END) { fprintf(stderr, "kernel_launch: unexpected n_in %d / ws_size %zu\n", n_in, ws_size); inited = -1; return; }
        (void)hipFuncSetAttribute((const void*)k_prep, hipFuncAttributeMaxDynamicSharedMemorySize, TP_LDS);
        (void)hipFuncSetAttribute((const void*)mega, hipFuncAttributeMaxDynamicSharedMemorySize, LDS_BYTES);
        int dev = 0, cus = 0; (void)hipGetDevice(&dev); (void)hipDeviceGetAttribute(&cus, hipDeviceAttributeMultiprocessorCount, dev); int per_cu = 0; (void)hipOccupancyMaxActiveBlocksPerMultiprocessor(&per_cu, (const void*)mega, 512, LDS_BYTES); grid = (cus > 0 ? cus : 256) * (per_cu > 0 ? 1 : 1);
        if (per_cu < 1) fprintf(stderr, "kernel_launch: occupancy query reports %d blocks per CU\n", per_cu);
        inited = 1;
    }
    if (inited < 0) return;
    Params p{};
    const float** pp = (const float**)&p;
    for (int i = 0; i < 25; ++i) pp[i] = (const float*)d_in[i];
    p.out = (float*)d_out; p.ws = (unsigned char*)d_ws; p.ph_lo = 0; p.ph_hi = 0;
    (void)hipMemsetAsync((char*)d_ws + WS_CTL, 0, 65536, stream);
    p.ph_lo = 0; p.ph_hi = NPHASE;
    void* args[] = {&p};
    hipError_t e = hipLaunchCooperativeKernel((const void*)mega, dim3(grid), dim3(512), args, LDS_BYTES, stream);
    if (e != hipSuccess) fprintf(stderr, "cooperative launch failed: %s (grid %d)\n", hipGetErrorString(e), grid);
}
```

```cpp
#include <hip/hip_runtime.h>
#include <hip/hip_cooperative_groups.h>
#include <cstdio>
#include <cstdint>

constexpr int NB = 8, S = 2048, D = 1024, T = NB * S;
constexpr int IN_PAD = 2304;
constexpr int MEMT = 256, MROWS = NB * MEMT;
constexpr int NE = 32, TOPK = 4, NPAIR = T * TOPK;
constexpr int LCAP = T;
constexpr float EPS = 1e-6f;
constexpr float LOG2E = 1.4426950408889634f;
constexpr float QS_FOX = 0.125f * LOG2E;
constexpr float QS_MLA = 0.10206207261596577f * LOG2E;
constexpr float QS_MEM = 0.08838834764831845f * LOG2E;
#ifndef ATT_PRB
#define ATT_PRB 0
#endif
#ifndef ATT_PIPE
#define ATT_PIPE 1
#endif
#ifndef MOE_FP8
#define MOE_FP8 1
#endif
constexpr float W8_SCALE = 32.0f, ACT8_SCALE = 4.0f, YP8_SCALE = 16.0f;

typedef unsigned short bf16;
typedef float f32x4 __attribute__((ext_vector_type(4)));
typedef unsigned u32x4 __attribute__((ext_vector_type(4)));
typedef unsigned u32x2 __attribute__((ext_vector_type(2)));

constexpr size_t MiB = 1u << 20;
constexpr size_t WS_CTL = 0;
constexpr size_t WS_BLKCNT = 128 * 1024;
constexpr size_t WS_CNT = 64 * 1024;
constexpr size_t WS_RS1 = 1 * MiB + 5 * 65536, WS_RS3 = 1 * MiB + 6 * 65536, WS_RSMEM = 1 * MiB + 7 * 65536;
constexpr size_t WS_PQ = 11 * MiB, WS_PKV = 12 * MiB, WS_PFOX = 12 * MiB + 524288, WS_PMLA = 13 * MiB, WS_P2 = 14 * MiB;
constexpr size_t WS_COS = 2 * MiB, WS_SIN = 2 * MiB + 131072, WS_WR = 2 * MiB + 262144, WS_LOGF = 3 * MiB, WS_CDEC = 3 * MiB + 524288, WS_KROPE = 4 * MiB;
constexpr size_t WS_TOKE = 6 * MiB, WS_TOKP = 6 * MiB + 262144, WS_LIST = 7 * MiB, WS_GATEV = 9 * MiB;
constexpr size_t WS_WIN = 16 * MiB, WS_WUQ = 21 * MiB, WS_WUKV = 22 * MiB, WS_WO = 23 * MiB, WS_WMQ = 25 * MiB, WS_WMKV = 26 * MiB, WS_WMO = 28 * MiB;
constexpr size_t WS_RSL = 30 * MiB;
constexpr size_t WS_WGU = 32 * MiB, WS_WD = 160 * MiB;
constexpr size_t WS_XB = 224 * MiB, WS_MEMB = 256 * MiB, WS_KVM = 260 * MiB, WS_QF = 264 * MiB, WS_KF = 280 * MiB, WS_VF = 296 * MiB;
constexpr size_t WS_QLAT = 312 * MiB, WS_KVLAT = 324 * MiB, WS_QM = 332 * MiB, WS_KM = 356 * MiB, WS_VM = 380 * MiB, WS_OMIX = 396 * MiB;
constexpr size_t WS_H1 = 428 * MiB, WS_QMEM = 460 * MiB, WS_OMEM = 476 * MiB, WS_H2 = 492 * MiB, WS_ACT = 524 * MiB, WS_YP = 653 * MiB, WS_END = 782 * MiB;

struct Params {
    const float *x, *mem, *g_mix, *w_in, *b_f, *g_q_lat, *w_uq, *g_kv_lat, *w_ukv, *g_fox_out, *g_mla_out, *w_o, *g_mem_q, *w_mem_q, *g_mem_kv, *w_mem_kv, *w_mem_o,
        *g_ffn, *w_router, *b_router, *w_gate_up, *b_gate_up, *w_down, *b_down, *g_final;
    float* out; unsigned char* ws;
    int ph_lo, ph_hi;
};
struct Bufs {
    int* cnt; int* blkcnt; float *pq, *pkv, *pfox, *pmla, *p2, *rs1, *rs3, *rsmem, *cosT, *sinT, *wr, *logf, *cdec, *krope, *gatev, *rsl;
    int *toke, *tokp, *list;
    bf16 *WinT, *WuqT, *WukvT, *WoT, *WmqT, *WmkvT, *WmoT, *WguT, *WdT;
    bf16 *xb, *memb, *KVm, *Qf, *Kf, *Vf, *qlat, *kvlat, *Qm, *Km, *Vm, *Omix, *h1, *Qmem, *Omem, *h2, *act, *yp; unsigned char* h2q;
};
__host__ __device__ __forceinline__ Bufs make_bufs(unsigned char* ws) {
    Bufs b;
    b.cnt = (int*)(ws + WS_CNT); b.blkcnt = (int*)(ws + WS_BLKCNT);
    b.pq = (float*)(ws + WS_PQ); b.pkv = (float*)(ws + WS_PKV); b.pfox = (float*)(ws + WS_PFOX); b.pmla = (float*)(ws + WS_PMLA);
    b.p2 = (float*)(ws + WS_P2); b.rs1 = (float*)(ws + WS_RS1); b.rs3 = (float*)(ws + WS_RS3); b.rsmem = (float*)(ws + WS_RSMEM);
    b.cosT = (float*)(ws + WS_COS); b.sinT = (float*)(ws + WS_SIN); b.wr = (float*)(ws + WS_WR); b.logf = (float*)(ws + WS_LOGF); b.cdec = (float*)(ws + WS_CDEC);
    b.krope = (float*)(ws + WS_KROPE); b.gatev = (float*)(ws + WS_GATEV); b.rsl = (float*)(ws + WS_RSL);
    b.toke = (int*)(ws + WS_TOKE); b.tokp = (int*)(ws + WS_TOKP); b.list = (int*)(ws + WS_LIST);
    b.WinT = (bf16*)(ws + WS_WIN); b.WuqT = (bf16*)(ws + WS_WUQ); b.WukvT = (bf16*)(ws + WS_WUKV); b.WoT = (bf16*)(ws + WS_WO); b.WmqT = (bf16*)(ws + WS_WMQ);
    b.WmkvT = (bf16*)(ws + WS_WMKV); b.WmoT = (bf16*)(ws + WS_WMO); b.WguT = (bf16*)(ws + WS_WGU); b.WdT = (bf16*)(ws + WS_WD);
    b.xb = (bf16*)(ws + WS_XB); b.memb = (bf16*)(ws + WS_MEMB); b.KVm = (bf16*)(ws + WS_KVM); b.Qf = (bf16*)(ws + WS_QF); b.Kf = (bf16*)(ws + WS_KF); b.Vf = (bf16*)(ws + WS_VF);
    b.qlat = (bf16*)(ws + WS_QLAT); b.kvlat = (bf16*)(ws + WS_KVLAT); b.Qm = (bf16*)(ws + WS_QM); b.Km = (bf16*)(ws + WS_KM); b.Vm = (bf16*)(ws + WS_VM);
    b.Omix = (bf16*)(ws + WS_OMIX); b.h1 = (bf16*)(ws + WS_H1); b.Qmem = (bf16*)(ws + WS_QMEM); b.Omem = (bf16*)(ws + WS_OMEM); b.h2 = (bf16*)(ws + WS_H2);
    b.act = (bf16*)(ws + WS_ACT); b.yp = (bf16*)(ws + WS_YP); b.h2q = ws + WS_ACT + 96 * MiB;
    return b;
}

__device__ __forceinline__ unsigned f2bf(float f) { unsigned u = __builtin_bit_cast(unsigned, f); return (u + 0x7fffu + ((u >> 16) & 1u)) >> 16; }
typedef float f32x2_t __attribute__((ext_vector_type(2)));
typedef __bf16 bf16x2_t __attribute__((ext_vector_type(2)));
__device__ __forceinline__ unsigned pk2(float lo, float hi) { f32x2_t v = {lo, hi}; bf16x2_t b = __builtin_convertvector(v, bf16x2_t); return __builtin_bit_cast(unsigned, b); }
__device__ __forceinline__ float bf2f(unsigned short h) { return __builtin_bit_cast(float, (unsigned)h << 16); }
__device__ __forceinline__ float bflo(unsigned w) { return __builtin_bit_cast(float, w << 16); }
__device__ __forceinline__ float bfhi(unsigned w) { return __builtin_bit_cast(float, w & 0xffff0000u); }
__device__ __forceinline__ float wave_sum(float v) {
#pragma unroll
    for (int o = 1; o < 64; o <<= 1) v += __shfl_xor(v, o);
    return v;
}
__device__ __forceinline__ float wave_max(float v) {
#pragma unroll
    for (int o = 1; o < 64; o <<= 1) v = fmaxf(v, __shfl_xor(v, o));
    return v;
}
__device__ __forceinline__ void unpack8(const u32x4 w, float (&f)[8]) {
    f[0] = bflo(w.x); f[1] = bfhi(w.x); f[2] = bflo(w.y); f[3] = bfhi(w.y); f[4] = bflo(w.z); f[5] = bfhi(w.z); f[6] = bflo(w.w); f[7] = bfhi(w.w);
}
__device__ __forceinline__ u32x2 pack8_fp8(const float (&f)[8]) { unsigned a = 0u, c = 0u; a = __builtin_amdgcn_cvt_pk_fp8_f32(f[0], f[1], a, false); a = __builtin_amdgcn_cvt_pk_fp8_f32(f[2], f[3], a, true);
    c = __builtin_amdgcn_cvt_pk_fp8_f32(f[4], f[5], c, false); c = __builtin_amdgcn_cvt_pk_fp8_f32(f[6], f[7], c, true); u32x2 w; w.x = a; w.y = c; return w; }
__device__ __forceinline__ u32x4 pack8(const float (&f)[8]) { u32x4 w; w.x = pk2(f[0], f[1]); w.y = pk2(f[2], f[3]); w.z = pk2(f[4], f[5]); w.w = pk2(f[6], f[7]); return w; }

__device__ __forceinline__ float sum8(const float* q) { const f32x4 a = *(const f32x4*)q, c = *(const f32x4*)(q + 4); return ((a.x + a.y) + (a.z + a.w)) + ((c.x + c.y) + (c.z + c.w)); }

constexpr int TP_LDS = 64 * 257 * 4;
struct TItem { const float* W; int ldw, Nsrc, K; const float* gain; const float* gain2; bf16* WT; int mapkind; int k0, n0; int fp8; float scale; };
__device__ __forceinline__ int map_row(int kind, int n) {
    if (kind == 0) return n;
    if (kind == 1) {
        if (n < 1536) return n;
        if (n < 1544) return 2208 + (n - 1536);
        if (n < 1928) return 1536 + (n - 1544);
        if (n < 2184) return 1920 + (n - 1928);
        return 2176 + (n - 2184);
    }
    return ((n & 1023) >> 7) * 256 + (n >> 10) * 128 + (n & 127);
}
struct TRegs { f32x4 v[8]; };
__device__ __forceinline__ void titem_load(const TItem& it, TRegs& R) {
    const int tid = threadIdx.x;
#pragma unroll
    for (int j = 0; j < 8; ++j) {
        const int kr = (tid >> 6) + 8 * j, n = it.n0 + (tid & 63) * 4, k = it.k0 + kr;
        R.v[j] = (f32x4){0.f, 0.f, 0.f, 0.f};
        if (n < it.Nsrc) R.v[j] = __builtin_nontemporal_load((const f32x4*)(it.W + (size_t)k * it.ldw + n));
    }
}
__device__ __forceinline__ void titem_to_lds(const TItem& it, const TRegs& R, float* Sm) {
    const int tid = threadIdx.x;
#pragma unroll
    for (int j = 0; j < 8; ++j) {
        const int kr = (tid >> 6) + 8 * j, n4 = (tid & 63) * 4, k = it.k0 + kr;
        float g = it.scale;
        if (it.gain) g *= (it.gain2 && k >= 512) ? it.gain2[k - 512] : it.gain[k];
        float* s = Sm + kr * 257 + n4;
        s[0] = R.v[j].x * g; s[1] = R.v[j].y * g; s[2] = R.v[j].z * g; s[3] = R.v[j].w * g;
    }
}
__device__ __forceinline__ void titem_store(const TItem& it, const float* Sm) {
    const int tid = threadIdx.x;
#pragma unroll
    for (int j = 0; j < 4; ++j) {
        const int r = (tid >> 3) + 64 * j, c = tid & 7, n = it.n0 + r;
        if (n < it.Nsrc) {
            const int row = map_row(it.mapkind, n);
            const float* s = Sm + (8 * c) * 257 + r;
            if (it.fp8) { const float f[8] = {s[0], s[257], s[2 * 257], s[3 * 257], s[4 * 257], s[5 * 257], s[6 * 257], s[7 * 257]};
                *(u32x2*)((unsigned char*)it.WT + (size_t)row * it.K + it.k0 + 8 * c) = pack8_fp8(f); }
            else { u32x4 o; o.x = pk2(s[0], s[257]); o.y = pk2(s[2 * 257], s[3 * 257]); o.z = pk2(s[4 * 257], s[5 * 257]); o.w = pk2(s[6 * 257], s[7 * 257]);
            *(u32x4*)(it.WT + (size_t)row * it.K + it.k0 + 8 * c) = o; }
        }
    }
}
constexpr int TI_WIN = 16 * 9, TI_WUQ = 6 * 3, TI_WUKV = 4 * 4, TI_WO = 16 * 4, TI_WMQ = 16 * 2, TI_WMKV = 16 * 4, TI_WMO = 8 * 4, TI_WGU = 32 * 16 * 8, TI_WD = 32 * 16 * 4;
constexpr int TI_TOTAL = TI_WIN + TI_WUQ + TI_WUKV + TI_WO + TI_WMQ + TI_WMKV + TI_WMO + TI_WGU + TI_WD;
__device__ __forceinline__ TItem get_titem(const Params& p, const Bufs& b, int i) {
    TItem t; t.gain2 = nullptr; t.mapkind = 0; t.fp8 = 0; t.scale = 1.f;
    auto fill = [&](const float* W, int ldw, int Nsrc, int K, const float* g, bf16* WT, int li) { const int nn = (Nsrc + 255) / 256; t.W = W; t.ldw = ldw; t.Nsrc = Nsrc; t.K = K; t.gain = g; t.WT = WT; t.k0 = (li / nn) * 64; t.n0 = (li % nn) * 256; };
    if (i < TI_WIN) { fill(p.w_in, 2216, 2216, 1024, p.g_mix, b.WinT, i); t.mapkind = 1; return t; } i -= TI_WIN;
    if (i < TI_WUQ) { fill(p.w_uq, 768, 768, 384, p.g_q_lat, b.WuqT, i); return t; } i -= TI_WUQ;
    if (i < TI_WUKV) { fill(p.w_ukv, 1024, 1024, 256, p.g_kv_lat, b.WukvT, i); return t; } i -= TI_WUKV;
    if (i < TI_WO) { fill(p.w_o, 1024, 1024, 1024, p.g_fox_out, b.WoT, i); t.gain2 = p.g_mla_out; return t; } i -= TI_WO;
    if (i < TI_WMQ) { fill(p.w_mem_q, 512, 512, 1024, p.g_mem_q, b.WmqT, i); return t; } i -= TI_WMQ;
    if (i < TI_WMKV) { fill(p.w_mem_kv, 1024, 1024, 1024, p.g_mem_kv, b.WmkvT, i); return t; } i -= TI_WMKV;
    if (i < TI_WMO) { fill(p.w_mem_o, 1024, 1024, 512, nullptr, b.WmoT, i); return t; } i -= TI_WMO;
    if (i < TI_WGU) { const int e = i / 128; fill(p.w_gate_up + (size_t)e * 1024 * 2048, 2048, 2048, 1024, p.g_ffn, MOE_FP8 ? (bf16*)((unsigned char*)b.WguT + (size_t)e * 2048 * 1024) : b.WguT + (size_t)e * 2048 * 1024, i % 128); t.mapkind = 2; if (MOE_FP8) { t.fp8 = 1; t.scale = W8_SCALE; } return t; } i -= TI_WGU;
    { const int e = i / 64; fill(p.w_down + (size_t)e * 1024 * 1024, 1024, 1024, 1024, nullptr, MOE_FP8 ? (bf16*)((unsigned char*)b.WdT + (size_t)e * 1024 * 1024) : b.WdT + (size_t)e * 1024 * 1024, i % 64); if (MOE_FP8) { t.fp8 = 1; t.scale = W8_SCALE; } return t; }
}
__device__ __forceinline__ void row_to_bf16(const float* xrow, bf16* orow, float* rs_out, int lane) {
    const f32x4* xr = (const f32x4*)xrow + lane;
    f32x4 v[4]; float s = 0.f;
#pragma unroll
    for (int j = 0; j < 4; ++j) { v[j] = xr[64 * j]; s += (v[j].x * v[j].x + v[j].y * v[j].y) + (v[j].z * v[j].z + v[j].w * v[j].w); }
    s = wave_sum(s);
    if (lane == 0) *rs_out = 1.0f / sqrtf(s * (1.0f / 1024.0f) + EPS);
    u32x2* o8 = (u32x2*)orow + lane;
#pragma unroll
    for (int j = 0; j < 4; ++j) { u32x2 w; w.x = pk2(v[j].x, v[j].y); w.y = pk2(v[j].z, v[j].w); o8[64 * j] = w; }
}
constexpr int TI_MOE0 = TI_TOTAL - TI_WGU - TI_WD;
constexpr int FILL1_BLK0 = 96, FILL1_PER = 9, FILL1_N = (256 - FILL1_BLK0) * FILL1_PER;
constexpr int FILL2_BLK0 = 192, FILL2_PER = 0, FILL2_N = (256 - FILL2_BLK0) * FILL2_PER;
constexpr int FILL5_BLK0 = 128, FILL5_PER = 14, FILL5_N = (256 - FILL5_BLK0) * FILL5_PER;
constexpr int TI_FILL = FILL1_N + FILL2_N + FILL5_N, TI_P0 = TI_TOTAL - TI_FILL;
static_assert(TI_FILL <= TI_WGU + TI_WD, "filler items are MoE items");
__device__ __forceinline__ void transpose_run(const Params& p, const Bufs& b, float* Sm, int first, int count, int j, int stride, bool moe = false, bool skipfill = true) {
    auto item_of = [&](int v) { return moe ? TI_MOE0 + v : ((v < TI_MOE0 || !skipfill) ? v : v + TI_FILL); };
    int v = first + j; const int end = first + count; TRegs R0, R1; float* Sm1 = Sm + TP_LDS / 4;
    if (v < end) { const TItem t0 = get_titem(p, b, item_of(v)); titem_load(t0, R0); }
    if (v + stride < end) { const TItem t1 = get_titem(p, b, item_of(v + stride)); titem_load(t1, R1); }
    for (; v < end; v += 2 * stride) {
        { const TItem t = get_titem(p, b, item_of(v));
          titem_to_lds(t, R0, Sm); __syncthreads();
          if (v + 2 * stride < end) { const TItem tn = get_titem(p, b, item_of(v + 2 * stride)); titem_load(tn, R0); }
          titem_store(t, Sm); }
        if (v + stride < end) { const TItem t = get_titem(p, b, item_of(v + stride));
          titem_to_lds(t, R1, Sm1); __syncthreads();
          if (v + 3 * stride < end) { const TItem tn = get_titem(p, b, item_of(v + 3 * stride)); titem_load(tn, R1); }
          titem_store(t, Sm1); }
    }
    __syncthreads();
}
__device__ __forceinline__ void prep_phase(const Params& p, const Bufs& b, unsigned char* lds, int vblock, int nblocks) {
    const int tid = threadIdx.x, lane = tid & 63, wave = tid >> 6;
    float* Sm = (float*)lds;
    if (nblocks == 256) transpose_run(p, b, Sm, 0, TI_P0, vblock, nblocks);
    else transpose_run(p, b, Sm, 0, TI_TOTAL, vblock, nblocks, false, false);
    const int gw = vblock * 8 + wave, ngw = nblocks * 8;
    for (int r = gw; r < T; r += ngw) row_to_bf16(p.x + (size_t)r * D, b.xb + (size_t)r * D, b.rs1 + r, lane);
    for (int r = gw; r < MROWS; r += ngw) row_to_bf16(p.mem + (size_t)r * D, b.memb + (size_t)r * D, b.rsmem + r, lane);
    const int gt = vblock * 512 + tid, ngt = nblocks * 512;
    for (int i = gt; i < S * 16; i += ngt) {
        const int s = i >> 4, j = i & 15; const double inv = pow(10000.0, -(double)j / 16.0), ang = (double)s * inv;
        b.cosT[i] = (float)cos(ang); b.sinT[i] = (float)sin(ang);
    }
    for (int i = gt; i < 1024 * 32; i += ngt) { const int e = i >> 10, k = i & 1023; const float w = p.w_router[k * 32 + e] * p.g_ffn[k]; const unsigned h = f2bf(w);
        ((bf16*)b.wr)[i] = (bf16)h; ((bf16*)b.wr)[32768 + i] = (bf16)f2bf(w - bf2f((unsigned short)h)); }
    for (int i = gt; i < (IN_PAD - 2216) * 1024 / 8; i += ngt) ((u32x4*)(b.WinT + (size_t)2216 * 1024))[i] = (u32x4){0u, 0u, 0u, 0u};
}

struct Unit { int kind, pm, pn, e, m0, rows; };
struct GemmOp { const bf16* A; const int* rowlist; const bf16* B; int K; int khook; };

__device__ __forceinline__ void dense_map(int L, int nM, int nN, int& pm, int& pn) {
    const int nwg = nM * nN; int wgid = L; { const int q = nwg / 8, r = nwg % 8, xcd = wgid % 8, off = wgid / 8; wgid = (xcd < r ? xcd * (q + 1) : r * (q + 1) + (xcd - r) * q) + off; }
    const int nig = 8 * nN, gid = wgid / nig, fm = gid * 8, gsz = (nM - fm) < 8 ? (nM - fm) : 8;
    pm = fm + ((wgid % nig) % gsz); pn = (wgid % nig) / gsz;
}
struct SchedIn {
    static constexpr int NUNITS = 64 * 9 + 8 * 4;
    __device__ __forceinline__ static void get(int i, Unit& u) { if (i < 576) { u.kind = 0; dense_map(i, 64, 9, u.pm, u.pn); } else { i -= 576; u.kind = 1; u.pm = i / 4; u.pn = i % 4; } u.e = 0; u.m0 = 0; u.rows = 256; }
    __device__ __forceinline__ static GemmOp op(const Bufs& b, const Unit& u) {
        GemmOp g; g.rowlist = nullptr; g.K = 1024; g.khook = 0;
        if (u.kind == 0) { g.A = b.xb + (size_t)u.pm * 256 * 1024; g.B = b.WinT + (size_t)u.pn * 256 * 1024; }
        else { g.A = b.memb + (size_t)u.pm * 256 * 1024; g.B = b.WmkvT + (size_t)u.pn * 256 * 1024; }
        return g;
    }
};
struct EpiIn {
    static constexpr bool HOOK = false, PAIRED = false, COLS = false, PREFETCH = true; Params p; Bufs b;
    __device__ __forceinline__ float row_val(const Unit& u, int r) const { const int row = u.pm * 256 + r; return u.kind == 1 ? b.rsmem[row] : b.rs1[row]; }
    template <bool FAST> __device__ __forceinline__ void operator()(const Unit& u, int r, int c, float (&v)[8], float s) const {
        const int row = u.pm * 256 + r, gc = u.pn * 256 + c;
        if (u.kind == 1) {
#pragma unroll
            for (int i = 0; i < 8; ++i) v[i] *= s;
            *(u32x4*)(b.KVm + (size_t)row * 1024 + gc) = pack8(v); return; }
#pragma unroll
        for (int i = 0; i < 8; ++i) v[i] *= s;
        if (gc < 1536) {
            bf16* dst = b.Qf + (size_t)(gc >> 9) * (8u << 20);
            if (gc < 512) {
#pragma unroll
                for (int i = 0; i < 8; ++i) v[i] *= QS_FOX;
            }
            *(u32x4*)(dst + (size_t)row * 512 + (gc & 511)) = pack8(v);
        } else if (gc < 2176) {
            const bool isq = gc < 1920;
            float ss = 0.f;
#pragma unroll
            for (int i = 0; i < 8; ++i) ss += v[i] * v[i];
            if (isq) *(u32x4*)(b.qlat + (size_t)row * 384 + (gc - 1536)) = pack8(v);
            else *(u32x4*)(b.kvlat + (size_t)row * 256 + (gc - 1920)) = pack8(v);
            float* dst = isq ? b.pq + (size_t)row * 12 + ((gc - 1536) >> 5) : b.pkv + (size_t)row * 8 + ((gc - 1920) >> 5);
            if (FAST) { ss += __shfl_xor(ss, 16); ss += __shfl_xor(ss, 32); if ((threadIdx.x & 63) < 16) *dst = ss; }
            else *dst += ss;
        } else if (gc < 2208) {
            float* dst = b.krope + (size_t)row * 32 + (gc - 2176);
            *(f32x4*)dst = (f32x4){v[0], v[1], v[2], v[3]}; *(f32x4*)(dst + 4) = (f32x4){v[4], v[5], v[6], v[7]};
        } else if (gc == 2208) {
            float o[8];
#pragma unroll
            for (int i = 0; i < 8; ++i) { const float z = v[i] + p.b_f[i]; o[i] = fminf(z, 0.f) - logf(1.0f + expf(-fabsf(z))); }
            float* dst = b.logf + (size_t)row * 8;
            *(f32x4*)dst = (f32x4){o[0], o[1], o[2], o[3]}; *(f32x4*)(dst + 4) = (f32x4){o[4], o[5], o[6], o[7]};
        }
    }
};
struct SchedUp {
    static constexpr int NUNITS = 64 * 3 + 64 * 4;
    __device__ __forceinline__ static void get(int i, Unit& u) { if (i < 192) { u.kind = 0; dense_map(i, 64, 3, u.pm, u.pn); } else { i -= 192; u.kind = 1; dense_map(i, 64, 4, u.pm, u.pn); } u.e = 0; u.m0 = 0; u.rows = 256; }
    __device__ __forceinline__ static GemmOp op(const Bufs& b, const Unit& u) {
        GemmOp g; g.rowlist = nullptr; g.khook = 0;
        if (u.kind == 0) { g.K = 384; g.A = b.qlat + (size_t)u.pm * 256 * 384; g.B = b.WuqT + (size_t)u.pn * 256 * 384; }
        else { g.K = 256; g.A = b.kvlat + (size_t)u.pm * 256 * 256; g.B = b.WukvT + (size_t)u.pn * 256 * 256; }
        return g;
    }
};
struct SchedUpQ { static constexpr int NUNITS = 192; __device__ __forceinline__ static void get(int i, Unit& u) { SchedUp::get(i, u); } __device__ __forceinline__ static GemmOp op(const Bufs& b, const Unit& u) { return SchedUp::op(b, u); } };
struct SchedUpKV { static constexpr int NUNITS = 256; __device__ __forceinline__ static void get(int i, Unit& u) { SchedUp::get(192 + i, u); } __device__ __forceinline__ static GemmOp op(const Bufs& b, const Unit& u) { return SchedUp::op(b, u); } };
struct EpiUp {
    static constexpr bool HOOK = false, PAIRED = false, COLS = false, PREFETCH = false; Params p; Bufs b;
    __device__ __forceinline__ float row_val(const Unit& u, int r) const {
        const int row = u.pm * 256 + r; float q = 0.f;
        if (u.kind == 0) {
#pragma unroll
            for (int i = 0; i < 3; ++i) { const f32x4 t = *(const f32x4*)(b.pq + (size_t)row * 12 + 4 * i); q += (t.x + t.y) + (t.z + t.w); }
            return (1.0f / sqrtf(q * (1.0f / 384.0f) + EPS)) * QS_MLA; }
        q = sum8(b.pkv + (size_t)row * 8); return 1.0f / sqrtf(q * (1.0f / 256.0f) + EPS);
    }
    template <bool FAST> __device__ __forceinline__ void operator()(const Unit& u, int r, int c, float (&v)[8], float s) const {
        const int row = u.pm * 256 + r, gc = u.pn * 256 + c;
#pragma unroll
        for (int i = 0; i < 8; ++i) v[i] *= s;
        if (u.kind == 0) *(u32x4*)(b.Qm + (size_t)row * 768 + gc) = pack8(v);
        else { const int h = gc >> 7, w = gc & 127;
            if (w < 64) *(u32x4*)(b.Km + (size_t)row * 768 + h * 96 + w) = pack8(v);
            else *(u32x4*)(b.Vm + (size_t)row * 512 + h * 64 + (w - 64)) = pack8(v); }
    }
};
struct SchedOut {
    static constexpr int NUNITS = 64 * 4;
    __device__ __forceinline__ static void get(int i, Unit& u) { u.kind = 0; dense_map(i, 64, 4, u.pm, u.pn); u.e = 0; u.m0 = 0; u.rows = 256; }
    __device__ __forceinline__ static GemmOp op(const Bufs& b, const Unit& u) { GemmOp g; g.rowlist = nullptr; g.K = 1024; g.khook = 512; g.A = b.Omix + (size_t)u.pm * 256 * 1024; g.B = b.WoT + (size_t)u.pn * 256 * 1024; return g; }
};
__device__ __forceinline__ float rs_of(float ssq, float n) { return 1.0f / sqrtf(ssq / n + EPS); }

struct EpiOut {
    static constexpr bool HOOK = true, PAIRED = false, COLS = false, PREFETCH = false; Params p; Bufs b;
    __device__ __forceinline__ float hook_ratio(const Unit& u, int r) const { const int row = u.pm * 256 + r; return rs_of(sum8(b.pfox + (size_t)row * 8), 512.f) / rs_of(sum8(b.pmla + (size_t)row * 8), 512.f); }
    __device__ __forceinline__ float row_val(const Unit& u, int r) const { return rs_of(sum8(b.pmla + (size_t)(u.pm * 256 + r) * 8), 512.f); }
    template <bool FAST> __device__ __forceinline__ void operator()(const Unit& u, int r, int c, float (&v)[8], float s) const {
        const int row = u.pm * 256 + r, gc = u.pn * 256 + c;
        const float* xr = p.x + (size_t)row * D + gc; const f32x4 x0 = *(const f32x4*)xr, x1 = *(const f32x4*)(xr + 4);
        v[0] = x0.x + v[0] * s; v[1] = x0.y + v[1] * s; v[2] = x0.z + v[2] * s; v[3] = x0.w + v[3] * s;
        v[4] = x1.x + v[4] * s; v[5] = x1.y + v[5] * s; v[6] = x1.z + v[6] * s; v[7] = x1.w + v[7] * s;
        float ss = 0.f;
#pragma unroll
        for (int i = 0; i < 8; ++i) ss += v[i] * v[i];
        *(u32x4*)(b.h1 + (size_t)row * D + gc) = pack8(v);
        float* dst = b.p2 + (size_t)row * 32 + (gc >> 5);
        if (FAST) { ss += __shfl_xor(ss, 16); ss += __shfl_xor(ss, 32); if ((threadIdx.x & 63) < 16) *dst = ss; }
        else *dst += ss;
    }
};
struct SchedMq {
    static constexpr int NUNITS = 64 * 2;
    __device__ __forceinline__ static void get(int i, Unit& u) { u.kind = 0; dense_map(i, 64, 2, u.pm, u.pn); u.e = 0; u.m0 = 0; u.rows = 256; }
    __device__ __forceinline__ static GemmOp op(const Bufs& b, const Unit& u) { GemmOp g; g.rowlist = nullptr; g.K = 1024; g.khook = 0; g.A = b.h1 + (size_t)u.pm * 256 * 1024; g.B = b.WmqT + (size_t)u.pn * 256 * 1024; return g; }
};
struct EpiMq {
    static constexpr bool HOOK = false, PAIRED = false, COLS = false, PREFETCH = false; Params p; Bufs b;
    __device__ __forceinline__ float row_val(const Unit& u, int r) const { const int row = u.pm * 256 + r; float q = 0.f;
#pragma unroll
        for (int i = 0; i < 4; ++i) q += sum8(b.p2 + (size_t)row * 32 + 8 * i);
        return rs_of(q, 1024.f) * QS_MEM; }
    template <bool FAST> __device__ __forceinline__ void operator()(const Unit& u, int r, int c, float (&v)[8], float s) const {
        const int row = u.pm * 256 + r, gc = u.pn * 256 + c;
#pragma unroll
        for (int i = 0; i < 8; ++i) v[i] *= s;
        *(u32x4*)(b.Qmem + (size_t)row * 512 + gc) = pack8(v);
    }
};
struct SchedMo {
    static constexpr int NUNITS = 64 * 4;
    __device__ __forceinline__ static void get(int i, Unit& u) { u.kind = 0; dense_map(i, 64, 4, u.pm, u.pn); u.e = 0; u.m0 = 0; u.rows = 256; }
    __device__ __forceinline__ static GemmOp op(const Bufs& b, const Unit& u) { GemmOp g; g.rowlist = nullptr; g.K = 512; g.khook = 0; g.A = b.Omem + (size_t)u.pm * 256 * 512; g.B = b.WmoT + (size_t)u.pn * 256 * 512; return g; }
};
struct EpiMo {
    static constexpr bool HOOK = false, PAIRED = false, COLS = false, PREFETCH = false; Params p; Bufs b;
    __device__ __forceinline__ float row_val(const Unit&, int) const { return 0.f; }
    template <bool FAST> __device__ __forceinline__ void operator()(const Unit& u, int r, int c, float (&v)[8], float) const {
        const int row = u.pm * 256 + r, gc = u.pn * 256 + c; float h[8]; unpack8(*(const u32x4*)(b.h1 + (size_t)row * D + gc), h);
#pragma unroll
        for (int i = 0; i < 8; ++i) v[i] += h[i];
        *(u32x4*)(b.h2 + (size_t)row * D + gc) = pack8(v);
        if (MOE_FP8) *(u32x2*)(b.h2q + (size_t)row * D + gc) = pack8_fp8(v);
    }
};
#define LAS __attribute__((address_space(3)))
struct MoeTabL { int ntile[32]; int cumT[33]; int off[33]; };
__device__ __forceinline__ void moe_unit(const int* cnt, int npn, int i, Unit& u, int& valid) {
    int base = 0; valid = 0;
    for (int e = 0; e < NE; ++e) { const int c = cnt[e], nt = (c + 255) >> 8, nu = nt * npn; if (i < base + nu) { const int l = i - base; u.kind = 0; u.e = e; u.pn = l / nt; u.pm = l % nt; u.m0 = u.pm * 256; u.rows = min(256, c - u.m0); valid = 1; return; } base += nu; }
}
__device__ __forceinline__ int moe_off(const int* cnt, int e) { int o = 0; for (int i = 0; i < e; ++i) o += cnt[i]; return o; }
struct EpiG1 {
    static constexpr bool HOOK = false, PAIRED = true, PREFETCH = true; Params p; Bufs b; LAS MoeTabL* tab; int off_fixed;
    __device__ __forceinline__ float row_val(const Unit& u, int r) const { return b.rsl[u.e * LCAP + u.m0 + r] * (MOE_FP8 ? 1.0f / W8_SCALE : 1.0f); }
    __device__ __forceinline__ void col_vals(const Unit& u, int c, float (&bg)[8], float (&bu)[8]) const {
        const float* q = p.b_gate_up + (size_t)u.e * 2048 + u.pn * 128 + c; const f32x4 a0 = *(const f32x4*)q, a1 = *(const f32x4*)(q + 4), u0 = *(const f32x4*)(q + 1024), u1 = *(const f32x4*)(q + 1028);
#pragma unroll
        for (int i = 0; i < 4; ++i) { bg[i] = a0[i]; bg[4 + i] = a1[i]; bu[i] = u0[i]; bu[4 + i] = u1[i]; } }
    __device__ __forceinline__ void pair(const Unit& u, int r, int c, float (&vg)[8], float (&vu)[8], float rsw, const float (&bg)[8], const float (&bu)[8]) const {
        typedef float f2 __attribute__((ext_vector_type(2)));
        const int off_e = tab->off[u.e], col = u.pn * 128 + c;
        constexpr float OS = MOE_FP8 ? ACT8_SCALE : 1.0f;
        float o[8];
#pragma unroll
        for (int i = 0; i < 8; i += 2) {
            f2 g = (f2){vg[i], vg[i + 1]} * rsw + (f2){bg[i], bg[i + 1]}, uu = (f2){vu[i], vu[i + 1]} * rsw + (f2){bu[i], bu[i + 1]};
            g.x = fminf(g.x, 7.0f); g.y = fminf(g.y, 7.0f); uu.x = fminf(fmaxf(uu.x, -7.0f), 7.0f); uu.y = fminf(fmaxf(uu.y, -7.0f), 7.0f);
            const f2 a = g * (-1.702f * LOG2E); f2 e; e.x = __builtin_amdgcn_exp2f(a.x); e.y = __builtin_amdgcn_exp2f(a.y);
            const f2 d = e + 1.0f; f2 sg; sg.x = __builtin_amdgcn_rcpf(d.x); sg.y = __builtin_amdgcn_rcpf(d.y);
            const f2 res = (g * sg) * (uu * OS + OS);
            o[i] = res.x; o[i + 1] = res.y; }
        if (r < u.rows) {
            if (MOE_FP8) *(u32x2*)((unsigned char*)b.act + (size_t)(off_e + u.m0 + r) * 1024 + col) = pack8_fp8(o);
            else *(u32x4*)(b.act + (size_t)(off_e + u.m0 + r) * 1024 + col) = pack8(o); }
    }
};
struct EpiG2 {
    static constexpr bool HOOK = false, PAIRED = false, COLS = true, PREFETCH = true; Params p; Bufs b; LAS MoeTabL* tab; int off_fixed;
    __device__ __forceinline__ float row_val(const Unit& u, int r) const { return b.gatev[u.e * LCAP + u.m0 + r]; }
    __device__ __forceinline__ void col_vals(const Unit& u, int c, float (&bd)[8]) const {
        const float* q = p.b_down + (size_t)u.e * 1024 + u.pn * 256 + c; const f32x4 a0 = *(const f32x4*)q, a1 = *(const f32x4*)(q + 4);
#pragma unroll
        for (int i = 0; i < 4; ++i) { bd[i] = a0[i]; bd[4 + i] = a1[i]; } }
    template <bool FAST> __device__ __forceinline__ void operator()(const Unit& u, int r, int c, float (&v)[8], float gw, const float (&bd)[8]) const {
        const int off_e = tab->off[u.e], col = u.pn * 256 + c;
        const float sc = MOE_FP8 ? 1.0f / (W8_SCALE * ACT8_SCALE) : 1.0f;
#pragma unroll
        for (int i = 0; i < 8; ++i) v[i] = (v[i] * sc + bd[i]) * (gw * (MOE_FP8 ? YP8_SCALE : 1.0f));
        if (r < u.rows) { if (MOE_FP8) *(u32x2*)((unsigned char*)b.yp + (size_t)(off_e + u.m0 + r) * 1024 + col) = pack8_fp8(v); else *(u32x4*)(b.yp + (size_t)(off_e + u.m0 + r) * 1024 + col) = pack8(v); }
    }
};

__device__ __forceinline__ void kpe_task(const Bufs& b, int gt, int ngt) {
    for (int i = gt; i < T * 8; i += ngt) {
        const int row = i >> 3, h = i & 7, pos = row & (S - 1);
        const float* kr = b.krope + (size_t)row * 32; const float* cs = b.cosT + pos * 16; const float* sn = b.sinT + pos * 16;
        float y1[16], y2[16];
#pragma unroll
        for (int q = 0; q < 4; ++q) { const f32x4 x1 = *(const f32x4*)(kr + 4 * q), x2 = *(const f32x4*)(kr + 16 + 4 * q), c = *(const f32x4*)(cs + 4 * q), sv = *(const f32x4*)(sn + 4 * q);
#pragma unroll
            for (int j = 0; j < 4; ++j) { y1[4 * q + j] = x1[j] * c[j] - x2[j] * sv[j]; y2[4 * q + j] = x2[j] * c[j] + x1[j] * sv[j]; } }
        u32x4* dst = (u32x4*)(b.Km + (size_t)row * 768 + h * 96 + 64);
        dst[0] = (u32x4){pk2(y1[0], y1[1]), pk2(y1[2], y1[3]), pk2(y1[4], y1[5]), pk2(y1[6], y1[7])}; dst[1] = (u32x4){pk2(y1[8], y1[9]), pk2(y1[10], y1[11]), pk2(y1[12], y1[13]), pk2(y1[14], y1[15])};
        dst[2] = (u32x4){pk2(y2[0], y2[1]), pk2(y2[2], y2[3]), pk2(y2[4], y2[5]), pk2(y2[6], y2[7])}; dst[3] = (u32x4){pk2(y2[8], y2[9]), pk2(y2[10], y2[11]), pk2(y2[12], y2[13]), pk2(y2[14], y2[15])};
    }
}
__device__ __forceinline__ void scan_task(const Bufs& b, int gw, int ngw, int lane) {
    for (int q = gw; q < NB * 8; q += ngw) {
        const int bb = q >> 3, h = q & 7; const float* src = b.logf + (size_t)(bb * S + lane * 32) * 8 + h;
        float v[32];
#pragma unroll
        for (int i = 0; i < 32; ++i) v[i] = src[i * 8];
#pragma unroll
        for (int i = 1; i < 32; ++i) v[i] += v[i - 1];
        float tot = v[31], ex = tot;
#pragma unroll
        for (int o = 1; o < 64; o <<= 1) { const float t = __shfl_up(ex, o); if (lane >= o) ex += t; }
        ex -= tot;
        f32x4* dst = (f32x4*)(b.cdec + (size_t)q * S + lane * 32);
#pragma unroll
        for (int i = 0; i < 8; ++i) dst[i] = (f32x4){(ex + v[4 * i]) * LOG2E, (ex + v[4 * i + 1]) * LOG2E, (ex + v[4 * i + 2]) * LOG2E, (ex + v[4 * i + 3]) * LOG2E};
    }
}
__device__ __forceinline__ void final_token(const Params& p, const Bufs& b, int tok, int lane, const int* offs  ) {
    float v[16];
#pragma unroll
    for (int hf = 0; hf < 2; ++hf) { float a[8]; unpack8(*(const u32x4*)(b.h2 + (size_t)tok * D + hf * 512 + lane * 8), a);
#pragma unroll
        for (int i = 0; i < 8; ++i) v[hf * 8 + i] = a[i]; }
#pragma unroll
    for (int k = 0; k < 4; ++k) { const int e = b.toke[tok * 4 + k], slot = offs[e] + b.tokp[tok * 4 + k];
#pragma unroll
        for (int hf = 0; hf < 2; ++hf) {
            if (MOE_FP8) { const u32x2 w = *(const u32x2*)((const unsigned char*)b.yp + (size_t)slot * D + hf * 512 + lane * 8);
                const auto f0 = __builtin_amdgcn_cvt_pk_f32_fp8(w.x, false), f1 = __builtin_amdgcn_cvt_pk_f32_fp8(w.x, true), f2 = __builtin_amdgcn_cvt_pk_f32_fp8(w.y, false), f3 = __builtin_amdgcn_cvt_pk_f32_fp8(w.y, true);
                v[hf * 8 + 0] += f0[0] * (1.0f / YP8_SCALE); v[hf * 8 + 1] += f0[1] * (1.0f / YP8_SCALE); v[hf * 8 + 2] += f1[0] * (1.0f / YP8_SCALE); v[hf * 8 + 3] += f1[1] * (1.0f / YP8_SCALE);
                v[hf * 8 + 4] += f2[0] * (1.0f / YP8_SCALE); v[hf * 8 + 5] += f2[1] * (1.0f / YP8_SCALE); v[hf * 8 + 6] += f3[0] * (1.0f / YP8_SCALE); v[hf * 8 + 7] += f3[1] * (1.0f / YP8_SCALE); }
            else { float a[8]; unpack8(*(const u32x4*)(b.yp + (size_t)slot * D + hf * 512 + lane * 8), a);
#pragma unroll
                for (int i = 0; i < 8; ++i) v[hf * 8 + i] += a[i]; } } }
    float ss = 0.f;
#pragma unroll
    for (int i = 0; i < 16; ++i) ss += v[i] * v[i];
    ss = wave_sum(ss);
    const float rs = 1.0f / sqrtf(ss * (1.0f / 1024.0f) + EPS);
#pragma unroll
    for (int hf = 0; hf < 2; ++hf) { const float* g = p.g_final + hf * 512 + lane * 8; float* o = p.out + (size_t)tok * D + hf * 512 + lane * 8;
        const f32x4 g0 = *(const f32x4*)g, g1 = *(const f32x4*)(g + 4);
        *(f32x4*)o = (f32x4){v[hf * 8 + 0] * rs * g0.x, v[hf * 8 + 1] * rs * g0.y, v[hf * 8 + 2] * rs * g0.z, v[hf * 8 + 3] * rs * g0.w};
        *(f32x4*)(o + 4) = (f32x4){v[hf * 8 + 4] * rs * g1.x, v[hf * 8 + 5] * rs * g1.y, v[hf * 8 + 6] * rs * g1.z, v[hf * 8 + 7] * rs * g1.w}; }
}
template <int NB>
__device__ __forceinline__ void final_tokens(const Params& p, const Bufs& b, int tok0, int tstride, int lane, const int* offs  ) {
    static_assert(MOE_FP8, "batched final pass reads the fp8 expert outputs");
    int sl[NB][4];
#pragma unroll
    for (int i = 0; i < NB; ++i)
#pragma unroll
        for (int k = 0; k < 4; ++k) { const int tok = tok0 + i * tstride; sl[i][k] = offs[b.toke[tok * 4 + k]] + b.tokp[tok * 4 + k]; }
    u32x4 hr[NB][2]; u32x2 yr[NB][4][2];
#pragma unroll
    for (int i = 0; i < NB; ++i) { const int tok = tok0 + i * tstride;
#pragma unroll
        for (int hf = 0; hf < 2; ++hf) { hr[i][hf] = *(const u32x4*)(b.h2 + (size_t)tok * D + hf * 512 + lane * 8);
#pragma unroll
            for (int k = 0; k < 4; ++k) yr[i][k][hf] = *(const u32x2*)((const unsigned char*)b.yp + (size_t)sl[i][k] * D + hf * 512 + lane * 8); } }
#pragma unroll
    for (int i = 0; i < NB; ++i) { const int tok = tok0 + i * tstride;
        float v[16];
#pragma unroll
        for (int hf = 0; hf < 2; ++hf) { float a[8]; unpack8(hr[i][hf], a);
#pragma unroll
            for (int j = 0; j < 8; ++j) v[hf * 8 + j] = a[j];
#pragma unroll
            for (int k = 0; k < 4; ++k) { const u32x2 w = yr[i][k][hf];
                const auto f0 = __builtin_amdgcn_cvt_pk_f32_fp8(w.x, false), f1 = __builtin_amdgcn_cvt_pk_f32_fp8(w.x, true), f2 = __builtin_amdgcn_cvt_pk_f32_fp8(w.y, false), f3 = __builtin_amdgcn_cvt_pk_f32_fp8(w.y, true);
                v[hf * 8 + 0] += f0[0] * (1.0f / YP8_SCALE); v[hf * 8 + 1] += f0[1] * (1.0f / YP8_SCALE); v[hf * 8 + 2] += f1[0] * (1.0f / YP8_SCALE); v[hf * 8 + 3] += f1[1] * (1.0f / YP8_SCALE);
                v[hf * 8 + 4] += f2[0] * (1.0f / YP8_SCALE); v[hf * 8 + 5] += f2[1] * (1.0f / YP8_SCALE); v[hf * 8 + 6] += f3[0] * (1.0f / YP8_SCALE); v[hf * 8 + 7] += f3[1] * (1.0f / YP8_SCALE); } }
        float ss = 0.f;
#pragma unroll
        for (int j = 0; j < 16; ++j) ss += v[j] * v[j];
        ss = wave_sum(ss);
        const float rs = 1.0f / sqrtf(ss * (1.0f / 1024.0f) + EPS);
#pragma unroll
        for (int hf = 0; hf < 2; ++hf) { const float* g = p.g_final + hf * 512 + lane * 8; float* o = p.out + (size_t)tok * D + hf * 512 + lane * 8;
            const f32x4 g0 = *(const f32x4*)g, g1 = *(const f32x4*)(g + 4);
            *(f32x4*)o = (f32x4){v[hf * 8 + 0] * rs * g0.x, v[hf * 8 + 1] * rs * g0.y, v[hf * 8 + 2] * rs * g0.z, v[hf * 8 + 3] * rs * g0.w};
            *(f32x4*)(o + 4) = (f32x4){v[hf * 8 + 4] * rs * g1.x, v[hf * 8 + 5] * rs * g1.y, v[hf * 8 + 6] * rs * g1.z, v[hf * 8 + 7] * rs * g1.w}; }
    }
}
typedef short bf16x8 __attribute__((ext_vector_type(8)));
typedef int v4i_t __attribute__((ext_vector_type(4)));
typedef int v8i_t __attribute__((ext_vector_type(8)));
namespace pg8 {
constexpr int BM = 256, BK = 64, HALF = 128, HTB = HALF * BK * 2, STAGE_BYTES = 8 * HTB;
__host__ __device__ __forceinline__ int lds_byte(int r, int c) { const int st = (r >> 4) * 2 + (c >> 5), rr = r & 15, cc = c & 31, ob = rr * 64 + cc * 2; return st * 1024 + (ob ^ (((ob >> 9) & 1) << 5)); }
__host__ __device__ __forceinline__ void stage_rc(int b, int& R, int& C) { const int st = b / 1024, sb = b % 1024, swz = sb ^ (((sb >> 9) & 1) << 5); R = (st >> 1) * 16 + swz / 64; C = (st & 1) * 32 + (swz % 64) / 2; }
__host__ __device__ __forceinline__ int perm32(int rho) { const int n = rho >> 4, i = rho & 15; return 8 * (i >> 2) + 4 * n + (i & 3); }

template <class Sched, class Epi>
__device__ __forceinline__ void gemm_phase(LAS unsigned char* lds, const unsigned char* ws, const Sched& S, const Epi& E) {
    const int tid = threadIdx.x, wid = __builtin_amdgcn_readfirstlane(tid >> 6), lane = tid & 63, wr = wid >> 2, wc = wid & 3, fr = lane & 15, fq = lane >> 4;
    int RA[2], CA[2], RB[2];
#pragma unroll
    for (int i = 0; i < 2; ++i) { int R, C; stage_rc(tid * 16 + i * 8192, R, C); RA[i] = R; CA[i] = C; RB[i] = (R & ~31) + perm32(R & 31); }
    const unsigned ldsw = (unsigned)wid * 1024u;
    const __amdgpu_buffer_rsrc_t wsrc = __builtin_amdgcn_make_buffer_rsrc((void*)ws, 0, 0x7ffffffe, 0x00020000);
    constexpr bool F8 = Sched::FP8; constexpr int EB = F8 ? 1 : 2;
    const int aoff = lds_byte(wr * 64 + fr, fq * 8), boff = lds_byte(wc * 32 + fr, fq * 8);
    int boffB = boff + 4 * HTB; asm volatile("" : "+v"(boffB));
#define PG8_SA(b, h) (((b) * 2 + (h)) * HTB)
#define PG8_SB(b, h) ((4 + (b) * 2 + (h)) * HTB)
#define PG8_SBR(b, h) (((b) * 2 + (h)) * HTB)
#define PG8_STAGE(bufoff, soff, v0, v1) do { \
        __builtin_amdgcn_raw_ptr_buffer_load_lds(wsrc, (LAS void*)(lds + (bufoff) + ldsw), 16, (int)(v0), (int)(soff), 0, 0); \
        __builtin_amdgcn_raw_ptr_buffer_load_lds(wsrc, (LAS void*)(lds + (bufoff) + ldsw + 8192), 16, (int)(v1), (int)(soff), 0, 0); } while (0)
#define PG8_LD16(off) (*(const LAS v4i_t*)(lds + (off)))
#define PG8_LDA(dst, b, h) do { _Pragma("unroll") for (int m = 0; m < 4; ++m) { if constexpr (F8) dst##8[m] = __builtin_shufflevector(PG8_LD16(PG8_SA(b, h) + aoff + m * 2048), PG8_LD16(PG8_SA(b, h) + aoff + m * 2048 + 1024), 0, 1, 2, 3, 4, 5, 6, 7); \
        else { _Pragma("unroll") for (int k = 0; k < 2; ++k) dst[m][k] = *(const LAS bf16x8*)(lds + PG8_SA(b, h) + aoff + m * 2048 + k * 1024); } } } while (0)
#define PG8_LDB(dst, b, h) do { _Pragma("unroll") for (int n = 0; n < 2; ++n) { if constexpr (F8) dst##8[n] = __builtin_shufflevector(PG8_LD16(boffB + PG8_SBR(b, h) + n * 2048), PG8_LD16(boffB + PG8_SBR(b, h) + n * 2048 + 1024), 0, 1, 2, 3, 4, 5, 6, 7); \
        else { _Pragma("unroll") for (int k = 0; k < 2; ++k) dst[n][k] = *(const LAS bf16x8*)(lds + boffB + PG8_SBR(b, h) + n * 2048 + k * 1024); } } } while (0)
#define PG8_CAT(x, y) __builtin_shufflevector(__builtin_bit_cast(v4i_t, x), __builtin_bit_cast(v4i_t, y), 0, 1, 2, 3, 4, 5, 6, 7)
#define PG8_MMA(ai, bj, At, Bt) do { __builtin_amdgcn_s_setprio(1); _Pragma("unroll") for (int m = 0; m < 4; ++m) _Pragma("unroll") for (int n = 0; n < 2; ++n) { \
        if constexpr (F8) asm volatile("v_mfma_scale_f32_16x16x128_f8f6f4 %0, %1, %2, %0, %3, %3 op_sel_hi:[0,0,0]" : "+v"(acc[ai][bj][m][n]) : "v"(Bt##8[n]), "v"(At##8[m]), "v"(sc1));   \
        else { _Pragma("unroll") for (int k = 0; k < 2; ++k) acc[ai][bj][m][n] = __builtin_amdgcn_mfma_f32_16x16x32_bf16(Bt[n][k], At[m][k], acc[ai][bj][m][n], 0, 0, 0); } } \
        __builtin_amdgcn_s_setprio(0); } while (0)
#define PG8_EPI_LOADS do { int rb_ = wr * 64 + fr, cb_ = wc * 32 + 8 * fq; asm volatile("" : "+v"(rb_), "+v"(cb_)); \
        _Pragma("unroll") for (int ai = 0; ai < 2; ++ai) _Pragma("unroll") for (int m = 0; m < 4; ++m) rv[ai][m] = E.row_val(cur, ai * HALF + m * 16 + rb_); \
        if constexpr (Epi::PAIRED) E.col_vals(cur, cb_, cv0, cv1); else if constexpr (Epi::COLS) { E.col_vals(cur, cb_, cv0); E.col_vals(cur, HALF + cb_, cv1); } } while (0)
#define PG8_WAIT_V(n) asm volatile("s_waitcnt vmcnt(" #n ")" ::: "memory")
#define PG8_WAIT_L(n) asm volatile("s_waitcnt lgkmcnt(" #n ")" ::: "memory")
#define PG8_BAR __builtin_amdgcn_s_barrier()
#define PG8_SCHED __builtin_amdgcn_sched_barrier(0)
    Unit cur, nxt; int ui = 0;
    if (!S.next(0, cur)) return;
    f32x4 acc[2][2][4][2];
#pragma unroll
    for (int a = 0; a < 2; ++a)
#pragma unroll
        for (int b = 0; b < 2; ++b)
#pragma unroll
            for (int m = 0; m < 4; ++m)
#pragma unroll
                for (int n = 0; n < 2; ++n) acc[a][b][m][n] = (f32x4){0.f, 0.f, 0.f, 0.f};
    int sc1 = 0x7f7f7f7f; asm volatile("" : "+v"(sc1));
    bf16x8 At[4][2], B0[2][2], B1[2][2]; v8i_t At8[4], B08[2], B18[2];
    const int K = S.K, nt = K * EB / 128, khook_t = S.khook ? S.khook / BK : -1;
    const unsigned vB0 = (unsigned)(RB[0] * K * EB + CA[0] * 2), vB1 = (unsigned)(RB[1] * K * EB + CA[1] * 2);
    const unsigned hstep = (unsigned)(HALF * K * EB);
    constexpr unsigned kstep = (unsigned)(BK * 2);
    unsigned cA, cB, nA, nB;
    unsigned vA00 = (unsigned)(RA[0] * K * EB + CA[0] * 2), vA01 = (unsigned)(RA[1] * K * EB + CA[1] * 2), vA10 = vA00 + (unsigned)hstep, vA11 = vA01 + (unsigned)hstep;
    unsigned nvA00 = vA00, nvA01 = vA01, nvA10 = vA10, nvA11 = vA11;
#define PG8_SETUP(u, pA, pB, a00, a01, a10, a11) do { const GemmOp g_ = S.op(u); pA = (unsigned)((const unsigned char*)g_.A - ws); pB = (unsigned)((const unsigned char*)g_.B - ws); \
        if constexpr (Sched::GATHER) { const int mx_ = (u).rows - 1; const int r00 = g_.rowlist[min(RA[0], mx_)], r01 = g_.rowlist[min(RA[1], mx_)], r10 = g_.rowlist[min(HALF + RA[0], mx_)], r11 = g_.rowlist[min(HALF + RA[1], mx_)]; \
            a00 = (unsigned)(r00 * K * EB + CA[0] * 2); a01 = (unsigned)(r01 * K * EB + CA[1] * 2); a10 = (unsigned)(r10 * K * EB + CA[0] * 2); a11 = (unsigned)(r11 * K * EB + CA[1] * 2); } } while (0)
    PG8_SETUP(cur, cA, cB, vA00, vA01, vA10, vA11);
    PG8_STAGE(PG8_SB(0, 0), cB, vB0, vB1); PG8_STAGE(PG8_SB(0, 1), cB + hstep, vB0, vB1); PG8_STAGE(PG8_SA(0, 0), cA, vA00, vA01); PG8_STAGE(PG8_SA(0, 1), cA, vA10, vA11);
    if (wr == 1) PG8_BAR;
    PG8_WAIT_V(2); PG8_BAR;
    PG8_STAGE(PG8_SB(1, 0), cB + kstep, vB0, vB1); PG8_STAGE(PG8_SA(1, 0), cA + kstep, vA00, vA01); PG8_STAGE(PG8_SB(1, 1), cB + hstep + kstep, vB0, vB1);
    PG8_WAIT_V(6); PG8_BAR;
    for (;;) {
        const bool has_next = S.next(ui + 1, nxt);
        float rv[2][4], cv0[8], cv1[8];
        if (has_next) PG8_SETUP(nxt, nA, nB, nvA00, nvA01, nvA10, nvA11);
        else { nA = cA; nB = cB; if constexpr (Sched::GATHER) { nvA00 = vA00; nvA01 = vA01; nvA10 = vA10; nvA11 = vA11; } }
#pragma clang loop unroll(disable)
        for (int t = 0; t < nt; t += 2) {
            const bool last = (t == nt - 2);
            if constexpr (Epi::HOOK) { if (t == khook_t) { int rbh = wr * 64 + fr; asm volatile("" : "+v"(rbh));
#pragma unroll
                for (int ai = 0; ai < 2; ++ai)
#pragma unroll
                    for (int m = 0; m < 4; ++m) { const int rh = ai * HALF + m * 16 + rbh; const float rt = E.hook_ratio(cur, rh);
#pragma unroll
                        for (int bj = 0; bj < 2; ++bj)
#pragma unroll
                            for (int n = 0; n < 2; ++n) acc[ai][bj][m][n] = acc[ai][bj][m][n] * rt;
                        asm volatile("" ::: "memory"); } } }
            const unsigned a1 = cA + (unsigned)(t + 1) * kstep;
            const unsigned a2 = last ? nA : cA + (unsigned)(t + 2) * kstep, b2 = last ? nB : cB + (unsigned)(t + 2) * kstep;
            const unsigned a3 = a2 + kstep, b3 = b2 + kstep;
            PG8_LDB(B0, 0, 0); PG8_LDB(B1, 0, 1); PG8_SCHED; PG8_LDA(At, 0, 0); PG8_STAGE(PG8_SA(1, 1), a1, vA10, vA11);
            if constexpr (Sched::GATHER) { if (last) { vA00 = nvA00; vA01 = nvA01; vA10 = nvA10; vA11 = nvA11; } }
            PG8_WAIT_V(8); PG8_WAIT_L(0); PG8_BAR; PG8_MMA(0, 0, At, B0); PG8_MMA(0, 1, At, B1); PG8_BAR; PG8_SCHED;
            PG8_LDA(At, 0, 1); PG8_STAGE(PG8_SB(0, 0), b2, vB0, vB1); PG8_STAGE(PG8_SB(0, 1), b2 + hstep, vB0, vB1); PG8_STAGE(PG8_SA(0, 0), a2, vA00, vA01);
            PG8_WAIT_V(8); PG8_WAIT_L(0); PG8_BAR; PG8_MMA(1, 0, At, B0); PG8_MMA(1, 1, At, B1); PG8_BAR; PG8_SCHED;
            PG8_LDB(B0, 1, 0); PG8_LDB(B1, 1, 1); PG8_SCHED; PG8_LDA(At, 1, 0); PG8_STAGE(PG8_SA(0, 1), a2, vA10, vA11);
            PG8_WAIT_V(8); PG8_WAIT_L(0); PG8_BAR; PG8_MMA(0, 0, At, B0); PG8_MMA(0, 1, At, B1); PG8_BAR; PG8_SCHED;
            PG8_LDA(At, 1, 1); PG8_STAGE(PG8_SB(1, 0), b3, vB0, vB1); PG8_STAGE(PG8_SB(1, 1), b3 + hstep, vB0, vB1); PG8_STAGE(PG8_SA(1, 0), a3, vA00, vA01);
            PG8_WAIT_V(8); PG8_WAIT_L(0); PG8_BAR;
            if constexpr (Epi::PREFETCH) { if (last) { PG8_EPI_LOADS; asm volatile("" ::: "memory"); } }
            PG8_MMA(1, 0, At, B0); PG8_MMA(1, 1, At, B1); PG8_BAR; PG8_SCHED;
        }
        if constexpr (F8) asm volatile("s_nop 15\n\ts_nop 15" ::: "memory");
        if (wr == 0) PG8_BAR;
        int rbase = wr * 64 + fr, cbase = wc * 32 + 8 * fq; asm volatile("" : "+v"(rbase), "+v"(cbase));
        if constexpr (!Epi::PREFETCH) PG8_EPI_LOADS;
#pragma unroll
        for (int ai = 0; ai < 2; ++ai)
#pragma unroll
            for (int m = 0; m < 4; ++m) {
                const int r = ai * HALF + m * 16 + rbase;
                if constexpr (Epi::PAIRED) {
                    float vg[8], vu[8];
#pragma unroll
                    for (int j = 0; j < 4; ++j) { vg[j] = acc[ai][0][m][0][j]; vg[4 + j] = acc[ai][0][m][1][j]; vu[j] = acc[ai][1][m][0][j]; vu[4 + j] = acc[ai][1][m][1][j]; }
                    E.pair(cur, r, cbase, vg, vu, rv[ai][m], cv0, cv1);
                } else {
#pragma unroll
                    for (int bj = 0; bj < 2; ++bj) { float v[8];
#pragma unroll
                        for (int j = 0; j < 4; ++j) { v[j] = acc[ai][bj][m][0][j]; v[4 + j] = acc[ai][bj][m][1][j]; }
                        if constexpr (Epi::COLS) { if (bj == 0) E.template operator()<true>(cur, r, cbase, v, rv[ai][m], cv0); else E.template operator()<true>(cur, r, HALF + cbase, v, rv[ai][m], cv1); }
                        else E.template operator()<true>(cur, r, bj * HALF + cbase, v, rv[ai][m]); }
                }
                if constexpr (Epi::HOOK) asm volatile("" ::: "memory");
            }
        if (!has_next) break;
#pragma unroll
        for (int a = 0; a < 2; ++a)
#pragma unroll
            for (int b = 0; b < 2; ++b)
#pragma unroll
                for (int m = 0; m < 4; ++m)
#pragma unroll
                    for (int n = 0; n < 2; ++n) acc[a][b][m][n] = (f32x4){0.f, 0.f, 0.f, 0.f};
        cur = nxt; cA = nA; cB = nB; ++ui;
        if (wr == 1) PG8_BAR;
    }
    PG8_WAIT_V(0);
    PG8_BAR;
#undef PG8_SA
#undef PG8_SB
#undef PG8_SBR
#undef PG8_STAGE
#undef PG8_LDA
#undef PG8_LDB
#undef PG8_MMA
#undef PG8_CAT
#undef PG8_LD16
#undef PG8_WAIT_V
#undef PG8_EPI_LOADS
#undef PG8_WAIT_L
#undef PG8_BAR
#undef PG8_SCHED
#undef PG8_SETUP
}
}

typedef float f32x16 __attribute__((ext_vector_type(16)));
typedef short s16x4 __attribute__((ext_vector_type(4)));
__device__ __forceinline__ unsigned cvtpk(float lo, float hi) { f32x2_t v = {lo, hi}; bf16x2_t b = __builtin_convertvector(v, bf16x2_t); return __builtin_bit_cast(unsigned, b); }
__device__ __forceinline__ int crow(int r, int hi) { return (r & 3) + 8 * (r >> 2) + 4 * hi; }
struct AttnPtrs { const bf16* Q; int ldq; const bf16* K; int ldk; const bf16* V; int ldv; bf16* O; int ldo; float* part; int pstride; const float* cd; const float* cosT; const float* sinT; };
__device__ __forceinline__ void glds16(const void* gsrc, unsigned lds_dst) { unsigned keep;
    asm volatile("s_mov_b32 %0, m0\n\ts_mov_b32 m0, %2\n\ts_nop 0\n\tglobal_load_lds_dwordx4 %1, off\n\ts_mov_b32 m0, %0" : "=&s"(keep) : "v"(gsrc), "s"(lds_dst) : "memory"); }
__device__ __forceinline__ void glds4(const void* gsrc, unsigned lds_dst) { unsigned keep;
    asm volatile("s_mov_b32 %0, m0\n\ts_mov_b32 m0, %2\n\ts_nop 0\n\tglobal_load_lds_dword %1, off\n\ts_mov_b32 m0, %0" : "=&s"(keep) : "v"(gsrc), "s"(lds_dst) : "memory"); }
__device__ __forceinline__ void glds16s(unsigned voff, const void* sbase, unsigned lds_dst) { unsigned keep;
    asm volatile("s_mov_b32 %0, m0\n\ts_mov_b32 m0, %3\n\ts_nop 0\n\tglobal_load_lds_dwordx4 %1, %2\n\ts_mov_b32 m0, %0" : "=&s"(keep) : "v"(voff), "s"(sbase), "s"(lds_dst) : "memory"); }
__device__ __forceinline__ void glds4s(unsigned voff, const void* sbase, unsigned lds_dst) { unsigned keep;
    asm volatile("s_mov_b32 %0, m0\n\ts_mov_b32 m0, %3\n\ts_nop 0\n\tglobal_load_lds_dword %1, %2\n\ts_mov_b32 m0, %0" : "=&s"(keep) : "v"(voff), "s"(sbase), "s"(lds_dst) : "memory"); }
#define ATT_WAITBAR(N) asm volatile("s_waitcnt vmcnt(" #N ") lgkmcnt(0)\n\ts_barrier" ::: "memory")
typedef unsigned u32x2v __attribute__((ext_vector_type(2)));
struct AttCarry { bf16x8 q[6]; f32x4 c0, c1, s0, s1; float cq; int gslot; };
template <int DK, int DV, int MODE, int PRB = 0, int NMODE = -1, bool CONT = false>
__device__ __forceinline__ void attn_unit(LAS unsigned char* lds, const AttnPtrs& A, int qb, const AttnPtrs& AN, int qbN, AttCarry& cy) {
    constexpr int KSLOT = MODE == 2 ? DK * 128 : 12288, VSLOT = DV * 128, NKP = DK / 8, NVP = DV / 8, CKOFF = KSLOT + VSLOT, BUF = CKOFF + 1024, ND = DK / 16, NO = DV / 32;
    constexpr int NKPN = NMODE == 1 ? 12 : 8, NPTN = NKPN + 8 + (NMODE == 0 ? 1 : 0), NDN = NMODE == 1 ? 6 : 4;
    constexpr int NPT = NKP + NVP + (MODE == 0 ? 1 : 0);
    constexpr float THR = 8.0f;
    constexpr bool PIPE = ATT_PIPE && MODE != 2;
    const int tid = threadIdx.x, lane = tid & 63, r32 = lane & 31, hi = lane >> 5; const int wid = __builtin_amdgcn_readfirstlane(tid >> 6);
    const int q0 = qb * 256, qrow = q0 + wid * 32 + r32;
    const int NT = PRB == 7 ? 1 : MODE == 2 ? 4 : 4 * qb + 4, NTw = PRB == 7 ? 1 : MODE == 2 ? 4 : 4 * qb + (wid >> 1) + 1;
    const int nw = (NPT - wid + 7) / 8;
    const int nwN = (NPTN - wid + 7) / 8;
    const unsigned lds0 = (unsigned)(uintptr_t)lds;
    unsigned voffK = (unsigned)(lane * A.ldk * 2), voffV = (unsigned)((((lane >> 2) * A.ldv) + (lane & 3) * 8) * 2), voffC = (unsigned)(lane * 4);
    unsigned voffKN = (unsigned)(lane * AN.ldk * 2);
    asm volatile("" : "+v"(voffK), "+v"(voffV), "+v"(voffC), "+v"(voffKN));
    auto issueN = [&](int t, int slot) {
        const unsigned base = lds0 + slot * BUF;
        for (int pi = wid; pi < NPTN; pi += 8) {
            if (pi < NKPN) { const bf16* sb = AN.K + (size_t)(t * 64) * AN.ldk + pi * 8; glds16s(voffKN, sb, (unsigned)__builtin_amdgcn_readfirstlane(base + pi * 1024)); }
            else if (pi < NKPN + 8) { const int v = pi - NKPN, dh = v >> 2, kg = v & 3; const bf16* sb = AN.V + (size_t)(t * 64 + 16 * kg) * AN.ldv + dh * 32;
                   glds16s(voffV, sb, (unsigned)__builtin_amdgcn_readfirstlane(base + KSLOT + v * 1024)); }
            else { if constexpr (NMODE == 0) glds4s(voffC, AN.cd + t * 64, (unsigned)__builtin_amdgcn_readfirstlane(base + CKOFF)); }
        }
    };
    auto loadqN = [&]() {
        const int qrowN = qbN * 256 + wid * 32 + r32;
#pragma unroll
        for (int d0 = 0; d0 < NDN; ++d0) cy.q[d0] = *(const bf16x8*)(AN.Q + (size_t)qrowN * AN.ldq + d0 * 16 + hi * 8);
        if constexpr (NMODE == 1) { const float* cp = AN.cosT + qrowN * 16 + hi * 8; const float* sp = AN.sinT + qrowN * 16 + hi * 8;
            cy.c0 = *(const f32x4*)cp; cy.c1 = *(const f32x4*)(cp + 4); cy.s0 = *(const f32x4*)sp; cy.s1 = *(const f32x4*)(sp + 4); }
        if constexpr (NMODE == 0) cy.cq = AN.cd[qrowN];
    };
    auto issue = [&](int t, int slot) {
        const unsigned base = lds0 + slot * BUF;
        for (int pi = wid; pi < NPT; pi += 8) {
            if (pi < NKP) { const bf16* sb = A.K + (size_t)(t * 64) * A.ldk + pi * 8; glds16s(voffK, sb, (unsigned)__builtin_amdgcn_readfirstlane(base + pi * 1024)); }
            else if (pi < NKP + NVP) { const int v = pi - NKP, dh = v >> 2, kg = v & 3; const bf16* sb = A.V + (size_t)(t * 64 + 16 * kg) * A.ldv + dh * 32;
                   glds16s(voffV, sb, (unsigned)__builtin_amdgcn_readfirstlane(base + KSLOT + v * 1024)); }
            else { if constexpr (MODE == 0) glds4s(voffC, A.cd + t * 64, (unsigned)__builtin_amdgcn_readfirstlane(base + CKOFF)); }
        }
    };
    auto waitbar = [&](bool keep_newest) {
        if (!keep_newest) { ATT_WAITBAR(0); }
        else if (nw == 2) { ATT_WAITBAR(2); } else if (nw == 3) { ATT_WAITBAR(3); } else { ATT_WAITBAR(4); }
    };
    const int gslot = (MODE != 2 && CONT) ? cy.gslot : 0;
    if constexpr (MODE == 2 || !CONT) { issue(0, 0); if (NT > 1) issue(1, 1); if constexpr (MODE != 2) { issue(2, 2); issue(3, 3); } }
    bf16x8 qr[ND]; f32x4 rc0, rc1, rs0, rs1; float cq = 0.f;
    if constexpr (MODE != 2 && CONT) {
#pragma unroll
        for (int d0 = 0; d0 < ND; ++d0) qr[d0] = cy.q[d0];
        if constexpr (MODE == 1) { rc0 = cy.c0; rc1 = cy.c1; rs0 = cy.s0; rs1 = cy.s1; }
        if constexpr (MODE == 0) cq = cy.cq;
    } else {
#pragma unroll
        for (int d0 = 0; d0 < ND; ++d0) qr[d0] = *(const bf16x8*)(A.Q + (size_t)qrow * A.ldq + d0 * 16 + hi * 8);
        if constexpr (MODE == 1) { const float* cp = A.cosT + qrow * 16 + hi * 8; const float* sp = A.sinT + qrow * 16 + hi * 8;
            rc0 = *(const f32x4*)cp; rc1 = *(const f32x4*)(cp + 4); rs0 = *(const f32x4*)sp; rs1 = *(const f32x4*)(sp + 4); }
        if constexpr (MODE == 0) cq = A.cd[qrow];
    }
    if constexpr (MODE == 1) {
        bf16x8 a = qr[4], c = qr[5];
#pragma unroll
        for (int i = 0; i < 8; ++i) { const float x1 = bf2f((unsigned short)a[i]), x2 = bf2f((unsigned short)c[i]), cs = i < 4 ? rc0[i & 3] : rc1[i & 3], sn = i < 4 ? rs0[i & 3] : rs1[i & 3];
            a[i] = (short)f2bf(x1 * cs - x2 * sn); c[i] = (short)f2bf(x2 * cs + x1 * sn); }
        qr[4] = a; qr[5] = c;
    }
    float mref = 0.f, l = 0.f; f32x16 o[NO];
#pragma unroll
    for (int i = 0; i < NO; ++i) o[i] = f32x16{};
#pragma unroll
    for (int d0 = 0; d0 < ND; ++d0) asm volatile("" : "+v"(qr[d0]));
    asm volatile("" : "+v"(cq));
    if constexpr (PIPE) {
#define ATT_INIT(P0, P1, SL) do { \
        if constexpr (MODE == 0) { \
            const LAS float* ck = (const LAS float*)(lds + (SL) * BUF + CKOFF) + 4 * hi; \
            _Pragma("unroll") for (int g = 0; g < 4; ++g) { const f32x4 c0 = *(const LAS f32x4*)(ck + 8 * g), c1 = *(const LAS f32x4*)(ck + 32 + 8 * g); \
                _Pragma("unroll") for (int i = 0; i < 4; ++i) { P0[4 * g + i] = cq - c0[i]; P1[4 * g + i] = cq - c1[i]; } } \
        } else { P0 = f32x16{}; P1 = f32x16{}; } } while (0)
#define ATT_QKM(P0, P1, SL) do { const LAS unsigned char* Kb = lds + (SL) * BUF + hi * 1024 + r32 * 16; \
        _Pragma("unroll") for (int d0 = 0; d0 < ND; ++d0) { \
            const bf16x8 b0 = *(const LAS bf16x8*)(Kb + d0 * 2048), b1 = *(const LAS bf16x8*)(Kb + d0 * 2048 + 512); \
            P0 = __builtin_amdgcn_mfma_f32_32x32x16_bf16(b0, qr[d0], P0, 0, 0, 0); P1 = __builtin_amdgcn_mfma_f32_32x32x16_bf16(b1, qr[d0], P1, 0, 0, 0); } } while (0)
#define ATT_MASKNOW(P0, P1, TT) do { if constexpr (MODE == 0) { const int kb = (TT) * 64 + 4 * hi; \
            _Pragma("unroll") for (int r = 0; r < 16; ++r) { const int kv = kb + (r & 3) + 8 * (r >> 2); if (kv > qrow) P0[r] = -INFINITY; if (kv + 32 > qrow) P1[r] = -INFINITY; } } } while (0)
#define ATT_MASK(P0, P1, TT) do { if constexpr (MODE == 0) { if (__builtin_amdgcn_readfirstlane((TT) == NTw - 1)) { const int kb = (TT) * 64 + 4 * hi; \
            _Pragma("unroll") for (int r = 0; r < 16; ++r) { const int kv = kb + (r & 3) + 8 * (r >> 2); if (kv > qrow) P0[r] = -INFINITY; if (kv + 32 > qrow) P1[r] = -INFINITY; } } } } while (0)
#define ATT_ROWMAX(P0, P1) do { \
        rm = fmaxf(P0[0], P1[0]); \
        _Pragma("unroll") for (int r = 1; r < 16; ++r) rm = fmaxf(fmaxf(rm, P0[r]), P1[r]); \
        { auto rr = __builtin_amdgcn_permlane32_swap(__float_as_uint(rm), __float_as_uint(rm), false, false); rm = fmaxf(__uint_as_float(rr[0]), __uint_as_float(rr[1])); } } while (0)
#define ATT_RESC(P0, P1) do {     \
        if (__builtin_expect(__any((rm - mref > THR) || (mref != 0.f)), 0)) { \
            rm -= mref; \
            const float dl = fmaxf(rm > THR ? rm : 0.f, 0.f), f = __builtin_amdgcn_exp2f(-dl), sub = mref + dl; mref += dl; l *= f; \
            _Pragma("unroll") for (int r = 0; r < 16; ++r) { P0[r] -= sub; P1[r] -= sub; } \
            _Pragma("unroll") for (int i = 0; i < NO; ++i) _Pragma("unroll") for (int r = 0; r < 16; ++r) o[i][r] *= f; } } while (0)
#define ATT_EXP(P0, P1) do { float sum = 0.f; \
        _Pragma("unroll") for (int r = 0; r < 16; ++r) { P0[r] = __builtin_amdgcn_exp2f(P0[r]); P1[r] = __builtin_amdgcn_exp2f(P1[r]); sum += P0[r] + P1[r]; } \
        l += sum; \
        _Pragma("unroll") for (int s2 = 0; s2 < 2; ++s2) { pw[s2] = (u32x4){cvtpk(P0[8 * s2], P0[8 * s2 + 1]), cvtpk(P0[8 * s2 + 2], P0[8 * s2 + 3]), cvtpk(P0[8 * s2 + 4], P0[8 * s2 + 5]), cvtpk(P0[8 * s2 + 6], P0[8 * s2 + 7])}; \
            pw[2 + s2] = (u32x4){cvtpk(P1[8 * s2], P1[8 * s2 + 1]), cvtpk(P1[8 * s2 + 2], P1[8 * s2 + 3]), cvtpk(P1[8 * s2 + 4], P1[8 * s2 + 5]), cvtpk(P1[8 * s2 + 6], P1[8 * s2 + 7])}; } } while (0)
#define ATT_HOT(C0, C1, N0, N1, SL, VSL) do { const LAS unsigned char* Kb = lds + (SL) * BUF + hi * 1024 + r32 * 16; float sum = 0.f; \
        const LAS unsigned char* Vb = lds + (VSL) * BUF + KSLOT + ((lane >> 4) & 1) * 32 + (lane & 3) * 8 + (4 * hi + ((lane & 15) >> 2)) * 64; \
        bf16x8 kf = *(const LAS bf16x8*)(Kb), kf1 = *(const LAS bf16x8*)(Kb + 512);     \
        _Pragma("unroll") for (int q_ = 0; q_ < 2 * ND; ++q_) { \
            bf16x8 kn = kf; \
            if (PRB != 5 && q_ + 2 < 2 * ND) kn = *(const LAS bf16x8*)(Kb + ((q_ + 2) >> 1) * 2048 + ((q_ + 2) & 1) * 512); \
            if (PRB != 5 && q_ >= 2 * ND - VPRE) { const int j_ = q_ - (2 * ND - VPRE); \
                vfr[2 * j_] = __builtin_bit_cast(s16x4, __builtin_amdgcn_ds_read_tr16_b64_v4i16((LAS s16x4*)(Vb + (j_ >> 2) * 4096 + (j_ & 3) * 1024))); \
                vfr[2 * j_ + 1] = __builtin_bit_cast(s16x4, __builtin_amdgcn_ds_read_tr16_b64_v4i16((LAS s16x4*)(Vb + (j_ >> 2) * 4096 + (j_ & 3) * 1024 + 512))); } \
            if (PRB == 6) { asm volatile("" :: "v"(kf)); } else if (q_ & 1) N1 = __builtin_amdgcn_mfma_f32_32x32x16_bf16(kf, qr[q_ >> 1], N1, 0, 0, 0); else N0 = __builtin_amdgcn_mfma_f32_32x32x16_bf16(kf, qr[q_ >> 1], N0, 0, 0, 0); \
            _Pragma("unroll") for (int j_ = 0; j_ < (32 + 2 * ND - 1) / (2 * ND); ++j_) { const int e_ = (q_ * 32) / (2 * ND) + j_; \
                if (e_ < ((q_ + 1) * 32) / (2 * ND)) { if (PRB != 4) { if (e_ < 16) C0[e_ & 15] = __builtin_amdgcn_exp2f(C0[e_ & 15]); else C1[e_ & 15] = __builtin_amdgcn_exp2f(C1[e_ & 15]); } } } \
            kf = kf1; kf1 = kn; \
            __builtin_amdgcn_sched_barrier(0); } \
        { float s0_ = C0[0], s1_ = C0[1], s2_ = C1[0], s3_ = C1[1]; \
          _Pragma("unroll") for (int r = 2; r < 16; r += 2) { s0_ += C0[r]; asm("" : "+v"(s0_)); s1_ += C0[r + 1]; asm("" : "+v"(s1_)); s2_ += C1[r]; asm("" : "+v"(s2_)); s3_ += C1[r + 1]; asm("" : "+v"(s3_)); } \
          sum = (s0_ + s1_) + (s2_ + s3_); } \
        l += sum; \
        _Pragma("unroll") for (int s2 = 0; s2 < 2; ++s2) { pw[s2] = (u32x4){cvtpk(C0[8 * s2], C0[8 * s2 + 1]), cvtpk(C0[8 * s2 + 2], C0[8 * s2 + 3]), cvtpk(C0[8 * s2 + 4], C0[8 * s2 + 5]), cvtpk(C0[8 * s2 + 6], C0[8 * s2 + 7])}; \
            pw[2 + s2] = (u32x4){cvtpk(C1[8 * s2], C1[8 * s2 + 1]), cvtpk(C1[8 * s2 + 2], C1[8 * s2 + 3]), cvtpk(C1[8 * s2 + 4], C1[8 * s2 + 5]), cvtpk(C1[8 * s2 + 6], C1[8 * s2 + 7])}; } } while (0)
#define ATT_PVR(SL) do { const LAS unsigned char* Vb2 = lds + (SL) * BUF + KSLOT + ((lane >> 4) & 1) * 32 + (lane & 3) * 8 + (4 * hi + ((lane & 15) >> 2)) * 64; \
        _Pragma("unroll") for (int ks = 0; ks < 4; ++ks) _Pragma("unroll") for (int d0 = 0; d0 < NO; ++d0) { \
            s16x4 vl, vh; \
            if (PRB == 5) { vl = __builtin_bit_cast(s16x4, (u32x2v){pw[ks][0], pw[ks][1]}); vh = __builtin_bit_cast(s16x4, (u32x2v){pw[ks][2], pw[ks][3]}); } \
            else if (d0 * 4 + ks < VPRE) { vl = vfr[2 * (d0 * 4 + ks)]; vh = vfr[2 * (d0 * 4 + ks) + 1]; } \
            else { vl = __builtin_bit_cast(s16x4, __builtin_amdgcn_ds_read_tr16_b64_v4i16((LAS s16x4*)(Vb2 + d0 * 4096 + ks * 1024))); vh = __builtin_bit_cast(s16x4, __builtin_amdgcn_ds_read_tr16_b64_v4i16((LAS s16x4*)(Vb2 + d0 * 4096 + ks * 1024 + 512))); } \
            const bf16x8 vf = (bf16x8){vl[0], vl[1], vl[2], vl[3], vh[0], vh[1], vh[2], vh[3]}; \
            if (PRB == 6) { asm volatile("" :: "v"(vf)); } else o[d0] = __builtin_amdgcn_mfma_f32_32x32x16_bf16(vf, __builtin_bit_cast(bf16x8, pw[ks]), o[d0], 0, 0, 0); } } while (0)
#define ATT_PV(SL) do { \
        const LAS unsigned char* Vb = lds + (SL) * BUF + KSLOT + ((lane >> 4) & 1) * 32 + (lane & 3) * 8 + (4 * hi + ((lane & 15) >> 2)) * 64; \
        _Pragma("unroll") for (int ks = 0; ks < 4; ++ks) _Pragma("unroll") for (int d0 = 0; d0 < NO; ++d0) { \
            const s16x4 vl = __builtin_bit_cast(s16x4, __builtin_amdgcn_ds_read_tr16_b64_v4i16((LAS s16x4*)(Vb + d0 * 4096 + ks * 1024))); \
            const s16x4 vh = __builtin_bit_cast(s16x4, __builtin_amdgcn_ds_read_tr16_b64_v4i16((LAS s16x4*)(Vb + d0 * 4096 + ks * 1024 + 512))); \
            const bf16x8 vf = (bf16x8){vl[0], vl[1], vl[2], vl[3], vh[0], vh[1], vh[2], vh[3]}; \
            o[d0] = __builtin_amdgcn_mfma_f32_32x32x16_bf16(vf, __builtin_bit_cast(bf16x8, pw[ks]), o[d0], 0, 0, 0); } } while (0)
    auto waitg = [&](int groups) { const int cnt = groups * nw;
        if (cnt == 0) { ATT_WAITBAR(0); } else if (cnt == 2) { ATT_WAITBAR(2); } else if (cnt == 3) { ATT_WAITBAR(3); } else if (cnt == 4) { ATT_WAITBAR(4); } else if (cnt == 6) { ATT_WAITBAR(6); } else { ATT_WAITBAR(8); } };
    asm volatile("s_waitcnt lgkmcnt(0)\n\ts_barrier" ::: "memory");
    f32x16 pA0, pA1, pB0, pB1; u32x4 pw[4]; constexpr int VPRE = 0; s16x4 vfr[2 * VPRE > 0 ? 2 * VPRE : 1];
    float rm;
    ATT_INIT(pA0, pA1, gslot); ATT_QKM(pA0, pA1, gslot); ATT_MASK(pA0, pA1, 0); ATT_ROWMAX(pA0, pA1); ATT_RESC(pA0, pA1);
    int slot = gslot;
#define ATT_HEAD const int s1 = slot == 5 ? 0 : slot + 1; if (PRB != 3) { if (t + 4 < NT) issue(t + 4, slot >= 2 ? slot - 2 : slot + 4); else if (NMODE >= 0) issueN(t + 4 - NT, slot >= 2 ? slot - 2 : slot + 4); }
#define ATT_NEXTQ if (NMODE >= 0 && t == NT - 1) loadqN()
#define ATT_FOOT if (PRB != 2 && (t & 1)) { const int cnt_ = t + 4 < NT ? nw : NMODE >= 0 ? nwN : 0; \
        if (NMODE >= 0 && t == NT - 1) { if (NMODE == 1) { if (nwN == 3) { ATT_WAITBAR(11); } else { ATT_WAITBAR(10); } } else { if (nwN == 3) { ATT_WAITBAR(7); } else { ATT_WAITBAR(6); } } } \
        else if (cnt_ == 3) { ATT_WAITBAR(3); } else if (cnt_ == 2) { ATT_WAITBAR(2); } else { ATT_WAITBAR(0); } } slot = s1; ++t
#define ATT_HOTTRIP(C0, C1, N0, N1, MSK) do { ATT_HEAD; ATT_INIT(N0, N1, s1); ATT_HOT(C0, C1, N0, N1, s1, slot); if (MSK) ATT_MASKNOW(N0, N1, t + 1); ATT_PVR(slot); ATT_ROWMAX(N0, N1); ATT_RESC(N0, N1); ATT_FOOT; } while (0)
#define ATT_LASTTRIP(C0, C1) do { ATT_HEAD; ATT_NEXTQ; ATT_EXP(C0, C1); ATT_PV(slot); ATT_FOOT; } while (0)
    int t = 0;
    while (t + 3 < NTw) { ATT_HOTTRIP(pA0, pA1, pB0, pB1, 0); ATT_HOTTRIP(pB0, pB1, pA0, pA1, 0); }
    if (t + 2 < NTw) { ATT_HOTTRIP(pA0, pA1, pB0, pB1, 0); ATT_HOTTRIP(pB0, pB1, pA0, pA1, 1); ATT_LASTTRIP(pA0, pA1); }
    else if (t + 1 < NTw) { ATT_HOTTRIP(pA0, pA1, pB0, pB1, 1); ATT_LASTTRIP(pB0, pB1); } else { ATT_LASTTRIP(pA0, pA1); }
    while (t < NT) { ATT_HEAD; ATT_NEXTQ; ATT_FOOT; }
    cy.gslot = (gslot + NT) % 6;
#undef ATT_NEXTQ
#undef ATT_HEAD
#undef ATT_FOOT
#undef ATT_HOTTRIP
#undef ATT_LASTTRIP
#undef ATT_INIT
#undef ATT_QKM
#undef ATT_MASK
#undef ATT_ROWMAX
#undef ATT_MASKNOW
#undef ATT_RESC
#undef ATT_EXP
#undef ATT_HOT
#undef ATT_PV
#undef ATT_PVR
    } else {
    waitbar(NT > 1);
    int slot = 0;
    for (int t = 0; t < NT; ++t) {
        if (t + 2 < NT) issue(t + 2, slot == 0 ? 2 : slot - 1);
        if (t < NTw) {
            const LAS unsigned char* Kb = lds + slot * BUF + hi * 1024 + r32 * 16;
            f32x16 p0, p1;
            if constexpr (MODE == 0) {
                const LAS float* ck = (const LAS float*)(lds + slot * BUF + CKOFF) + 4 * hi; const float c0m = cq - mref;
#pragma unroll
                for (int g = 0; g < 4; ++g) { const f32x4 c0 = *(const LAS f32x4*)(ck + 8 * g), c1 = *(const LAS f32x4*)(ck + 32 + 8 * g);
#pragma unroll
                    for (int i = 0; i < 4; ++i) { p0[4 * g + i] = c0m - c0[i]; p1[4 * g + i] = c0m - c1[i]; } }
            } else {
#pragma unroll
                for (int r = 0; r < 16; ++r) { p0[r] = -mref; p1[r] = -mref; } }
#pragma unroll
            for (int d0 = 0; d0 < ND; ++d0) {
                const bf16x8 b0 = *(const LAS bf16x8*)(Kb + d0 * 2048), b1 = *(const LAS bf16x8*)(Kb + d0 * 2048 + 512);
                p0 = __builtin_amdgcn_mfma_f32_32x32x16_bf16(b0, qr[d0], p0, 0, 0, 0); p1 = __builtin_amdgcn_mfma_f32_32x32x16_bf16(b1, qr[d0], p1, 0, 0, 0);
            }
            if constexpr (MODE == 0) { if (__builtin_amdgcn_readfirstlane(t == NTw - 1)) {
                const int kb = t * 64 + 4 * hi;
#pragma unroll
                for (int r = 0; r < 16; ++r) { const int kv = kb + (r & 3) + 8 * (r >> 2); if (kv > qrow) p0[r] = -INFINITY; if (kv + 32 > qrow) p1[r] = -INFINITY; } } }
            float rm = fmaxf(p0[0], p1[0]);
#pragma unroll
            for (int r = 1; r < 16; ++r) rm = fmaxf(fmaxf(rm, p0[r]), p1[r]);
            { auto rr = __builtin_amdgcn_permlane32_swap(__float_as_uint(rm), __float_as_uint(rm), false, false); rm = fmaxf(__uint_as_float(rr[0]), __uint_as_float(rr[1])); }
            if (__builtin_expect(__any(rm > THR), 0)) {
                const float dl = fmaxf(rm, 0.f), f = __builtin_amdgcn_exp2f(-dl); mref += dl; l *= f;
#pragma unroll
                for (int r = 0; r < 16; ++r) { p0[r] -= dl; p1[r] -= dl; }
#pragma unroll
                for (int i = 0; i < NO; ++i)
#pragma unroll
                    for (int r = 0; r < 16; ++r) o[i][r] *= f;
            }
            float sum = 0.f;
#pragma unroll
            for (int r = 0; r < 16; ++r) { p0[r] = __builtin_amdgcn_exp2f(p0[r]); p1[r] = __builtin_amdgcn_exp2f(p1[r]); sum += p0[r] + p1[r]; }
            l += sum;
            u32x4 pw[4];
#pragma unroll
            for (int s = 0; s < 2; ++s) { pw[s] = (u32x4){cvtpk(p0[8 * s], p0[8 * s + 1]), cvtpk(p0[8 * s + 2], p0[8 * s + 3]), cvtpk(p0[8 * s + 4], p0[8 * s + 5]), cvtpk(p0[8 * s + 6], p0[8 * s + 7])};
                pw[2 + s] = (u32x4){cvtpk(p1[8 * s], p1[8 * s + 1]), cvtpk(p1[8 * s + 2], p1[8 * s + 3]), cvtpk(p1[8 * s + 4], p1[8 * s + 5]), cvtpk(p1[8 * s + 6], p1[8 * s + 7])}; }
            const LAS unsigned char* Vb = lds + slot * BUF + KSLOT + ((lane >> 4) & 1) * 32 + (lane & 3) * 8 + (4 * hi + ((lane & 15) >> 2)) * 64;
#pragma unroll
            for (int d0 = 0; d0 < NO; ++d0)
#pragma unroll
                for (int ks = 0; ks < 4; ++ks) {
                    const s16x4 vl = __builtin_bit_cast(s16x4, __builtin_amdgcn_ds_read_tr16_b64_v4i16((LAS s16x4*)(Vb + d0 * 4096 + ks * 1024)));
                    const s16x4 vh = __builtin_bit_cast(s16x4, __builtin_amdgcn_ds_read_tr16_b64_v4i16((LAS s16x4*)(Vb + d0 * 4096 + ks * 1024 + 512)));
                    const bf16x8 vf = (bf16x8){vl[0], vl[1], vl[2], vl[3], vh[0], vh[1], vh[2], vh[3]};
                    o[d0] = __builtin_amdgcn_mfma_f32_32x32x16_bf16(vf, __builtin_bit_cast(bf16x8, pw[ks]), o[d0], 0, 0, 0);
                }
        }
        waitbar(t + 2 < NT);
        slot = slot == 2 ? 0 : slot + 1;
    }
    }
    { auto rr = __builtin_amdgcn_permlane32_swap(__float_as_uint(l), __float_as_uint(l), false, false); l = __uint_as_float(rr[0]) + __uint_as_float(rr[1]); }
    const float inv = 1.0f / l; float ss = 0.f;
    bf16* orow = A.O + (size_t)qrow * A.ldo + 8 * hi;
#pragma unroll
    for (int d0 = 0; d0 < NO; ++d0)
#pragma unroll
        for (int g = 0; g < 4; g += 2) {
            float v[8];
#pragma unroll
            for (int i = 0; i < 4; ++i) { v[i] = o[d0][4 * g + i] * inv; v[4 + i] = o[d0][4 * (g + 1) + i] * inv; ss += v[i] * v[i] + v[4 + i] * v[4 + i]; }
            unsigned ax = pk2(v[0], v[1]), ay = pk2(v[2], v[3]), bx_ = pk2(v[4], v[5]), by = pk2(v[6], v[7]);
            { auto r = __builtin_amdgcn_permlane32_swap(ax, bx_, false, false); ax = r[0]; bx_ = r[1]; }
            { auto r = __builtin_amdgcn_permlane32_swap(ay, by, false, false); ay = r[0]; by = r[1]; }
            *(u32x4*)(orow + d0 * 32 + 8 * g) = (u32x4){ax, ay, bx_, by};
        }
    if (MODE != 2 || A.part) { auto rr = __builtin_amdgcn_permlane32_swap(__float_as_uint(ss), __float_as_uint(ss), false, false); ss = __uint_as_float(rr[0]) + __uint_as_float(rr[1]); A.part[(size_t)qrow * A.pstride] = ss; }
}
template <int PRB = 0>
__device__ __forceinline__ void attn_phase_self(LAS unsigned char* lds, const Bufs& b, int vcu) {
    const int bh = vcu >> 2, s = vcu & 3, bb = bh >> 3, h = bh & 7; const size_t r0 = (size_t)bb * S;
    if (vcu >= 256) return;
    bf16* const Ob = PRB ? b.yp : b.Omix; float* const pf = PRB ? (float*)b.act : b.pfox; float* const pm = PRB ? (float*)b.act + 262144 : b.pmla;
    AttnPtrs F{b.Qf + r0 * 512 + h * 64, 512, b.Kf + r0 * 512 + h * 64, 512, b.Vf + r0 * 512 + h * 64, 512, Ob + r0 * 1024 + h * 64, 1024, pf + r0 * 8 + h, 8, b.cdec + (size_t)bh * S, nullptr, nullptr};
    AttnPtrs M{b.Qm + r0 * 768 + h * 96, 768, b.Km + r0 * 768 + h * 96, 768, b.Vm + r0 * 512 + h * 64, 512, Ob + r0 * 1024 + 512 + h * 64, 1024, pm + r0 * 8 + h, 8, nullptr, b.cosT, b.sinT};
    AttCarry cy;
    attn_unit<96, 64, 1, PRB, 0, false>(lds, M, 7 - s, F, 7 - s, cy); attn_unit<64, 64, 0, PRB, 1, true>(lds, F, 7 - s, M, s, cy);
    attn_unit<96, 64, 1, PRB, 0, true>(lds, M, s, F, s, cy); attn_unit<64, 64, 0, PRB, -1, true>(lds, F, s, F, s, cy);
}
__device__ __forceinline__ void attn_phase_mem(LAS unsigned char* lds, const Bufs& b, int vcu) {
    if (vcu >= 256) return;
    const int bb = vcu >> 5, h = (vcu >> 3) & 3, qb = vcu & 7; const size_t r0 = (size_t)bb * S, m0 = (size_t)bb * MEMT;
    AttnPtrs X{b.Qmem + r0 * 512 + h * 128, 512, b.KVm + m0 * 1024 + h * 128, 1024, b.KVm + m0 * 1024 + 512 + h * 128, 1024, b.Omem + r0 * 512 + h * 128, 512, nullptr, 0, nullptr, nullptr, nullptr};
    AttCarry cy;
    attn_unit<128, 128, 2>(lds, X, qb, X, qb, cy);
}

typedef float f32x4v __attribute__((ext_vector_type(4)));
struct RouterRec { int sel[256]; float gw[256]; int rank[256]; float rs[64]; int tok[64]; int base[32]; int wcnt[128]; int pbase[512]; int ptot[512]; };
__device__ __forceinline__ void router_tile(const Params& p, const Bufs& b, int tile, int lane, float* lgl  , RouterRec* R, int wslot) {
    const int n = lane & 15, g = lane >> 4, tok0 = tile * 16;
    const bf16* hrow = b.h2 + (size_t)(tok0 + n) * D + 8 * g;
    const bf16* wh0 = (const bf16*)b.wr + (size_t)n * 1024 + 8 * g; const bf16* wh1 = wh0 + 16 * 1024; const bf16* wl0 = wh0 + 32768; const bf16* wl1 = wh1 + 32768;
    f32x4v acc0 = {0.f, 0.f, 0.f, 0.f}, acc1 = {0.f, 0.f, 0.f, 0.f}; float ss = 0.f;
#pragma unroll 4
    for (int j = 0; j < 32; ++j) {
        const u32x4 araw = *(const u32x4*)(hrow + 32 * j); const bf16x8 a = __builtin_bit_cast(bf16x8, araw);
        const bf16x8 h0 = *(const bf16x8*)(wh0 + 32 * j), h1 = *(const bf16x8*)(wh1 + 32 * j), l0 = *(const bf16x8*)(wl0 + 32 * j), l1 = *(const bf16x8*)(wl1 + 32 * j);
        float f[8]; unpack8(araw, f);
#pragma unroll
        for (int i = 0; i < 8; ++i) ss += f[i] * f[i];
        acc0 = __builtin_amdgcn_mfma_f32_16x16x32_bf16(h0, a, acc0, 0, 0, 0); acc0 = __builtin_amdgcn_mfma_f32_16x16x32_bf16(l0, a, acc0, 0, 0, 0);
        acc1 = __builtin_amdgcn_mfma_f32_16x16x32_bf16(h1, a, acc1, 0, 0, 0); acc1 = __builtin_amdgcn_mfma_f32_16x16x32_bf16(l1, a, acc1, 0, 0, 0);
    }
    ss += __shfl_xor(ss, 16); ss += __shfl_xor(ss, 32);
    const float rs = 1.0f / sqrtf(ss * (1.0f / 1024.0f) + EPS);
#pragma unroll
    for (int r = 0; r < 4; ++r) { lgl[n * 33 + 4 * g + r] = acc0[r] * rs + p.b_router[4 * g + r]; lgl[n * 33 + 16 + 4 * g + r] = acc1[r] * rs + p.b_router[16 + 4 * g + r]; }
    __builtin_amdgcn_s_waitcnt(0xc07f); __builtin_amdgcn_wave_barrier();
    if (lane < 16) {
        const float* lg = lgl + lane * 33; const int slot = wslot * 16 + lane;
        unsigned taken = 0u; float tv0 = 0.f, tv1 = 0.f, tv2 = 0.f, tv3 = 0.f; int ti0 = 0, ti1 = 0, ti2 = 0, ti3 = 0;
#pragma unroll
        for (int k = 0; k < 4; ++k) {
            float best = -INFINITY; int bi = 0;
            for (int e = 0; e < 32; ++e) { const float x = lg[e]; if (!((taken >> e) & 1u) && x > best) { best = x; bi = e; } }
            taken |= 1u << bi;
            if (k == 0) { tv0 = best; ti0 = bi; } else if (k == 1) { tv1 = best; ti1 = bi; } else if (k == 2) { tv2 = best; ti2 = bi; } else { tv3 = best; ti3 = bi; }
        }
        const float e1 = expf(tv1 - tv0), e2 = expf(tv2 - tv0), e3 = expf(tv3 - tv0), inv = 1.0f / (1.0f + e1 + e2 + e3);
        R->sel[slot * 4 + 0] = ti0; R->sel[slot * 4 + 1] = ti1; R->sel[slot * 4 + 2] = ti2; R->sel[slot * 4 + 3] = ti3;
        R->gw[slot * 4 + 0] = inv; R->gw[slot * 4 + 1] = e1 * inv; R->gw[slot * 4 + 2] = e2 * inv; R->gw[slot * 4 + 3] = e3 * inv;
        R->rs[slot] = rs; R->tok[slot] = tok0 + lane;
    }
}
__device__ __forceinline__ void router_rank(const Bufs& b, RouterRec* R, int bx, int nslots) {
    __syncthreads();
    const int tid = threadIdx.x, lane = tid & 63, w = tid >> 6;
    if (w < 4) { const int i = w * 64 + lane, e = R->sel[i]; int myrank = 0;
        for (int q = 0; q < 32; ++q) { const unsigned long long m = __ballot(e == q); if (e == q) myrank = __popcll(m & ((1ull << lane) - 1ull)); if (lane == 0) R->wcnt[w * 32 + q] = __popcll(m); }
        R->rank[i] = myrank; }
    __syncthreads();
    if (w < 4) { const int i = w * 64 + lane, e = R->sel[i]; int add = 0; for (int ww = 0; ww < w; ++ww) add += R->wcnt[ww * 32 + e]; R->rank[i] += add; }
    if (tid < 32) b.blkcnt[bx * 32 + tid] = R->wcnt[tid] + R->wcnt[32 + tid] + R->wcnt[64 + tid] + R->wcnt[96 + tid];
}
__device__ __forceinline__ void router_publish(const Bufs& b, RouterRec* R, int bx, int G, int nslots) {
    const int tid = threadIdx.x;
    { const int e = tid & 31, jg = tid >> 5; int base = 0, tot = 0;
#pragma unroll
      for (int q = 0; q < 16; ++q) { const int j = jg * 16 + q; const int c = (int)__hip_atomic_load((const unsigned*)b.blkcnt + j * 32 + e, __ATOMIC_RELAXED, __HIP_MEMORY_SCOPE_AGENT); tot += c; if (j < bx) base += c; }
      R->pbase[jg * 32 + e] = base; R->ptot[jg * 32 + e] = tot; }
    __syncthreads();
    if (tid < 32) { int base = 0, tot = 0;
#pragma unroll
        for (int q = 0; q < 16; ++q) { base += R->pbase[q * 32 + tid]; tot += R->ptot[q * 32 + tid]; }
        R->base[tid] = base; if (bx == 0) b.cnt[tid] = tot; }
    __syncthreads();
    for (int i = tid; i < nslots * 4; i += 512) {
        const int e = R->sel[i], pos = R->base[e] + R->rank[i], slot = i >> 2, tok = R->tok[slot];
        b.list[e * LCAP + pos] = tok; b.gatev[e * LCAP + pos] = R->gw[i]; b.rsl[e * LCAP + pos] = R->rs[slot]; b.toke[tok * 4 + (i & 3)] = e; b.tokp[tok * 4 + (i & 3)] = pos;
    }
}

template <class Base> struct PSched {
    static constexpr bool GATHER = false, FP8 = false; Bufs b; int G, c, K, khook;
    __device__ __forceinline__ bool next(int i, Unit& u) const { const int L = i * G + c; if (L >= Base::NUNITS) return false; Base::get(L, u); return true; }
    __device__ __forceinline__ GemmOp op(const Unit& u) const { return Base::op(b, u); }
};
__device__ __forceinline__ void moe_build(LAS MoeTabL* tab, const int* cnt) {
    if (threadIdx.x < 64) {
        const int lane = threadIdx.x; const int c = (lane < 32) ? (int)__hip_atomic_load((const unsigned*)cnt + lane, __ATOMIC_RELAXED, __HIP_MEMORY_SCOPE_AGENT) : 0;
        const int nt = (c + 255) >> 8; int st = nt, so = c;
#pragma unroll
        for (int o = 1; o < 32; o <<= 1) { const int a = __shfl_up(st, o), d = __shfl_up(so, o); if (lane >= o) { st += a; so += d; } }
        if (lane < 32) { tab->ntile[lane] = nt; tab->cumT[lane + 1] = st; tab->off[lane + 1] = so; }
        if (lane == 0) { tab->cumT[0] = 0; tab->off[0] = 0; }
    }
    __syncthreads();
}
template <int WHICH> struct MoeSched {
    Bufs b; LAS MoeTabL* tab; int G, vcu;
    static constexpr int NPN = WHICH == 1 ? 8 : 4, K = 1024, khook = 0; static constexpr bool GATHER = WHICH == 1, FP8 = MOE_FP8 != 0;
    mutable int ecur = 0;
    __device__ __forceinline__ bool next(int i, Unit& u) const {
        const int L = i * G + vcu; const int total = __builtin_amdgcn_readfirstlane(tab->cumT[32]) * NPN; if (L >= total) return false;
        int e = ecur;
        while (e < 31 && __builtin_amdgcn_readfirstlane(tab->cumT[e + 1]) * NPN <= L) ++e;
        ecur = e;
        const int base = __builtin_amdgcn_readfirstlane(tab->cumT[e]) * NPN, nt = __builtin_amdgcn_readfirstlane(tab->ntile[e]), l = L - base;
        const int cn = __builtin_amdgcn_readfirstlane(tab->off[e + 1]) - __builtin_amdgcn_readfirstlane(tab->off[e]);
        u.kind = 0; u.e = e; u.pn = l / nt; u.pm = l % nt; u.m0 = u.pm * 256; u.rows = min(256, cn - u.m0); return true;
    }
    __device__ __forceinline__ int off_e(const Unit& u) const { return __builtin_amdgcn_readfirstlane(tab->off[u.e]); }
    __device__ __forceinline__ GemmOp op(const Unit& u) const {
        GemmOp g; g.K = 1024; g.khook = 0;
        if (MOE_FP8) {
            if (WHICH == 1) { g.A = (const bf16*)b.h2q; g.rowlist = b.list + u.e * LCAP + u.m0; g.B = (const bf16*)((const unsigned char*)b.WguT + ((size_t)u.e * 2048 + (size_t)u.pn * 256) * 1024); }
            else { g.A = (const bf16*)((const unsigned char*)b.act + (size_t)(off_e(u) + u.m0) * 1024); g.rowlist = nullptr; g.B = (const bf16*)((const unsigned char*)b.WdT + ((size_t)u.e * 1024 + (size_t)u.pn * 256) * 1024); }
            return g; }
        if (WHICH == 1) { g.A = b.h2; g.rowlist = b.list + u.e * LCAP + u.m0; g.B = b.WguT + ((size_t)u.e * 2048 + (size_t)u.pn * 256) * 1024; }
        else { g.A = b.act + (size_t)(off_e(u) + u.m0) * 1024; g.rowlist = nullptr; g.B = b.WdT + ((size_t)u.e * 1024 + (size_t)u.pn * 256) * 1024; }
        return g;
    }
};

#ifndef XB_ACQUIRE
#define XB_ACQUIRE 0
#endif
#define XB_TMO      128
#define XB_XCNT(j)  (256  + 64 * (j))
#define XB_XSUB(j)  (1280 + 64 * (j))
#define XB_XGEN(j)  (2304 + 64 * (j))
#define XB_TOP      3328
#define XB_TOPGEN   3392
#define XCD_BAR_WORDS 3456
#define XB_SPIN_CAP (1u << 18)
__device__ __forceinline__ unsigned xb_ld(unsigned* p)              { return __hip_atomic_load(p, __ATOMIC_RELAXED, __HIP_MEMORY_SCOPE_AGENT); }
__device__ __forceinline__ unsigned xb_add(unsigned* p, unsigned v) { return __hip_atomic_fetch_add(p, v, __ATOMIC_RELAXED, __HIP_MEMORY_SCOPE_AGENT); }
__device__ __forceinline__ unsigned xb_xcc_id() { return (unsigned)__builtin_amdgcn_s_getreg((3 << 11) | 20) & 0xFu; }
#define XB_SPIN(cond, bar) do { unsigned _sp = 0; while (cond) { __builtin_amdgcn_s_sleep(1); \
    if ((++_sp & 255u) == 0u) { if (xb_ld(&(bar)[XB_TMO])) break; if (_sp > XB_SPIN_CAP) { atomicAdd(&(bar)[XB_TMO], 1u); break; } } } } while (0)
struct XcdBarrier { unsigned* bar; unsigned x; volatile LAS unsigned* st; };
__device__ __forceinline__ XcdBarrier xcd_barrier_post(unsigned* bar, volatile LAS unsigned* st) {
    XcdBarrier b; b.bar = bar; b.x = xb_xcc_id(); b.st = st;
    if (threadIdx.x == 0) (void)xb_add(&bar[XB_XCNT(b.x)], 1u);
    return b;
}
__device__ __forceinline__ void xcd_barrier_complete(unsigned* bar, unsigned x, unsigned& nloc, unsigned& nx) {
    const unsigned G = gridDim.x * gridDim.y * gridDim.z;
    unsigned sum, cnt, mine, sp = 0u;
    for (;;) {
        sum = 0u; cnt = 0u; mine = 0u;
#pragma unroll
        for (unsigned j = 0; j < 16; ++j) { const unsigned c = xb_ld(&bar[XB_XCNT(j)]); sum += c; cnt += (c > 0u) ? 1u : 0u; mine = (j == x) ? c : mine; }
        if (sum == G) break;
        __builtin_amdgcn_s_sleep(1);
        if ((++sp & 255u) == 0u) { if (xb_ld(&bar[XB_TMO])) break; if (sp > XB_SPIN_CAP) { atomicAdd(&bar[XB_TMO], 1u); break; } }
    }
    nloc = mine > 0u ? mine : 1u; nx = cnt > 0u ? cnt : 1u;
}
__device__ __forceinline__ void xcd_barrier(const XcdBarrier& b) {
    asm volatile("s_waitcnt vmcnt(0)" ::: "memory");
    __syncthreads();
    if (threadIdx.x == 0) {
        unsigned* bar = b.bar;
        __builtin_amdgcn_s_waitcnt(0);
        unsigned nloc = b.st[0], nx = b.st[1];
        if (nloc == 0u) { xcd_barrier_complete(bar, b.x, nloc, nx); b.st[0] = nloc; b.st[1] = nx; }
        const unsigned old = xb_add(&bar[XB_XSUB(b.x)], 1u);
        const unsigned gen = old / nloc;
        if (old + 1u == (gen + 1u) * nloc) {
            __builtin_amdgcn_fence(__ATOMIC_RELEASE, "agent");
            asm volatile("s_waitcnt vmcnt(0)" ::: "memory");
            const unsigned og = xb_add(&bar[XB_TOP], 1u);
            const unsigned tg = og / nx;
            if (og + 1u == (tg + 1u) * nx) xb_add(&bar[XB_TOPGEN], 1u);
            else XB_SPIN(xb_ld(&bar[XB_TOPGEN]) == tg, bar);
            if (XB_ACQUIRE) __builtin_amdgcn_fence(__ATOMIC_ACQUIRE, "agent");
            xb_add(&bar[XB_XGEN(b.x)], 1u);
            asm volatile("s_waitcnt vmcnt(0)" ::: "memory");
        } else {
            XB_SPIN(xb_ld(&bar[XB_XGEN(b.x)]) == gen, bar);
            if (XB_ACQUIRE) __builtin_amdgcn_fence(__ATOMIC_ACQUIRE, "agent");
            asm volatile("s_waitcnt vmcnt(0)" ::: "memory");
        }
    }
    __syncthreads();
}

constexpr int RING_BYTES = 131072, LDS_BYTES = 147456, MISC_OFF = LDS_BYTES - 2048;
static_assert(2 * TP_LDS <= MISC_OFF && RING_BYTES <= MISC_OFF, "LDS map");
constexpr int NPHASE = 12;
__global__ void __launch_bounds__(512, 2) mega(Params p) {
    extern __shared__ __attribute__((aligned(16))) unsigned char lds_raw[];
    LAS unsigned char* lds = (LAS unsigned char*)lds_raw;
    const Bufs b = make_bufs(p.ws);
    const int tid = threadIdx.x, lane = tid & 63, wave = __builtin_amdgcn_readfirstlane(tid >> 6);
    const int G = gridDim.x, bx = blockIdx.x, vcu = (G % 8 == 0) ? (bx % 8) * (G / 8) + bx / 8 : bx;
    LAS MoeTabL* tab = (LAS MoeTabL*)(lds + MISC_OFF);
    volatile LAS unsigned* xst = (volatile LAS unsigned*)(lds + MISC_OFF + 512);
    if (tid < 2) xst[tid] = 0u;
    __syncthreads();
    XcdBarrier xbar; xbar.bar = (unsigned*)(p.ws + WS_CTL); xbar.x = 0; xbar.st = xst;
    if (p.ph_hi - p.ph_lo > 1) xbar = xcd_barrier_post((unsigned*)(p.ws + WS_CTL), xst);
    const int lo = p.ph_lo, hi = p.ph_hi;
#ifndef REPK
#define REPK -1
#endif
#ifdef TPROBE_A
#define STAMP(i) do { if (bx == 0 && tid == 0) ((unsigned long long*)(p.ws + WS_CTL + 32768))[i] = __builtin_amdgcn_s_memrealtime(); } while (0)
#else
#define STAMP(i) do { } while (0)
#endif
#define SEAM(k) do { if (IN(k) && IN((k) + 1)) xcd_barrier(xbar); STAMP((k) + 1); } while (0)
#ifdef ONLY
#define IN(k) ((k) == ONLY && lo <= (k) && (k) < hi)
#else
#define IN(k) (lo <= (k) && (k) < hi)
#endif
    STAMP(0);
#define RUN(k, ...) do { if (IN(k)) { __VA_ARGS__ if (REPK == (k)) { xcd_barrier(xbar); __VA_ARGS__ } } } while (0)
    RUN(0, { prep_phase(p, b, lds_raw, bx, G); });
    SEAM(0);
    RUN(1, { PSched<SchedIn> S{b, G, bx, 1024, 0}; EpiIn E{p, b}; pg8::gemm_phase(lds, p.ws, S, E);
             if (G == 256 && bx >= FILL1_BLK0) transpose_run(p, b, (float*)lds_raw, 0, FILL1_N, bx - FILL1_BLK0, 256 - FILL1_BLK0, true); });
    SEAM(1);
    RUN(2, { EpiUp E{p, b}; { PSched<SchedUpQ> S{b, G, bx, 384, 0}; pg8::gemm_phase(lds, p.ws, S, E); }
             if (G == 256 && bx >= FILL2_BLK0) { scan_task(b, (bx - FILL2_BLK0) * 8 + wave, (256 - FILL2_BLK0) * 8, lane);
                 kpe_task(b, (bx - FILL2_BLK0) * 512 + tid, (256 - FILL2_BLK0) * 512);
                 if (FILL2_N > 0) transpose_run(p, b, (float*)lds_raw, FILL1_N, FILL2_N, bx - FILL2_BLK0, 256 - FILL2_BLK0, true); }
             else if (G != 256) { scan_task(b, bx * 8 + wave, G * 8, lane); kpe_task(b, bx * 512 + tid, G * 512); }
             { PSched<SchedUpKV> S{b, G, bx, 256, 0}; pg8::gemm_phase(lds, p.ws, S, E); } });
    SEAM(2);
    RUN(3, { attn_phase_self(lds, b, vcu); });
#if ATT_PRB
    if (IN(3)) { xcd_barrier(xbar); attn_phase_self<ATT_PRB>(lds, b, vcu); }
#endif
    SEAM(3);
    RUN(4, { PSched<SchedOut> S{b, G, bx, 1024, 512}; EpiOut E{p, b}; pg8::gemm_phase(lds, p.ws, S, E); });
    SEAM(4);
    RUN(5, { PSched<SchedMq> S{b, G, bx, 1024, 0}; EpiMq E{p, b}; pg8::gemm_phase(lds, p.ws, S, E);
             if (G == 256 && bx >= FILL5_BLK0) transpose_run(p, b, (float*)lds_raw, FILL1_N + FILL2_N, FILL5_N, bx - FILL5_BLK0, 256 - FILL5_BLK0, true); });
    SEAM(5);
    RUN(6, { attn_phase_mem(lds, b, vcu); });
    SEAM(6);
    RUN(7, { PSched<SchedMo> S{b, G, bx, 512, 0}; EpiMo E{p, b}; pg8::gemm_phase(lds, p.ws, S, E); });
    SEAM(7);
    if (IN(8)) { float* lgl = (float*)lds_raw + wave * 544; RouterRec* RR = (RouterRec*)(lds_raw + 16384);
                 if (wave < 4) router_tile(p, b, bx * 4 + wave, lane, lgl, RR, wave);
                 router_rank(b, RR, bx, 64);
                 xcd_barrier(xbar);
                 router_publish(b, RR, bx, G, 64); }
    SEAM(8);
    RUN(9, { moe_build(tab, b.cnt); MoeSched<1> S{b, tab, G, vcu, 0}; EpiG1 E{p, b, tab, 0}; pg8::gemm_phase(lds, p.ws, S, E); });
    SEAM(9);
    RUN(10, { if (!IN(9)) moe_build(tab, b.cnt);     MoeSched<2> S{b, tab, G, vcu, 0}; EpiG2 E{p, b, tab, 0}; pg8::gemm_phase(lds, p.ws, S, E); });
    SEAM(10);
    RUN(11, { if (!IN(9)) moe_build(tab, b.cnt); int tok = bx * 8 + wave; const int ts = G * 8;
              for (; tok + 3 * ts < T; tok += 4 * ts) final_tokens<4>(p, b, tok, ts, lane, (const int*)tab->off);
              for (; tok < T; tok += ts) final_token(p, b, tok, lane, (const int*)tab->off); });
#undef RUN
#ifdef TPROBE_A
    {
        xcd_barrier(xbar); STAMP(12);
        if (bx == 0 && tid == 0) { const unsigned long long* ts = (const unsigned long long*)(p.ws + WS_CTL + 32768);
            const float usa = (float)(ts[TPROBE_A + 1] - ts[TPROBE_A]) * 0.01f, usb = (float)(ts[TPROBE_B + 1] - ts[TPROBE_B]) * 0.01f;
            float* pr = (float*)(p.ws + WS_CTL + 49152); __hip_atomic_store(pr, usa / (float)TPROBE_SCALE, __ATOMIC_RELAXED, __HIP_MEMORY_SCOPE_AGENT); __hip_atomic_store(pr + 1, usb * 0.1f, __ATOMIC_RELAXED, __HIP_MEMORY_SCOPE_AGENT); }
        xcd_barrier(xbar);
        const float* pr = (const float*)(p.ws + WS_CTL + 49152); const float eps = __hip_atomic_load(pr, __ATOMIC_RELAXED, __HIP_MEMORY_SCOPE_AGENT), spike = __hip_atomic_load(pr + 1, __ATOMIC_RELAXED, __HIP_MEMORY_SCOPE_AGENT);
        for (int tok = bx * 8 + wave; tok < T; tok += G * 8) { float* o = p.out + (size_t)tok * D; for (int c = lane; c < D; c += 64) o[c] *= (1.0f + eps); }
        asm volatile("s_waitcnt vmcnt(0)" ::: "memory"); __syncthreads();
        if (bx == 0 && tid == 0) p.out[0] += spike;
    }
#endif
#undef IN
#undef SEAM
}

extern "C" void kernel_launch(void* const* d_in, const int* in_sizes, int n_in, void* d_out, int out_size, void* d_ws, size_t ws_size, hipStream_t stream) {
    static int inited = 0; static int grid = 256;
    if (!inited) {
        if (n_in != 25 || ws_size < WS_END) { fprintf(stderr, "kernel_launch: unexpected n_in %d / ws_size %zu\n", n_in, ws_size); inited = -1; return; }
        (void)hipFuncSetAttribute((const void*)mega, hipFuncAttributeMaxDynamicSharedMemorySize, LDS_BYTES);
        int dev = 0, cus = 0; (void)hipGetDevice(&dev); (void)hipDeviceGetAttribute(&cus, hipDeviceAttributeMultiprocessorCount, dev); int per_cu = 0; (void)hipOccupancyMaxActiveBlocksPerMultiprocessor(&per_cu, (const void*)mega, 512, LDS_BYTES);
        grid = 256;
        if (cus < 256) fprintf(stderr, "kernel_launch: this kernel needs 256 CUs (device reports %d)\n", cus);
        if (per_cu < 1) fprintf(stderr, "kernel_launch: occupancy query reports %d blocks per CU\n", per_cu);
        inited = 1;
    }
    if (inited < 0) return;
    Params p{};
    const float** pp = (const float**)&p;
    for (int i = 0; i < 25; ++i) pp[i] = (const float*)d_in[i];
    p.out = (float*)d_out; p.ws = (unsigned char*)d_ws; p.ph_lo = 0; p.ph_hi = 0;
    (void)hipMemsetAsync((char*)d_ws + WS_CTL, 0, 65536, stream);
    p.ph_lo = 0; p.ph_hi = NPHASE;
    void* args[] = {&p};
    hipError_t e = hipLaunchCooperativeKernel((const void*)mega, dim3(grid), dim3(512), args, LDS_BYTES, stream);
    if (e != hipSuccess) fprintf(stderr, "cooperative launch failed: %s (grid %d)\n", hipGetErrorString(e), grid);
}
```

```cpp
#include <hip/hip_runtime.h>
#include <hip/hip_cooperative_groups.h>
#include <cstdio>
#include <cstdint>

constexpr int NB = 8, S = 2048, D = 1024, T = NB * S;
constexpr int IN_PAD = 2304;
constexpr int MEMT = 256, MROWS = NB * MEMT;
constexpr int NE = 32, TOPK = 4, NPAIR = T * TOPK;
constexpr int LCAP = T;
constexpr float EPS = 1e-6f;
constexpr float LOG2E = 1.4426950408889634f;
constexpr float QS_FOX = 0.125f * LOG2E;
constexpr float QS_MLA = 0.10206207261596577f * LOG2E;
constexpr float QS_MEM = 0.08838834764831845f * LOG2E;
#ifndef P0_REVERSE
#define P0_REVERSE 1
#endif
#ifndef H2Q_IN_ROUTER
#define H2Q_IN_ROUTER 1
#endif
#ifndef ATT_PRB
#define ATT_PRB 0
#endif
#ifndef ATT_PIPE
#define ATT_PIPE 1
#endif
#ifndef MOE_FP8
#define MOE_FP8 1
#endif
constexpr float W8_SCALE = 32.0f, ACT8_SCALE = 4.0f, YP8_SCALE = 16.0f;

typedef unsigned short bf16;
typedef float f32x4 __attribute__((ext_vector_type(4)));
typedef unsigned u32x4 __attribute__((ext_vector_type(4)));
typedef unsigned u32x2 __attribute__((ext_vector_type(2)));

constexpr size_t MiB = 1u << 20;
constexpr size_t WS_CTL = 0;
constexpr size_t WS_BLKCNT = 128 * 1024;
constexpr size_t WS_CNT = 64 * 1024;
constexpr size_t WS_RS1 = 1 * MiB + 5 * 65536, WS_RS3 = 1 * MiB + 6 * 65536, WS_RSMEM = 1 * MiB + 7 * 65536;
constexpr size_t WS_PQ = 11 * MiB, WS_PKV = 12 * MiB, WS_PFOX = 12 * MiB + 524288, WS_PMLA = 13 * MiB, WS_P2 = 14 * MiB;
constexpr size_t WS_COS = 2 * MiB, WS_SIN = 2 * MiB + 131072, WS_WR = 2 * MiB + 262144, WS_LOGF = 3 * MiB, WS_CDEC = 3 * MiB + 524288, WS_KROPE = 4 * MiB;
constexpr size_t WS_TOKE = 6 * MiB, WS_TOKP = 6 * MiB + 262144, WS_LIST = 7 * MiB, WS_GATEV = 9 * MiB;
static_assert(MOE_FP8 == 1, "the packed workspace map holds the fp8 expert weights");
constexpr size_t WS_RSL = 16 * MiB;
constexpr size_t WS_YP = 18 * MiB;
constexpr size_t WS_ACT = 147 * MiB;
constexpr size_t WS_H2 = 276 * MiB;
constexpr size_t WS_OMEM = 308 * MiB;
constexpr size_t WS_QMEM = 324 * MiB;
constexpr size_t WS_H1 = 340 * MiB;
constexpr size_t WS_OMIX = 372 * MiB;
constexpr size_t WS_VM = 404 * MiB;
constexpr size_t WS_KM = 420 * MiB;
constexpr size_t WS_QM = 444 * MiB;
constexpr size_t WS_KVM = 468 * MiB;
constexpr size_t WS_KVLAT = 472 * MiB;
constexpr size_t WS_QLAT = 480 * MiB;
constexpr size_t WS_QF = 492 * MiB;
constexpr size_t WS_KF = WS_QF + 16 * MiB, WS_VF = WS_QF + 32 * MiB;
constexpr size_t WS_WIN = 540 * MiB;
constexpr size_t WS_WUQ = 545 * MiB;
constexpr size_t WS_WUKV = 546 * MiB;
constexpr size_t WS_WO = 547 * MiB;
constexpr size_t WS_WMQ = 549 * MiB;
constexpr size_t WS_WMKV = 550 * MiB;
constexpr size_t WS_WMO = 552 * MiB;
constexpr size_t WS_WD = 554 * MiB;
constexpr size_t WS_WGU = 586 * MiB;
constexpr size_t WS_MEMB = 650 * MiB;
constexpr size_t WS_XB = 654 * MiB;
constexpr size_t WS_END = 686 * MiB;

struct Params {
    const float *x, *mem, *g_mix, *w_in, *b_f, *g_q_lat, *w_uq, *g_kv_lat, *w_ukv, *g_fox_out, *g_mla_out, *w_o, *g_mem_q, *w_mem_q, *g_mem_kv, *w_mem_kv, *w_mem_o,
        *g_ffn, *w_router, *b_router, *w_gate_up, *b_gate_up, *w_down, *b_down, *g_final;
    float* out; unsigned char* ws;
    int ph_lo, ph_hi;
};
struct Bufs {
    int* cnt; int* blkcnt; float *pq, *pkv, *pfox, *pmla, *p2, *rs1, *rs3, *rsmem, *cosT, *sinT, *wr, *logf, *cdec, *krope, *gatev, *rsl;
    int *toke, *tokp, *list;
    bf16 *WinT, *WuqT, *WukvT, *WoT, *WmqT, *WmkvT, *WmoT, *WguT, *WdT;
    bf16 *xb, *memb, *KVm, *Qf, *Kf, *Vf, *qlat, *kvlat, *Qm, *Km, *Vm, *Omix, *h1, *Qmem, *Omem, *h2, *act, *yp; unsigned char* h2q;
};
__host__ __device__ __forceinline__ Bufs make_bufs(unsigned char* ws) {
    Bufs b;
    b.cnt = (int*)(ws + WS_CNT); b.blkcnt = (int*)(ws + WS_BLKCNT);
    b.pq = (float*)(ws + WS_PQ); b.pkv = (float*)(ws + WS_PKV); b.pfox = (float*)(ws + WS_PFOX); b.pmla = (float*)(ws + WS_PMLA);
    b.p2 = (float*)(ws + WS_P2); b.rs1 = (float*)(ws + WS_RS1); b.rs3 = (float*)(ws + WS_RS3); b.rsmem = (float*)(ws + WS_RSMEM);
    b.cosT = (float*)(ws + WS_COS); b.sinT = (float*)(ws + WS_SIN); b.wr = (float*)(ws + WS_WR); b.logf = (float*)(ws + WS_LOGF); b.cdec = (float*)(ws + WS_CDEC);
    b.krope = (float*)(ws + WS_KROPE); b.gatev = (float*)(ws + WS_GATEV); b.rsl = (float*)(ws + WS_RSL);
    b.toke = (int*)(ws + WS_TOKE); b.tokp = (int*)(ws + WS_TOKP); b.list = (int*)(ws + WS_LIST);
    b.WinT = (bf16*)(ws + WS_WIN); b.WuqT = (bf16*)(ws + WS_WUQ); b.WukvT = (bf16*)(ws + WS_WUKV); b.WoT = (bf16*)(ws + WS_WO); b.WmqT = (bf16*)(ws + WS_WMQ);
    b.WmkvT = (bf16*)(ws + WS_WMKV); b.WmoT = (bf16*)(ws + WS_WMO); b.WguT = (bf16*)(ws + WS_WGU); b.WdT = (bf16*)(ws + WS_WD);
    b.xb = (bf16*)(ws + WS_XB); b.memb = (bf16*)(ws + WS_MEMB); b.KVm = (bf16*)(ws + WS_KVM); b.Qf = (bf16*)(ws + WS_QF); b.Kf = (bf16*)(ws + WS_KF); b.Vf = (bf16*)(ws + WS_VF);
    b.qlat = (bf16*)(ws + WS_QLAT); b.kvlat = (bf16*)(ws + WS_KVLAT); b.Qm = (bf16*)(ws + WS_QM); b.Km = (bf16*)(ws + WS_KM); b.Vm = (bf16*)(ws + WS_VM);
    b.Omix = (bf16*)(ws + WS_OMIX); b.h1 = (bf16*)(ws + WS_H1); b.Qmem = (bf16*)(ws + WS_QMEM); b.Omem = (bf16*)(ws + WS_OMEM); b.h2 = (bf16*)(ws + WS_H2);
    b.act = (bf16*)(ws + WS_ACT); b.yp = (bf16*)(ws + WS_YP); b.h2q = ws + WS_ACT + 96 * MiB;
    return b;
}

__device__ __forceinline__ unsigned f2bf(float f) { unsigned u = __builtin_bit_cast(unsigned, f); return (u + 0x7fffu + ((u >> 16) & 1u)) >> 16; }
typedef float f32x2_t __attribute__((ext_vector_type(2)));
typedef __bf16 bf16x2_t __attribute__((ext_vector_type(2)));
__device__ __forceinline__ unsigned pk2(float lo, float hi) { f32x2_t v = {lo, hi}; bf16x2_t b = __builtin_convertvector(v, bf16x2_t); return __builtin_bit_cast(unsigned, b); }
__device__ __forceinline__ float bf2f(unsigned short h) { return __builtin_bit_cast(float, (unsigned)h << 16); }
__device__ __forceinline__ float bflo(unsigned w) { return __builtin_bit_cast(float, w << 16); }
__device__ __forceinline__ float bfhi(unsigned w) { return __builtin_bit_cast(float, w & 0xffff0000u); }
__device__ __forceinline__ float wave_sum(float v) {
#pragma unroll
    for (int o = 1; o < 64; o <<= 1) v += __shfl_xor(v, o);
    return v;
}
__device__ __forceinline__ float wave_max(float v) {
#pragma unroll
    for (int o = 1; o < 64; o <<= 1) v = fmaxf(v, __shfl_xor(v, o));
    return v;
}
__device__ __forceinline__ void unpack8(const u32x4 w, float (&f)[8]) {
    f[0] = bflo(w.x); f[1] = bfhi(w.x); f[2] = bflo(w.y); f[3] = bfhi(w.y); f[4] = bflo(w.z); f[5] = bfhi(w.z); f[6] = bflo(w.w); f[7] = bfhi(w.w);
}
__device__ __forceinline__ u32x2 pack8_fp8(const float (&f)[8]) { unsigned a = 0u, c = 0u; a = __builtin_amdgcn_cvt_pk_fp8_f32(f[0], f[1], a, false); a = __builtin_amdgcn_cvt_pk_fp8_f32(f[2], f[3], a, true);
    c = __builtin_amdgcn_cvt_pk_fp8_f32(f[4], f[5], c, false); c = __builtin_amdgcn_cvt_pk_fp8_f32(f[6], f[7], c, true); u32x2 w; w.x = a; w.y = c; return w; }
__device__ __forceinline__ u32x4 pack8(const float (&f)[8]) { u32x4 w; w.x = pk2(f[0], f[1]); w.y = pk2(f[2], f[3]); w.z = pk2(f[4], f[5]); w.w = pk2(f[6], f[7]); return w; }

__device__ __forceinline__ float sum8(const float* q) { const f32x4 a = *(const f32x4*)q, c = *(const f32x4*)(q + 4); return ((a.x + a.y) + (a.z + a.w)) + ((c.x + c.y) + (c.z + c.w)); }

constexpr int TP_LDS = 64 * 257 * 4;
struct TItem { const float* W; int ldw, Nsrc, K; const float* gain; const float* gain2; bf16* WT; int mapkind; int k0, n0; int fp8; float scale; };
__device__ __forceinline__ int map_row(int kind, int n) {
    if (kind == 0) return n;
    if (kind == 1) {
        if (n < 1536) return n;
        if (n < 1544) return 2208 + (n - 1536);
        if (n < 1928) return 1536 + (n - 1544);
        if (n < 2184) return 1920 + (n - 1928);
        return 2176 + (n - 2184);
    }
    return ((n & 1023) >> 7) * 256 + (n >> 10) * 128 + (n & 127);
}
struct TRegs { f32x4 v[8]; };
__device__ __forceinline__ void titem_load(const TItem& it, TRegs& R) {
    const int tid = threadIdx.x;
#pragma unroll
    for (int j = 0; j < 8; ++j) {
        const int kr = (tid >> 6) + 8 * j, n = it.n0 + (tid & 63) * 4, k = it.k0 + kr;
        R.v[j] = (f32x4){0.f, 0.f, 0.f, 0.f};
        if (n < it.Nsrc) R.v[j] = __builtin_nontemporal_load((const f32x4*)(it.W + (size_t)k * it.ldw + n));
    }
}
__device__ __forceinline__ void titem_to_lds(const TItem& it, const TRegs& R, float* Sm) {
    const int tid = threadIdx.x;
#pragma unroll
    for (int j = 0; j < 8; ++j) {
        const int kr = (tid >> 6) + 8 * j, n4 = (tid & 63) * 4, k = it.k0 + kr;
        float g = it.scale;
        if (it.gain) g *= (it.gain2 && k >= 512) ? it.gain2[k - 512] : it.gain[k];
        float* s = Sm + kr * 257 + n4;
        s[0] = R.v[j].x * g; s[1] = R.v[j].y * g; s[2] = R.v[j].z * g; s[3] = R.v[j].w * g;
    }
}
__device__ __forceinline__ void titem_store(const TItem& it, const float* Sm) {
    const int tid = threadIdx.x;
#pragma unroll
    for (int j = 0; j < 4; ++j) {
        const int r = (tid >> 3) + 64 * j, c = tid & 7, n = it.n0 + r;
        if (n < it.Nsrc) {
            const int row = map_row(it.mapkind, n);
            const float* s = Sm + (8 * c) * 257 + r;
            if (it.fp8) { const float f[8] = {s[0], s[257], s[2 * 257], s[3 * 257], s[4 * 257], s[5 * 257], s[6 * 257], s[7 * 257]};
                __builtin_nontemporal_store(pack8_fp8(f), (u32x2*)((unsigned char*)it.WT + (size_t)row * it.K + it.k0 + 8 * c)); }
            else { u32x4 o; o.x = pk2(s[0], s[257]); o.y = pk2(s[2 * 257], s[3 * 257]); o.z = pk2(s[4 * 257], s[5 * 257]); o.w = pk2(s[6 * 257], s[7 * 257]);
            *(u32x4*)(it.WT + (size_t)row * it.K + it.k0 + 8 * c) = o; }
        }
    }
}
constexpr int TI_WIN = 16 * 9, TI_WUQ = 6 * 3, TI_WUKV = 4 * 4, TI_WO = 16 * 4, TI_WMQ = 16 * 2, TI_WMKV = 16 * 4, TI_WMO = 8 * 4, TI_WGU = 32 * 16 * 8, TI_WD = 32 * 16 * 4;
constexpr int TI_TOTAL = TI_WIN + TI_WUQ + TI_WUKV + TI_WO + TI_WMQ + TI_WMKV + TI_WMO + TI_WGU + TI_WD;
__device__ __forceinline__ TItem get_titem(const Params& p, const Bufs& b, int i) {
    TItem t; t.gain2 = nullptr; t.mapkind = 0; t.fp8 = 0; t.scale = 1.f;
    auto fill = [&](const float* W, int ldw, int Nsrc, int K, const float* g, bf16* WT, int li) { const int nn = (Nsrc + 255) / 256; t.W = W; t.ldw = ldw; t.Nsrc = Nsrc; t.K = K; t.gain = g; t.WT = WT; t.k0 = (li / nn) * 64; t.n0 = (li % nn) * 256; };
    if (i < TI_WIN) { fill(p.w_in, 2216, 2216, 1024, p.g_mix, b.WinT, i); t.mapkind = 1; return t; } i -= TI_WIN;
    if (i < TI_WUQ) { fill(p.w_uq, 768, 768, 384, p.g_q_lat, b.WuqT, i); return t; } i -= TI_WUQ;
    if (i < TI_WUKV) { fill(p.w_ukv, 1024, 1024, 256, p.g_kv_lat, b.WukvT, i); return t; } i -= TI_WUKV;
    if (i < TI_WO) { fill(p.w_o, 1024, 1024, 1024, p.g_fox_out, b.WoT, i); t.gain2 = p.g_mla_out; return t; } i -= TI_WO;
    if (i < TI_WMQ) { fill(p.w_mem_q, 512, 512, 1024, p.g_mem_q, b.WmqT, i); return t; } i -= TI_WMQ;
    if (i < TI_WMKV) { fill(p.w_mem_kv, 1024, 1024, 1024, p.g_mem_kv, b.WmkvT, i); return t; } i -= TI_WMKV;
    if (i < TI_WMO) { fill(p.w_mem_o, 1024, 1024, 512, nullptr, b.WmoT, i); return t; } i -= TI_WMO;
    if (i < TI_WGU) { const int e = i / 128; fill(p.w_gate_up + (size_t)e * 1024 * 2048, 2048, 2048, 1024, p.g_ffn, MOE_FP8 ? (bf16*)((unsigned char*)b.WguT + (size_t)e * 2048 * 1024) : b.WguT + (size_t)e * 2048 * 1024, i % 128); t.mapkind = 2; if (MOE_FP8) { t.fp8 = 1; t.scale = W8_SCALE; } return t; } i -= TI_WGU;
    { const int e = i / 64; fill(p.w_down + (size_t)e * 1024 * 1024, 1024, 1024, 1024, nullptr, MOE_FP8 ? (bf16*)((unsigned char*)b.WdT + (size_t)e * 1024 * 1024) : b.WdT + (size_t)e * 1024 * 1024, i % 64); if (MOE_FP8) { t.fp8 = 1; t.scale = W8_SCALE; } return t; }
}
__device__ __forceinline__ void row_to_bf16(const float* xrow, bf16* orow, float* rs_out, int lane) {
    const f32x4* xr = (const f32x4*)xrow + lane;
    f32x4 v[4]; float s = 0.f;
#pragma unroll
    for (int j = 0; j < 4; ++j) { v[j] = xr[64 * j]; s += (v[j].x * v[j].x + v[j].y * v[j].y) + (v[j].z * v[j].z + v[j].w * v[j].w); }
    s = wave_sum(s);
    if (lane == 0) *rs_out = 1.0f / sqrtf(s * (1.0f / 1024.0f) + EPS);
    u32x2* o8 = (u32x2*)orow + lane;
#pragma unroll
    for (int j = 0; j < 4; ++j) { u32x2 w; w.x = pk2(v[j].x, v[j].y); w.y = pk2(v[j].z, v[j].w); o8[64 * j] = w; }
}
template <int NR>
__device__ __forceinline__ void rows_to_bf16(const float* x, bf16* o, float* rs_out, int r0, int rstride, int lane) {
    f32x4 v[NR][4];
#pragma unroll
    for (int i = 0; i < NR; ++i) { const f32x4* xr = (const f32x4*)(x + (size_t)(r0 + i * rstride) * D) + lane;
#pragma unroll
        for (int j = 0; j < 4; ++j) v[i][j] = __builtin_nontemporal_load(xr + 64 * j); }
#pragma unroll
    for (int i = 0; i < NR; ++i) { float s = 0.f;
#pragma unroll
        for (int j = 0; j < 4; ++j) s += (v[i][j].x * v[i][j].x + v[i][j].y * v[i][j].y) + (v[i][j].z * v[i][j].z + v[i][j].w * v[i][j].w);
        s = wave_sum(s);
        if (lane == 0) rs_out[r0 + i * rstride] = 1.0f / sqrtf(s * (1.0f / 1024.0f) + EPS);
        u32x2* o8 = (u32x2*)(o + (size_t)(r0 + i * rstride) * D) + lane;
#pragma unroll
        for (int j = 0; j < 4; ++j) { u32x2 w; w.x = pk2(v[i][j].x, v[i][j].y); w.y = pk2(v[i][j].z, v[i][j].w); o8[64 * j] = w; } }
}
constexpr int TI_MOE0 = TI_TOTAL - TI_WGU - TI_WD;
constexpr int FILL1_BLK0 = 96, FILL1_PER = 9, FILL1_N = (256 - FILL1_BLK0) * FILL1_PER;
constexpr int FILL2_BLK0 = 192, FILL2_PER = 0, FILL2_N = (256 - FILL2_BLK0) * FILL2_PER;
constexpr int FILL5_BLK0 = 128, FILL5_PER = 14, FILL5_N = (256 - FILL5_BLK0) * FILL5_PER;
constexpr int TI_FILL = FILL1_N + FILL2_N + FILL5_N, TI_P0 = TI_TOTAL - TI_FILL;
static_assert(TI_FILL <= TI_WGU + TI_WD, "filler items are MoE items");
__device__ __forceinline__ void transpose_run(const Params& p, const Bufs& b, float* Sm, int first, int count, int j, int stride, bool moe = false, bool skipfill = true) {
    auto item_of = [&](int v0) { if (moe) return TI_MOE0 + v0; const int v = (skipfill && P0_REVERSE) ? (TI_P0 - 1 - v0) : v0;
        return (v < TI_MOE0 || !skipfill) ? v : v + TI_FILL; };
    int v = first + j; const int end = first + count; TRegs R0, R1; float* Sm1 = Sm + TP_LDS / 4;
    if (v < end) { const TItem t0 = get_titem(p, b, item_of(v)); titem_load(t0, R0); }
    if (v + stride < end) { const TItem t1 = get_titem(p, b, item_of(v + stride)); titem_load(t1, R1); }
    for (; v < end; v += 2 * stride) {
        { const TItem t = get_titem(p, b, item_of(v));
          titem_to_lds(t, R0, Sm); __syncthreads();
          if (v + 2 * stride < end) { const TItem tn = get_titem(p, b, item_of(v + 2 * stride)); titem_load(tn, R0); }
          titem_store(t, Sm); }
        if (v + stride < end) { const TItem t = get_titem(p, b, item_of(v + stride));
          titem_to_lds(t, R1, Sm1); __syncthreads();
          if (v + 3 * stride < end) { const TItem tn = get_titem(p, b, item_of(v + 3 * stride)); titem_load(tn, R1); }
          titem_store(t, Sm1); }
    }
    __syncthreads();
}
__device__ __forceinline__ void prep_phase(const Params& p, const Bufs& b, unsigned char* lds, int vblock, int nblocks) {
    const int tid = threadIdx.x, lane = tid & 63, wave = tid >> 6;
    float* Sm = (float*)lds;
    if (nblocks == 256) transpose_run(p, b, Sm, 0, TI_P0, vblock, nblocks);
    else transpose_run(p, b, Sm, 0, TI_TOTAL, vblock, nblocks, false, false);
    const int gw = vblock * 8 + wave, ngw = nblocks * 8;
    { int r = gw; for (; r + 3 * ngw < T; r += 4 * ngw) rows_to_bf16<4>(p.x, b.xb, b.rs1, r, ngw, lane);
      for (; r < T; r += ngw) row_to_bf16(p.x + (size_t)r * D, b.xb + (size_t)r * D, b.rs1 + r, lane); }
    for (int r = gw; r < MROWS; r += ngw) row_to_bf16(p.mem + (size_t)r * D, b.memb + (size_t)r * D, b.rsmem + r, lane);
    const int gt = vblock * 512 + tid, ngt = nblocks * 512;
    for (int i = gt; i < S * 16; i += ngt) {
        const int s = i >> 4, j = i & 15; const double inv = pow(10000.0, -(double)j / 16.0), ang = (double)s * inv;
        b.cosT[i] = (float)cos(ang); b.sinT[i] = (float)sin(ang);
    }
    for (int i = gt; i < 1024 * 32; i += ngt) { const int e = i >> 10, k = i & 1023; const float w = p.w_router[k * 32 + e] * p.g_ffn[k]; const unsigned h = f2bf(w);
        ((bf16*)b.wr)[i] = (bf16)h; ((bf16*)b.wr)[32768 + i] = (bf16)f2bf(w - bf2f((unsigned short)h)); }
    for (int i = gt; i < (IN_PAD - 2216) * 1024 / 8; i += ngt) ((u32x4*)(b.WinT + (size_t)2216 * 1024))[i] = (u32x4){0u, 0u, 0u, 0u};
}

struct Unit { int kind, pm, pn, e, m0, rows; };
struct GemmOp { const bf16* A; const int* rowlist; const bf16* B; int K; int khook; };

__device__ __forceinline__ void dense_map(int L, int nM, int nN, int& pm, int& pn) {
    const int nwg = nM * nN; int wgid = L; { const int q = nwg / 8, r = nwg % 8, xcd = wgid % 8, off = wgid / 8; wgid = (xcd < r ? xcd * (q + 1) : r * (q + 1) + (xcd - r) * q) + off; }
    const int nig = 8 * nN, gid = wgid / nig, fm = gid * 8, gsz = (nM - fm) < 8 ? (nM - fm) : 8;
    pm = fm + ((wgid % nig) % gsz); pn = (wgid % nig) / gsz;
}
struct SchedIn {
    static constexpr int NUNITS = 64 * 9 + 8 * 4;
    __device__ __forceinline__ static void get(int i, Unit& u) { if (i < 576) { u.kind = 0; dense_map(i, 64, 9, u.pm, u.pn); } else { i -= 576; u.kind = 1; u.pm = i / 4; u.pn = i % 4; } u.e = 0; u.m0 = 0; u.rows = 256; }
    __device__ __forceinline__ static GemmOp op(const Bufs& b, const Unit& u) {
        GemmOp g; g.rowlist = nullptr; g.K = 1024; g.khook = 0;
        if (u.kind == 0) { g.A = b.xb + (size_t)u.pm * 256 * 1024; g.B = b.WinT + (size_t)u.pn * 256 * 1024; }
        else { g.A = b.memb + (size_t)u.pm * 256 * 1024; g.B = b.WmkvT + (size_t)u.pn * 256 * 1024; }
        return g;
    }
};
struct EpiIn {
    static constexpr bool HOOK = false, PAIRED = false, COLS = false, PREFETCH = true; Params p; Bufs b;
    __device__ __forceinline__ float row_val(const Unit& u, int r) const { const int row = u.pm * 256 + r; return u.kind == 1 ? b.rsmem[row] : b.rs1[row]; }
    template <bool FAST> __device__ __forceinline__ void operator()(const Unit& u, int r, int c, float (&v)[8], float s) const {
        const int row = u.pm * 256 + r, gc = u.pn * 256 + c;
        if (u.kind == 1) {
#pragma unroll
            for (int i = 0; i < 8; ++i) v[i] *= s;
            *(u32x4*)(b.KVm + (size_t)row * 1024 + gc) = pack8(v); return; }
#pragma unroll
        for (int i = 0; i < 8; ++i) v[i] *= s;
        if (gc < 1536) {
            bf16* dst = b.Qf + (size_t)(gc >> 9) * (8u << 20);
            if (gc < 512) {
#pragma unroll
                for (int i = 0; i < 8; ++i) v[i] *= QS_FOX;
            }
            *(u32x4*)(dst + (size_t)row * 512 + (gc & 511)) = pack8(v);
        } else if (gc < 2176) {
            const bool isq = gc < 1920;
            float ss = 0.f;
#pragma unroll
            for (int i = 0; i < 8; ++i) ss += v[i] * v[i];
            if (isq) *(u32x4*)(b.qlat + (size_t)row * 384 + (gc - 1536)) = pack8(v);
            else *(u32x4*)(b.kvlat + (size_t)row * 256 + (gc - 1920)) = pack8(v);
            float* dst = isq ? b.pq + (size_t)row * 12 + ((gc - 1536) >> 5) : b.pkv + (size_t)row * 8 + ((gc - 1920) >> 5);
            if (FAST) { ss += __shfl_xor(ss, 16); ss += __shfl_xor(ss, 32); if ((threadIdx.x & 63) < 16) *dst = ss; }
            else *dst += ss;
        } else if (gc < 2208) {
            float* dst = b.krope + (size_t)row * 32 + (gc - 2176);
            *(f32x4*)dst = (f32x4){v[0], v[1], v[2], v[3]}; *(f32x4*)(dst + 4) = (f32x4){v[4], v[5], v[6], v[7]};
        } else if (gc == 2208) {
            float o[8];
#pragma unroll
            for (int i = 0; i < 8; ++i) { const float z = v[i] + p.b_f[i]; o[i] = fminf(z, 0.f) - logf(1.0f + expf(-fabsf(z))); }
            float* dst = b.logf + (size_t)row * 8;
            *(f32x4*)dst = (f32x4){o[0], o[1], o[2], o[3]}; *(f32x4*)(dst + 4) = (f32x4){o[4], o[5], o[6], o[7]};
        }
    }
};
struct SchedUp {
    static constexpr int NUNITS = 64 * 3 + 64 * 4;
    __device__ __forceinline__ static void get(int i, Unit& u) { if (i < 192) { u.kind = 0; dense_map(i, 64, 3, u.pm, u.pn); } else { i -= 192; u.kind = 1; dense_map(i, 64, 4, u.pm, u.pn); } u.e = 0; u.m0 = 0; u.rows = 256; }
    __device__ __forceinline__ static GemmOp op(const Bufs& b, const Unit& u) {
        GemmOp g; g.rowlist = nullptr; g.khook = 0;
        if (u.kind == 0) { g.K = 384; g.A = b.qlat + (size_t)u.pm * 256 * 384; g.B = b.WuqT + (size_t)u.pn * 256 * 384; }
        else { g.K = 256; g.A = b.kvlat + (size_t)u.pm * 256 * 256; g.B = b.WukvT + (size_t)u.pn * 256 * 256; }
        return g;
    }
};
struct SchedUpQ { static constexpr int NUNITS = 192; __device__ __forceinline__ static void get(int i, Unit& u) { SchedUp::get(i, u); } __device__ __forceinline__ static GemmOp op(const Bufs& b, const Unit& u) { return SchedUp::op(b, u); } };
struct SchedUpKV { static constexpr int NUNITS = 256; __device__ __forceinline__ static void get(int i, Unit& u) { SchedUp::get(192 + i, u); } __device__ __forceinline__ static GemmOp op(const Bufs& b, const Unit& u) { return SchedUp::op(b, u); } };
struct EpiUp {
    static constexpr bool HOOK = false, PAIRED = false, COLS = false, PREFETCH = false; Params p; Bufs b;
    __device__ __forceinline__ float row_val(const Unit& u, int r) const {
        const int row = u.pm * 256 + r; float q = 0.f;
        if (u.kind == 0) {
#pragma unroll
            for (int i = 0; i < 3; ++i) { const f32x4 t = *(const f32x4*)(b.pq + (size_t)row * 12 + 4 * i); q += (t.x + t.y) + (t.z + t.w); }
            return (1.0f / sqrtf(q * (1.0f / 384.0f) + EPS)) * QS_MLA; }
        q = sum8(b.pkv + (size_t)row * 8); return 1.0f / sqrtf(q * (1.0f / 256.0f) + EPS);
    }
    template <bool FAST> __device__ __forceinline__ void operator()(const Unit& u, int r, int c, float (&v)[8], float s) const {
        const int row = u.pm * 256 + r, gc = u.pn * 256 + c;
#pragma unroll
        for (int i = 0; i < 8; ++i) v[i] *= s;
        if (u.kind == 0) *(u32x4*)(b.Qm + (size_t)row * 768 + gc) = pack8(v);
        else { const int h = gc >> 7, w = gc & 127;
            if (w < 64) *(u32x4*)(b.Km + (size_t)row * 768 + h * 96 + w) = pack8(v);
            else *(u32x4*)(b.Vm + (size_t)row * 512 + h * 64 + (w - 64)) = pack8(v); }
    }
};
struct SchedOut {
    static constexpr int NUNITS = 64 * 4;
    __device__ __forceinline__ static void get(int i, Unit& u) { u.kind = 0; dense_map(i, 64, 4, u.pm, u.pn); u.e = 0; u.m0 = 0; u.rows = 256; }
    __device__ __forceinline__ static GemmOp op(const Bufs& b, const Unit& u) { GemmOp g; g.rowlist = nullptr; g.K = 1024; g.khook = 512; g.A = b.Omix + (size_t)u.pm * 256 * 1024; g.B = b.WoT + (size_t)u.pn * 256 * 1024; return g; }
};
__device__ __forceinline__ float rs_of(float ssq, float n) { return 1.0f / sqrtf(ssq / n + EPS); }

#ifndef LAS
#define LAS __attribute__((address_space(3)))
#endif
struct EpiOut {
    static constexpr bool HOOK = true, PAIRED = false, COLS = false, PREFETCH = false; Params p; Bufs b; const LAS float* rtab;
    __device__ __forceinline__ float hook_ratio(const Unit& u, int r) const { if (rtab) return rtab[r]; const int row = u.pm * 256 + r; return rs_of(sum8(b.pfox + (size_t)row * 8), 512.f) / rs_of(sum8(b.pmla + (size_t)row * 8), 512.f); }
    __device__ __forceinline__ float row_val(const Unit& u, int r) const { if (rtab) return rtab[256 + r]; return rs_of(sum8(b.pmla + (size_t)(u.pm * 256 + r) * 8), 512.f); }
    static constexpr bool RESID = true;
    __device__ __forceinline__ u32x4 resid(const Unit& u, int r, int c) const { return *(const u32x4*)(b.xb + (size_t)(u.pm * 256 + r) * D + u.pn * 256 + c); }
    template <bool FAST> __device__ __forceinline__ void operator()(const Unit& u, int r, int c, float (&v)[8], float s, const u32x4& xraw) const {
        const int row = u.pm * 256 + r, gc = u.pn * 256 + c;
        float xf[8]; unpack8(xraw, xf);
#pragma unroll
        for (int i = 0; i < 8; ++i) v[i] = xf[i] + v[i] * s;
        float ss = 0.f;
#pragma unroll
        for (int i = 0; i < 8; ++i) ss += v[i] * v[i];
        *(u32x4*)(b.h1 + (size_t)row * D + gc) = pack8(v);
        float* dst = b.p2 + (size_t)row * 32 + (gc >> 5);
        if (FAST) { ss += __shfl_xor(ss, 16); ss += __shfl_xor(ss, 32); if ((threadIdx.x & 63) < 16) *dst = ss; }
        else *dst += ss;
    }
};
struct SchedMq {
    static constexpr int NUNITS = 64 * 2;
    __device__ __forceinline__ static void get(int i, Unit& u) { u.kind = 0; dense_map(i, 64, 2, u.pm, u.pn); u.e = 0; u.m0 = 0; u.rows = 256; }
    __device__ __forceinline__ static GemmOp op(const Bufs& b, const Unit& u) { GemmOp g; g.rowlist = nullptr; g.K = 1024; g.khook = 0; g.A = b.h1 + (size_t)u.pm * 256 * 1024; g.B = b.WmqT + (size_t)u.pn * 256 * 1024; return g; }
};
struct EpiMq {
    static constexpr bool HOOK = false, PAIRED = false, COLS = false, PREFETCH = false; Params p; Bufs b;
    __device__ __forceinline__ float row_val(const Unit& u, int r) const { const int row = u.pm * 256 + r; float q = 0.f;
#pragma unroll
        for (int i = 0; i < 4; ++i) q += sum8(b.p2 + (size_t)row * 32 + 8 * i);
        return rs_of(q, 1024.f) * QS_MEM; }
    template <bool FAST> __device__ __forceinline__ void operator()(const Unit& u, int r, int c, float (&v)[8], float s) const {
        const int row = u.pm * 256 + r, gc = u.pn * 256 + c;
#pragma unroll
        for (int i = 0; i < 8; ++i) v[i] *= s;
        *(u32x4*)(b.Qmem + (size_t)row * 512 + gc) = pack8(v);
    }
};
struct SchedMo {
    static constexpr int NUNITS = 64 * 4;
    __device__ __forceinline__ static void get(int i, Unit& u) { u.kind = 0; dense_map(i, 64, 4, u.pm, u.pn); u.e = 0; u.m0 = 0; u.rows = 256; }
    __device__ __forceinline__ static GemmOp op(const Bufs& b, const Unit& u) { GemmOp g; g.rowlist = nullptr; g.K = 512; g.khook = 0; g.A = b.Omem + (size_t)u.pm * 256 * 512; g.B = b.WmoT + (size_t)u.pn * 256 * 512; return g; }
};
struct EpiMo {
    static constexpr bool HOOK = false, PAIRED = false, COLS = false, PREFETCH = false, RESID = true; Params p; Bufs b;
    __device__ __forceinline__ float row_val(const Unit&, int) const { return 0.f; }
    __device__ __forceinline__ u32x4 resid(const Unit& u, int r, int c) const { return *(const u32x4*)(b.h1 + (size_t)(u.pm * 256 + r) * D + u.pn * 256 + c); }
    template <bool FAST> __device__ __forceinline__ void operator()(const Unit& u, int r, int c, float (&v)[8], float, const u32x4& hraw) const {
        const int row = u.pm * 256 + r, gc = u.pn * 256 + c; float h[8]; unpack8(hraw, h);
#pragma unroll
        for (int i = 0; i < 8; ++i) v[i] += h[i];
        *(u32x4*)(b.h2 + (size_t)row * D + gc) = pack8(v);
        if (MOE_FP8 && !H2Q_IN_ROUTER) *(u32x2*)(b.h2q + (size_t)row * D + gc) = pack8_fp8(v);
    }
};
#ifndef LAS
#define LAS __attribute__((address_space(3)))
#endif
struct MoeTabL { int ntile[32]; int cumT[33]; int off[33]; };
__device__ __forceinline__ void moe_unit(const int* cnt, int npn, int i, Unit& u, int& valid) {
    int base = 0; valid = 0;
    for (int e = 0; e < NE; ++e) { const int c = cnt[e], nt = (c + 255) >> 8, nu = nt * npn; if (i < base + nu) { const int l = i - base; u.kind = 0; u.e = e; u.pn = l / nt; u.pm = l % nt; u.m0 = u.pm * 256; u.rows = min(256, c - u.m0); valid = 1; return; } base += nu; }
}
__device__ __forceinline__ int moe_off(const int* cnt, int e) { int o = 0; for (int i = 0; i < e; ++i) o += cnt[i]; return o; }
struct EpiG1 {
    static constexpr bool HOOK = false, PAIRED = true, PREFETCH = true; Params p; Bufs b; LAS MoeTabL* tab; int off_fixed;
    __device__ __forceinline__ float row_val(const Unit& u, int r) const { return b.rsl[u.e * LCAP + u.m0 + r] * (MOE_FP8 ? 1.0f / W8_SCALE : 1.0f); }
    __device__ __forceinline__ void col_vals(const Unit& u, int c, float (&bg)[8], float (&bu)[8]) const {
        const float* q = p.b_gate_up + (size_t)u.e * 2048 + u.pn * 128 + c; const f32x4 a0 = *(const f32x4*)q, a1 = *(const f32x4*)(q + 4), u0 = *(const f32x4*)(q + 1024), u1 = *(const f32x4*)(q + 1028);
#pragma unroll
        for (int i = 0; i < 4; ++i) { bg[i] = a0[i]; bg[4 + i] = a1[i]; bu[i] = u0[i]; bu[4 + i] = u1[i]; } }
    __device__ __forceinline__ void pair(const Unit& u, int r, int c, float (&vg)[8], float (&vu)[8], float rsw, const float (&bg)[8], const float (&bu)[8]) const {
        typedef float f2 __attribute__((ext_vector_type(2)));
        const int off_e = tab->off[u.e], col = u.pn * 128 + c;
        constexpr float OS = MOE_FP8 ? ACT8_SCALE : 1.0f;
        float o[8];
#pragma unroll
        for (int i = 0; i < 8; i += 2) {
            f2 g = (f2){vg[i], vg[i + 1]} * rsw + (f2){bg[i], bg[i + 1]}, uu = (f2){vu[i], vu[i + 1]} * rsw + (f2){bu[i], bu[i + 1]};
            g.x = fminf(g.x, 7.0f); g.y = fminf(g.y, 7.0f); uu.x = fminf(fmaxf(uu.x, -7.0f), 7.0f); uu.y = fminf(fmaxf(uu.y, -7.0f), 7.0f);
            const f2 a = g * (-1.702f * LOG2E); f2 e; e.x = __builtin_amdgcn_exp2f(a.x); e.y = __builtin_amdgcn_exp2f(a.y);
            const f2 d = e + 1.0f; f2 sg; sg.x = __builtin_amdgcn_rcpf(d.x); sg.y = __builtin_amdgcn_rcpf(d.y);
            const f2 res = (g * sg) * (uu * OS + OS);
            o[i] = res.x; o[i + 1] = res.y; }
        if (r < u.rows) {
            if (MOE_FP8) *(u32x2*)((unsigned char*)b.act + (size_t)(off_e + u.m0 + r) * 1024 + col) = pack8_fp8(o);
            else *(u32x4*)(b.act + (size_t)(off_e + u.m0 + r) * 1024 + col) = pack8(o); }
    }
};
struct EpiG2 {
    static constexpr bool HOOK = false, PAIRED = false, COLS = true, PREFETCH = true; Params p; Bufs b; LAS MoeTabL* tab; int off_fixed;
    __device__ __forceinline__ float row_val(const Unit& u, int r) const { return b.gatev[u.e * LCAP + u.m0 + r]; }
    __device__ __forceinline__ void col_vals(const Unit& u, int c, float (&bd)[8]) const {
        const float* q = p.b_down + (size_t)u.e * 1024 + u.pn * 256 + c; const f32x4 a0 = *(const f32x4*)q, a1 = *(const f32x4*)(q + 4);
#pragma unroll
        for (int i = 0; i < 4; ++i) { bd[i] = a0[i]; bd[4 + i] = a1[i]; } }
    template <bool FAST> __device__ __forceinline__ void operator()(const Unit& u, int r, int c, float (&v)[8], float gw, const float (&bd)[8]) const {
        const int off_e = tab->off[u.e], col = u.pn * 256 + c;
        const float sc = MOE_FP8 ? 1.0f / (W8_SCALE * ACT8_SCALE) : 1.0f;
#pragma unroll
        for (int i = 0; i < 8; ++i) v[i] = (v[i] * sc + bd[i]) * (gw * (MOE_FP8 ? YP8_SCALE : 1.0f));
        if (r < u.rows) { if (MOE_FP8) *(u32x2*)((unsigned char*)b.yp + (size_t)(off_e + u.m0 + r) * 1024 + col) = pack8_fp8(v); else *(u32x4*)(b.yp + (size_t)(off_e + u.m0 + r) * 1024 + col) = pack8(v); }
    }
};

__device__ __forceinline__ void kpe_task(const Bufs& b, int gt, int ngt) {
    for (int i = gt; i < T * 8; i += ngt) {
        const int row = i >> 3, h = i & 7, pos = row & (S - 1);
        const float* kr = b.krope + (size_t)row * 32; const float* cs = b.cosT + pos * 16; const float* sn = b.sinT + pos * 16;
        float y1[16], y2[16];
#pragma unroll
        for (int q = 0; q < 4; ++q) { const f32x4 x1 = *(const f32x4*)(kr + 4 * q), x2 = *(const f32x4*)(kr + 16 + 4 * q), c = *(const f32x4*)(cs + 4 * q), sv = *(const f32x4*)(sn + 4 * q);
#pragma unroll
            for (int j = 0; j < 4; ++j) { y1[4 * q + j] = x1[j] * c[j] - x2[j] * sv[j]; y2[4 * q + j] = x2[j] * c[j] + x1[j] * sv[j]; } }
        u32x4* dst = (u32x4*)(b.Km + (size_t)row * 768 + h * 96 + 64);
        dst[0] = (u32x4){pk2(y1[0], y1[1]), pk2(y1[2], y1[3]), pk2(y1[4], y1[5]), pk2(y1[6], y1[7])}; dst[1] = (u32x4){pk2(y1[8], y1[9]), pk2(y1[10], y1[11]), pk2(y1[12], y1[13]), pk2(y1[14], y1[15])};
        dst[2] = (u32x4){pk2(y2[0], y2[1]), pk2(y2[2], y2[3]), pk2(y2[4], y2[5]), pk2(y2[6], y2[7])}; dst[3] = (u32x4){pk2(y2[8], y2[9]), pk2(y2[10], y2[11]), pk2(y2[12], y2[13]), pk2(y2[14], y2[15])};
    }
}
__device__ __forceinline__ void scan_task(const Bufs& b, int gw, int ngw, int lane) {
    for (int q = gw; q < NB * 8; q += ngw) {
        const int bb = q >> 3, h = q & 7; const float* src = b.logf + (size_t)(bb * S + lane * 32) * 8 + h;
        float v[32];
#pragma unroll
        for (int i = 0; i < 32; ++i) v[i] = src[i * 8];
#pragma unroll
        for (int i = 1; i < 32; ++i) v[i] += v[i - 1];
        float tot = v[31], ex = tot;
#pragma unroll
        for (int o = 1; o < 64; o <<= 1) { const float t = __shfl_up(ex, o); if (lane >= o) ex += t; }
        ex -= tot;
        f32x4* dst = (f32x4*)(b.cdec + (size_t)q * S + lane * 32);
#pragma unroll
        for (int i = 0; i < 8; ++i) dst[i] = (f32x4){(ex + v[4 * i]) * LOG2E, (ex + v[4 * i + 1]) * LOG2E, (ex + v[4 * i + 2]) * LOG2E, (ex + v[4 * i + 3]) * LOG2E};
    }
}
__device__ __forceinline__ void final_token(const Params& p, const Bufs& b, int tok, int lane, const int* offs  ) {
    float v[16];
#pragma unroll
    for (int hf = 0; hf < 2; ++hf) { float a[8]; unpack8(*(const u32x4*)(b.h2 + (size_t)tok * D + hf * 512 + lane * 8), a);
#pragma unroll
        for (int i = 0; i < 8; ++i) v[hf * 8 + i] = a[i]; }
#pragma unroll
    for (int k = 0; k < 4; ++k) { const int e = b.toke[tok * 4 + k], slot = offs[e] + b.tokp[tok * 4 + k];
#pragma unroll
        for (int hf = 0; hf < 2; ++hf) {
            if (MOE_FP8) { const u32x2 w = *(const u32x2*)((const unsigned char*)b.yp + (size_t)slot * D + hf * 512 + lane * 8);
                const auto f0 = __builtin_amdgcn_cvt_pk_f32_fp8(w.x, false), f1 = __builtin_amdgcn_cvt_pk_f32_fp8(w.x, true), f2 = __builtin_amdgcn_cvt_pk_f32_fp8(w.y, false), f3 = __builtin_amdgcn_cvt_pk_f32_fp8(w.y, true);
                v[hf * 8 + 0] += f0[0] * (1.0f / YP8_SCALE); v[hf * 8 + 1] += f0[1] * (1.0f / YP8_SCALE); v[hf * 8 + 2] += f1[0] * (1.0f / YP8_SCALE); v[hf * 8 + 3] += f1[1] * (1.0f / YP8_SCALE);
                v[hf * 8 + 4] += f2[0] * (1.0f / YP8_SCALE); v[hf * 8 + 5] += f2[1] * (1.0f / YP8_SCALE); v[hf * 8 + 6] += f3[0] * (1.0f / YP8_SCALE); v[hf * 8 + 7] += f3[1] * (1.0f / YP8_SCALE); }
            else { float a[8]; unpack8(*(const u32x4*)(b.yp + (size_t)slot * D + hf * 512 + lane * 8), a);
#pragma unroll
                for (int i = 0; i < 8; ++i) v[hf * 8 + i] += a[i]; } } }
    float ss = 0.f;
#pragma unroll
    for (int i = 0; i < 16; ++i) ss += v[i] * v[i];
    ss = wave_sum(ss);
    const float rs = 1.0f / sqrtf(ss * (1.0f / 1024.0f) + EPS);
#pragma unroll
    for (int hf = 0; hf < 2; ++hf) { const float* g = p.g_final + hf * 512 + lane * 8; float* o = p.out + (size_t)tok * D + hf * 512 + lane * 8;
        const f32x4 g0 = *(const f32x4*)g, g1 = *(const f32x4*)(g + 4);
        *(f32x4*)o = (f32x4){v[hf * 8 + 0] * rs * g0.x, v[hf * 8 + 1] * rs * g0.y, v[hf * 8 + 2] * rs * g0.z, v[hf * 8 + 3] * rs * g0.w};
        *(f32x4*)(o + 4) = (f32x4){v[hf * 8 + 4] * rs * g1.x, v[hf * 8 + 5] * rs * g1.y, v[hf * 8 + 6] * rs * g1.z, v[hf * 8 + 7] * rs * g1.w}; }
}
template <int NB>
__device__ __forceinline__ void final_tokens(const Params& p, const Bufs& b, int tok0, int tstride, int lane, const int* offs  ) {
    static_assert(MOE_FP8, "batched final pass reads the fp8 expert outputs");
    int sl[NB][4];
#pragma unroll
    for (int i = 0; i < NB; ++i)
#pragma unroll
        for (int k = 0; k < 4; ++k) { const int tok = tok0 + i * tstride; sl[i][k] = offs[b.toke[tok * 4 + k]] + b.tokp[tok * 4 + k]; }
    u32x4 hr[NB][2]; u32x2 yr[NB][4][2];
#pragma unroll
    for (int i = 0; i < NB; ++i) { const int tok = tok0 + i * tstride;
#pragma unroll
        for (int hf = 0; hf < 2; ++hf) { hr[i][hf] = *(const u32x4*)(b.h2 + (size_t)tok * D + hf * 512 + lane * 8);
#pragma unroll
            for (int k = 0; k < 4; ++k) yr[i][k][hf] = *(const u32x2*)((const unsigned char*)b.yp + (size_t)sl[i][k] * D + hf * 512 + lane * 8); } }
#pragma unroll
    for (int i = 0; i < NB; ++i) { const int tok = tok0 + i * tstride;
        float v[16];
#pragma unroll
        for (int hf = 0; hf < 2; ++hf) { float a[8]; unpack8(hr[i][hf], a);
#pragma unroll
            for (int j = 0; j < 8; ++j) v[hf * 8 + j] = a[j];
#pragma unroll
            for (int k = 0; k < 4; ++k) { const u32x2 w = yr[i][k][hf];
                const auto f0 = __builtin_amdgcn_cvt_pk_f32_fp8(w.x, false), f1 = __builtin_amdgcn_cvt_pk_f32_fp8(w.x, true), f2 = __builtin_amdgcn_cvt_pk_f32_fp8(w.y, false), f3 = __builtin_amdgcn_cvt_pk_f32_fp8(w.y, true);
                v[hf * 8 + 0] += f0[0] * (1.0f / YP8_SCALE); v[hf * 8 + 1] += f0[1] * (1.0f / YP8_SCALE); v[hf * 8 + 2] += f1[0] * (1.0f / YP8_SCALE); v[hf * 8 + 3] += f1[1] * (1.0f / YP8_SCALE);
                v[hf * 8 + 4] += f2[0] * (1.0f / YP8_SCALE); v[hf * 8 + 5] += f2[1] * (1.0f / YP8_SCALE); v[hf * 8 + 6] += f3[0] * (1.0f / YP8_SCALE); v[hf * 8 + 7] += f3[1] * (1.0f / YP8_SCALE); } }
        float ss = 0.f;
#pragma unroll
        for (int j = 0; j < 16; ++j) ss += v[j] * v[j];
        ss = wave_sum(ss);
        const float rs = 1.0f / sqrtf(ss * (1.0f / 1024.0f) + EPS);
#pragma unroll
        for (int hf = 0; hf < 2; ++hf) { const float* g = p.g_final + hf * 512 + lane * 8; float* o = p.out + (size_t)tok * D + hf * 512 + lane * 8;
            const f32x4 g0 = *(const f32x4*)g, g1 = *(const f32x4*)(g + 4);
            *(f32x4*)o = (f32x4){v[hf * 8 + 0] * rs * g0.x, v[hf * 8 + 1] * rs * g0.y, v[hf * 8 + 2] * rs * g0.z, v[hf * 8 + 3] * rs * g0.w};
            *(f32x4*)(o + 4) = (f32x4){v[hf * 8 + 4] * rs * g1.x, v[hf * 8 + 5] * rs * g1.y, v[hf * 8 + 6] * rs * g1.z, v[hf * 8 + 7] * rs * g1.w}; }
    }
}
typedef short bf16x8 __attribute__((ext_vector_type(8)));
typedef int v4i_t __attribute__((ext_vector_type(4)));
typedef int v8i_t __attribute__((ext_vector_type(8)));
namespace pg8 {
constexpr int BM = 256, BK = 64, HALF = 128, HTB = HALF * BK * 2, STAGE_BYTES = 8 * HTB;
__host__ __device__ __forceinline__ int lds_byte(int r, int c) { const int st = (r >> 4) * 2 + (c >> 5), rr = r & 15, cc = c & 31, ob = rr * 64 + cc * 2; return st * 1024 + (ob ^ (((ob >> 9) & 1) << 5)); }
__host__ __device__ __forceinline__ void stage_rc(int b, int& R, int& C) { const int st = b / 1024, sb = b % 1024, swz = sb ^ (((sb >> 9) & 1) << 5); R = (st >> 1) * 16 + swz / 64; C = (st & 1) * 32 + (swz % 64) / 2; }
__host__ __device__ __forceinline__ int perm32(int rho) { const int n = rho >> 4, i = rho & 15; return 8 * (i >> 2) + 4 * n + (i & 3); }

template <class T, class = void> struct pg8_resid { static constexpr bool value = false; };
template <class T> struct pg8_resid<T, decltype((void)T::RESID)> { static constexpr bool value = T::RESID; };
template <class Sched, class Epi>
__device__ __forceinline__ void gemm_phase(LAS unsigned char* lds, const unsigned char* ws, const Sched& S, const Epi& E) {
    const int tid = threadIdx.x, wid = __builtin_amdgcn_readfirstlane(tid >> 6), lane = tid & 63, wr = wid >> 2, wc = wid & 3, fr = lane & 15, fq = lane >> 4;
    int RA[2], CA[2], RB[2];
#pragma unroll
    for (int i = 0; i < 2; ++i) { int R, C; stage_rc(tid * 16 + i * 8192, R, C); RA[i] = R; CA[i] = C; RB[i] = (R & ~31) + perm32(R & 31); }
    const unsigned ldsw = (unsigned)wid * 1024u;
    const __amdgpu_buffer_rsrc_t wsrc = __builtin_amdgcn_make_buffer_rsrc((void*)ws, 0, 0x7ffffffe, 0x00020000);
    constexpr bool F8 = Sched::FP8; constexpr int EB = F8 ? 1 : 2;
    const int aoff = lds_byte(wr * 64 + fr, fq * 8), boff = lds_byte(wc * 32 + fr, fq * 8);
    int boffB = boff + 4 * HTB; asm volatile("" : "+v"(boffB));
#define PG8_SA(b, h) (((b) * 2 + (h)) * HTB)
#define PG8_SB(b, h) ((4 + (b) * 2 + (h)) * HTB)
#define PG8_SBR(b, h) (((b) * 2 + (h)) * HTB)
#define PG8_STAGE(bufoff, soff, v0, v1) do { \
        __builtin_amdgcn_raw_ptr_buffer_load_lds(wsrc, (LAS void*)(lds + (bufoff) + ldsw), 16, (int)(v0), (int)(soff), 0, 0); \
        __builtin_amdgcn_raw_ptr_buffer_load_lds(wsrc, (LAS void*)(lds + (bufoff) + ldsw + 8192), 16, (int)(v1), (int)(soff), 0, 0); } while (0)
#define PG8_LD16(off) (*(const LAS v4i_t*)(lds + (off)))
#define PG8_LDA(dst, b, h) do { _Pragma("unroll") for (int m = 0; m < 4; ++m) { if constexpr (F8) dst##8[m] = __builtin_shufflevector(PG8_LD16(PG8_SA(b, h) + aoff + m * 2048), PG8_LD16(PG8_SA(b, h) + aoff + m * 2048 + 1024), 0, 1, 2, 3, 4, 5, 6, 7); \
        else { _Pragma("unroll") for (int k = 0; k < 2; ++k) dst[m][k] = *(const LAS bf16x8*)(lds + PG8_SA(b, h) + aoff + m * 2048 + k * 1024); } } } while (0)
#define PG8_LDB(dst, b, h) do { _Pragma("unroll") for (int n = 0; n < 2; ++n) { if constexpr (F8) dst##8[n] = __builtin_shufflevector(PG8_LD16(boffB + PG8_SBR(b, h) + n * 2048), PG8_LD16(boffB + PG8_SBR(b, h) + n * 2048 + 1024), 0, 1, 2, 3, 4, 5, 6, 7); \
        else { _Pragma("unroll") for (int k = 0; k < 2; ++k) dst[n][k] = *(const LAS bf16x8*)(lds + boffB + PG8_SBR(b, h) + n * 2048 + k * 1024); } } } while (0)
#define PG8_CAT(x, y) __builtin_shufflevector(__builtin_bit_cast(v4i_t, x), __builtin_bit_cast(v4i_t, y), 0, 1, 2, 3, 4, 5, 6, 7)
#define PG8_MMA(ai, bj, At, Bt) do { __builtin_amdgcn_s_setprio(1); _Pragma("unroll") for (int m = 0; m < 4; ++m) _Pragma("unroll") for (int n = 0; n < 2; ++n) { \
        if constexpr (F8) asm volatile("v_mfma_scale_f32_16x16x128_f8f6f4 %0, %1, %2, %0, %3, %3 op_sel_hi:[0,0,0]" : "+v"(acc[ai][bj][m][n]) : "v"(Bt##8[n]), "v"(At##8[m]), "v"(sc1));   \
        else { _Pragma("unroll") for (int k = 0; k < 2; ++k) acc[ai][bj][m][n] = __builtin_amdgcn_mfma_f32_16x16x32_bf16(Bt[n][k], At[m][k], acc[ai][bj][m][n], 0, 0, 0); } } \
        __builtin_amdgcn_s_setprio(0); } while (0)
#define PG8_EPI_LOADS do { int rb_ = wr * 64 + fr, cb_ = wc * 32 + 8 * fq; asm volatile("" : "+v"(rb_), "+v"(cb_)); \
        _Pragma("unroll") for (int ai = 0; ai < 2; ++ai) _Pragma("unroll") for (int m = 0; m < 4; ++m) rv[ai][m] = E.row_val(cur, ai * HALF + m * 16 + rb_); \
        if constexpr (Epi::PAIRED) E.col_vals(cur, cb_, cv0, cv1); else if constexpr (Epi::COLS) { E.col_vals(cur, cb_, cv0); E.col_vals(cur, HALF + cb_, cv1); } } while (0)
#define PG8_WAIT_V(n) asm volatile("s_waitcnt vmcnt(" #n ")" ::: "memory")
#define PG8_WAIT_L(n) asm volatile("s_waitcnt lgkmcnt(" #n ")" ::: "memory")
#define PG8_BAR __builtin_amdgcn_s_barrier()
#define PG8_SCHED __builtin_amdgcn_sched_barrier(0)
    Unit cur, nxt; int ui = 0;
    if (!S.next(0, cur)) return;
    f32x4 acc[2][2][4][2];
#pragma unroll
    for (int a = 0; a < 2; ++a)
#pragma unroll
        for (int b = 0; b < 2; ++b)
#pragma unroll
            for (int m = 0; m < 4; ++m)
#pragma unroll
                for (int n = 0; n < 2; ++n) acc[a][b][m][n] = (f32x4){0.f, 0.f, 0.f, 0.f};
    int sc1 = 0x7f7f7f7f; asm volatile("" : "+v"(sc1));
    bf16x8 At[4][2], B0[2][2], B1[2][2]; v8i_t At8[4], B08[2], B18[2];
    const int K = S.K, nt = K * EB / 128, khook_t = S.khook ? S.khook / BK : -1;
    const unsigned vB0 = (unsigned)(RB[0] * K * EB + CA[0] * 2), vB1 = (unsigned)(RB[1] * K * EB + CA[1] * 2);
    const unsigned hstep = (unsigned)(HALF * K * EB);
    constexpr unsigned kstep = (unsigned)(BK * 2);
    unsigned cA, cB, nA, nB;
    unsigned vA00 = (unsigned)(RA[0] * K * EB + CA[0] * 2), vA01 = (unsigned)(RA[1] * K * EB + CA[1] * 2), vA10 = vA00 + (unsigned)hstep, vA11 = vA01 + (unsigned)hstep;
    unsigned nvA00 = vA00, nvA01 = vA01, nvA10 = vA10, nvA11 = vA11;
#define PG8_SETUP(u, pA, pB, a00, a01, a10, a11) do { const GemmOp g_ = S.op(u); pA = (unsigned)((const unsigned char*)g_.A - ws); pB = (unsigned)((const unsigned char*)g_.B - ws); \
        if constexpr (Sched::GATHER) { const int mx_ = (u).rows - 1; const int r00 = g_.rowlist[min(RA[0], mx_)], r01 = g_.rowlist[min(RA[1], mx_)], r10 = g_.rowlist[min(HALF + RA[0], mx_)], r11 = g_.rowlist[min(HALF + RA[1], mx_)]; \
            a00 = (unsigned)(r00 * K * EB + CA[0] * 2); a01 = (unsigned)(r01 * K * EB + CA[1] * 2); a10 = (unsigned)(r10 * K * EB + CA[0] * 2); a11 = (unsigned)(r11 * K * EB + CA[1] * 2); } } while (0)
    PG8_SETUP(cur, cA, cB, vA00, vA01, vA10, vA11);
    PG8_STAGE(PG8_SB(0, 0), cB, vB0, vB1); PG8_STAGE(PG8_SB(0, 1), cB + hstep, vB0, vB1); PG8_STAGE(PG8_SA(0, 0), cA, vA00, vA01); PG8_STAGE(PG8_SA(0, 1), cA, vA10, vA11);
    if (wr == 1) PG8_BAR;
    PG8_WAIT_V(2); PG8_BAR;
    PG8_STAGE(PG8_SB(1, 0), cB + kstep, vB0, vB1); PG8_STAGE(PG8_SA(1, 0), cA + kstep, vA00, vA01); PG8_STAGE(PG8_SB(1, 1), cB + hstep + kstep, vB0, vB1);
    PG8_WAIT_V(6); PG8_BAR;
    for (;;) {
        const bool has_next = S.next(ui + 1, nxt);
        float rv[2][4], cv0[8], cv1[8];
        if (has_next) PG8_SETUP(nxt, nA, nB, nvA00, nvA01, nvA10, nvA11);
        else { nA = cA; nB = cB; if constexpr (Sched::GATHER) { nvA00 = vA00; nvA01 = vA01; nvA10 = vA10; nvA11 = vA11; } }
#pragma clang loop unroll(disable)
        for (int t = 0; t < nt; t += 2) {
            const bool last = (t == nt - 2);
            if constexpr (Epi::HOOK) { if (t == khook_t) { int rbh = wr * 64 + fr; asm volatile("" : "+v"(rbh));
#pragma unroll
                for (int ai = 0; ai < 2; ++ai)
#pragma unroll
                    for (int m = 0; m < 4; ++m) { const int rh = ai * HALF + m * 16 + rbh; const float rt = E.hook_ratio(cur, rh);
#pragma unroll
                        for (int bj = 0; bj < 2; ++bj)
#pragma unroll
                            for (int n = 0; n < 2; ++n) acc[ai][bj][m][n] = acc[ai][bj][m][n] * rt;
                        asm volatile("" ::: "memory"); } } }
            const unsigned a1 = cA + (unsigned)(t + 1) * kstep;
            const unsigned a2 = last ? nA : cA + (unsigned)(t + 2) * kstep, b2 = last ? nB : cB + (unsigned)(t + 2) * kstep;
            const unsigned a3 = a2 + kstep, b3 = b2 + kstep;
            PG8_LDB(B0, 0, 0); PG8_LDB(B1, 0, 1); PG8_SCHED; PG8_LDA(At, 0, 0); PG8_STAGE(PG8_SA(1, 1), a1, vA10, vA11);
            if constexpr (Sched::GATHER) { if (last) { vA00 = nvA00; vA01 = nvA01; vA10 = nvA10; vA11 = nvA11; } }
            PG8_WAIT_V(8); PG8_WAIT_L(0); PG8_BAR; PG8_MMA(0, 0, At, B0); PG8_MMA(0, 1, At, B1); PG8_BAR; PG8_SCHED;
            PG8_LDA(At, 0, 1); PG8_STAGE(PG8_SB(0, 0), b2, vB0, vB1); PG8_STAGE(PG8_SB(0, 1), b2 + hstep, vB0, vB1); PG8_STAGE(PG8_SA(0, 0), a2, vA00, vA01);
            PG8_WAIT_V(8); PG8_WAIT_L(0); PG8_BAR; PG8_MMA(1, 0, At, B0); PG8_MMA(1, 1, At, B1); PG8_BAR; PG8_SCHED;
            PG8_LDB(B0, 1, 0); PG8_LDB(B1, 1, 1); PG8_SCHED; PG8_LDA(At, 1, 0); PG8_STAGE(PG8_SA(0, 1), a2, vA10, vA11);
            PG8_WAIT_V(8); PG8_WAIT_L(0); PG8_BAR; PG8_MMA(0, 0, At, B0); PG8_MMA(0, 1, At, B1); PG8_BAR; PG8_SCHED;
            PG8_LDA(At, 1, 1); PG8_STAGE(PG8_SB(1, 0), b3, vB0, vB1); PG8_STAGE(PG8_SB(1, 1), b3 + hstep, vB0, vB1); PG8_STAGE(PG8_SA(1, 0), a3, vA00, vA01);
            PG8_WAIT_V(8); PG8_WAIT_L(0); PG8_BAR;
            if constexpr (Epi::PREFETCH) { if (last) { PG8_EPI_LOADS; asm volatile("" ::: "memory"); } }
            PG8_MMA(1, 0, At, B0); PG8_MMA(1, 1, At, B1); PG8_BAR; PG8_SCHED;
        }
        if constexpr (F8) asm volatile("s_nop 15\n\ts_nop 15" ::: "memory");
        if (wr == 0) PG8_BAR;
        int rbase = wr * 64 + fr, cbase = wc * 32 + 8 * fq; asm volatile("" : "+v"(rbase), "+v"(cbase));
        if constexpr (!Epi::PREFETCH) PG8_EPI_LOADS;
        u32x4 res[2][4][2];
        if constexpr (pg8_resid<Epi>::value && !Epi::HOOK) {
#pragma unroll
            for (int ai = 0; ai < 2; ++ai)
#pragma unroll
                for (int m = 0; m < 4; ++m)
#pragma unroll
                    for (int bj = 0; bj < 2; ++bj) res[ai][m][bj] = E.resid(cur, ai * HALF + m * 16 + rbase, bj * HALF + cbase);
            asm volatile("" ::: "memory");
        }
#pragma unroll
        for (int ai = 0; ai < 2; ++ai)
#pragma unroll
            for (int m = 0; m < 4; ++m) {
                const int r = ai * HALF + m * 16 + rbase;
                if constexpr (pg8_resid<Epi>::value && Epi::HOOK) { if (m == 0) {
#pragma unroll
                    for (int m2 = 0; m2 < 4; ++m2)
#pragma unroll
                        for (int bj = 0; bj < 2; ++bj) res[ai][m2][bj] = E.resid(cur, ai * HALF + m2 * 16 + rbase, bj * HALF + cbase);
                    asm volatile("" ::: "memory"); } }
                if constexpr (Epi::PAIRED) {
                    float vg[8], vu[8];
#pragma unroll
                    for (int j = 0; j < 4; ++j) { vg[j] = acc[ai][0][m][0][j]; vg[4 + j] = acc[ai][0][m][1][j]; vu[j] = acc[ai][1][m][0][j]; vu[4 + j] = acc[ai][1][m][1][j]; }
                    E.pair(cur, r, cbase, vg, vu, rv[ai][m], cv0, cv1);
                } else {
#pragma unroll
                    for (int bj = 0; bj < 2; ++bj) { float v[8];
#pragma unroll
                        for (int j = 0; j < 4; ++j) { v[j] = acc[ai][bj][m][0][j]; v[4 + j] = acc[ai][bj][m][1][j]; }
                        if constexpr (Epi::COLS) { if (bj == 0) E.template operator()<true>(cur, r, cbase, v, rv[ai][m], cv0); else E.template operator()<true>(cur, r, HALF + cbase, v, rv[ai][m], cv1); }
                        else if constexpr (pg8_resid<Epi>::value) E.template operator()<true>(cur, r, bj * HALF + cbase, v, rv[ai][m], res[ai][m][bj]);
                        else E.template operator()<true>(cur, r, bj * HALF + cbase, v, rv[ai][m]); }
                }
                if constexpr (Epi::HOOK) { if (m == 3) asm volatile("" ::: "memory"); }
            }
        if (!has_next) break;
#pragma unroll
        for (int a = 0; a < 2; ++a)
#pragma unroll
            for (int b = 0; b < 2; ++b)
#pragma unroll
                for (int m = 0; m < 4; ++m)
#pragma unroll
                    for (int n = 0; n < 2; ++n) acc[a][b][m][n] = (f32x4){0.f, 0.f, 0.f, 0.f};
        cur = nxt; cA = nA; cB = nB; ++ui;
        if (wr == 1) PG8_BAR;
    }
    PG8_WAIT_V(0);
    PG8_BAR;
#undef PG8_SA
#undef PG8_SB
#undef PG8_SBR
#undef PG8_STAGE
#undef PG8_LDA
#undef PG8_LDB
#undef PG8_MMA
#undef PG8_CAT
#undef PG8_LD16
#undef PG8_WAIT_V
#undef PG8_EPI_LOADS
#undef PG8_WAIT_L
#undef PG8_BAR
#undef PG8_SCHED
#undef PG8_SETUP
}
}

typedef float f32x16 __attribute__((ext_vector_type(16)));
typedef short s16x4 __attribute__((ext_vector_type(4)));
__device__ __forceinline__ unsigned cvtpk(float lo, float hi) { f32x2_t v = {lo, hi}; bf16x2_t b = __builtin_convertvector(v, bf16x2_t); return __builtin_bit_cast(unsigned, b); }
__device__ __forceinline__ int crow(int r, int hi) { return (r & 3) + 8 * (r >> 2) + 4 * hi; }
struct AttnPtrs { const bf16* Q; int ldq; const bf16* K; int ldk; const bf16* V; int ldv; bf16* O; int ldo; float* part; int pstride; const float* cd; const float* cosT; const float* sinT; };
__device__ __forceinline__ void glds16(const void* gsrc, unsigned lds_dst) { unsigned keep;
    asm volatile("s_mov_b32 %0, m0\n\ts_mov_b32 m0, %2\n\ts_nop 0\n\tglobal_load_lds_dwordx4 %1, off\n\ts_mov_b32 m0, %0" : "=&s"(keep) : "v"(gsrc), "s"(lds_dst) : "memory"); }
__device__ __forceinline__ void glds4(const void* gsrc, unsigned lds_dst) { unsigned keep;
    asm volatile("s_mov_b32 %0, m0\n\ts_mov_b32 m0, %2\n\ts_nop 0\n\tglobal_load_lds_dword %1, off\n\ts_mov_b32 m0, %0" : "=&s"(keep) : "v"(gsrc), "s"(lds_dst) : "memory"); }
__device__ __forceinline__ void glds16s(unsigned voff, const void* sbase, unsigned lds_dst) { unsigned keep;
    asm volatile("s_mov_b32 %0, m0\n\ts_mov_b32 m0, %3\n\ts_nop 0\n\tglobal_load_lds_dwordx4 %1, %2\n\ts_mov_b32 m0, %0" : "=&s"(keep) : "v"(voff), "s"(sbase), "s"(lds_dst) : "memory"); }
__device__ __forceinline__ void glds4s(unsigned voff, const void* sbase, unsigned lds_dst) { unsigned keep;
    asm volatile("s_mov_b32 %0, m0\n\ts_mov_b32 m0, %3\n\ts_nop 0\n\tglobal_load_lds_dword %1, %2\n\ts_mov_b32 m0, %0" : "=&s"(keep) : "v"(voff), "s"(sbase), "s"(lds_dst) : "memory"); }
#define ATT_WAITBAR(N) asm volatile("s_waitcnt vmcnt(" #N ") lgkmcnt(0)\n\ts_barrier" ::: "memory")
typedef unsigned u32x2v __attribute__((ext_vector_type(2)));
struct AttCarry { bf16x8 q[6]; f32x4 c0, c1, s0, s1; float cq; int gslot; };
template <int DK, int DV, int MODE, int PRB = 0, int NMODE = -1, bool CONT = false>
__device__ __forceinline__ void attn_unit(LAS unsigned char* lds, const AttnPtrs& A, int qb, const AttnPtrs& AN, int qbN, AttCarry& cy) {
    constexpr int KSLOT = MODE == 2 ? DK * 128 : 12288, VSLOT = DV * 128, NKP = DK / 8, NVP = DV / 8, CKOFF = KSLOT + VSLOT, BUF = CKOFF + 1024, ND = DK / 16, NO = DV / 32;
    constexpr int NKPN = NMODE == 1 ? 12 : 8, NPTN = NKPN + 8 + (NMODE == 0 ? 1 : 0), NDN = NMODE == 1 ? 6 : 4;
    constexpr int NPT = NKP + NVP + (MODE == 0 ? 1 : 0);
    constexpr float THR = 8.0f;
    constexpr bool PIPE = ATT_PIPE && MODE != 2;
    const int tid = threadIdx.x, lane = tid & 63, r32 = lane & 31, hi = lane >> 5; const int wid = __builtin_amdgcn_readfirstlane(tid >> 6);
    const int q0 = qb * 256, qrow = q0 + wid * 32 + r32;
    const int NT = PRB == 7 ? 1 : MODE == 2 ? 4 : 4 * qb + 4, NTw = PRB == 7 ? 1 : MODE == 2 ? 4 : 4 * qb + (wid >> 1) + 1;
    const int nw = (NPT - wid + 7) / 8;
    const int nwN = (NPTN - wid + 7) / 8;
    const unsigned lds0 = (unsigned)(uintptr_t)lds;
    unsigned voffK = (unsigned)(lane * A.ldk * 2), voffV = (unsigned)((((lane >> 2) * A.ldv) + (lane & 3) * 8) * 2), voffC = (unsigned)(lane * 4);
    unsigned voffKN = (unsigned)(lane * AN.ldk * 2);
    asm volatile("" : "+v"(voffK), "+v"(voffV), "+v"(voffC), "+v"(voffKN));
    auto issueN = [&](int t, int slot) {
        const unsigned base = lds0 + slot * BUF;
        for (int pi = wid; pi < NPTN; pi += 8) {
            if (pi < NKPN) { const bf16* sb = AN.K + (size_t)(t * 64) * AN.ldk + pi * 8; glds16s(voffKN, sb, (unsigned)__builtin_amdgcn_readfirstlane(base + pi * 1024)); }
            else if (pi < NKPN + 8) { const int v = pi - NKPN, dh = v >> 2, kg = v & 3; const bf16* sb = AN.V + (size_t)(t * 64 + 16 * kg) * AN.ldv + dh * 32;
                   glds16s(voffV, sb, (unsigned)__builtin_amdgcn_readfirstlane(base + KSLOT + v * 1024)); }
            else { if constexpr (NMODE == 0) glds4s(voffC, AN.cd + t * 64, (unsigned)__builtin_amdgcn_readfirstlane(base + CKOFF)); }
        }
    };
    auto loadqN = [&]() {
        const int qrowN = qbN * 256 + wid * 32 + r32;
#pragma unroll
        for (int d0 = 0; d0 < NDN; ++d0) cy.q[d0] = *(const bf16x8*)(AN.Q + (size_t)qrowN * AN.ldq + d0 * 16 + hi * 8);
        if constexpr (NMODE == 1) { const float* cp = AN.cosT + qrowN * 16 + hi * 8; const float* sp = AN.sinT + qrowN * 16 + hi * 8;
            cy.c0 = *(const f32x4*)cp; cy.c1 = *(const f32x4*)(cp + 4); cy.s0 = *(const f32x4*)sp; cy.s1 = *(const f32x4*)(sp + 4); }
        if constexpr (NMODE == 0) cy.cq = AN.cd[qrowN];
    };
    auto issue = [&](int t, int slot) {
        const unsigned base = lds0 + slot * BUF;
        for (int pi = wid; pi < NPT; pi += 8) {
            if (pi < NKP) { const bf16* sb = A.K + (size_t)(t * 64) * A.ldk + pi * 8; glds16s(voffK, sb, (unsigned)__builtin_amdgcn_readfirstlane(base + pi * 1024)); }
            else if (pi < NKP + NVP) { const int v = pi - NKP, dh = v >> 2, kg = v & 3; const bf16* sb = A.V + (size_t)(t * 64 + 16 * kg) * A.ldv + dh * 32;
                   glds16s(voffV, sb, (unsigned)__builtin_amdgcn_readfirstlane(base + KSLOT + v * 1024)); }
            else { if constexpr (MODE == 0) glds4s(voffC, A.cd + t * 64, (unsigned)__builtin_amdgcn_readfirstlane(base + CKOFF)); }
        }
    };
    auto waitbar = [&](bool keep_newest) {
        if (!keep_newest) { ATT_WAITBAR(0); }
        else if (nw == 2) { ATT_WAITBAR(2); } else if (nw == 3) { ATT_WAITBAR(3); } else { ATT_WAITBAR(4); }
    };
    const int gslot = (MODE != 2 && CONT) ? cy.gslot : 0;
    if constexpr (MODE == 2 || !CONT) { issue(0, 0); if (NT > 1) issue(1, 1); if constexpr (MODE != 2) { issue(2, 2); issue(3, 3); } }
    bf16x8 qr[ND]; f32x4 rc0, rc1, rs0, rs1; float cq = 0.f;
    if constexpr (MODE != 2 && CONT) {
#pragma unroll
        for (int d0 = 0; d0 < ND; ++d0) qr[d0] = cy.q[d0];
        if constexpr (MODE == 1) { rc0 = cy.c0; rc1 = cy.c1; rs0 = cy.s0; rs1 = cy.s1; }
        if constexpr (MODE == 0) cq = cy.cq;
    } else {
#pragma unroll
        for (int d0 = 0; d0 < ND; ++d0) qr[d0] = *(const bf16x8*)(A.Q + (size_t)qrow * A.ldq + d0 * 16 + hi * 8);
        if constexpr (MODE == 1) { const float* cp = A.cosT + qrow * 16 + hi * 8; const float* sp = A.sinT + qrow * 16 + hi * 8;
            rc0 = *(const f32x4*)cp; rc1 = *(const f32x4*)(cp + 4); rs0 = *(const f32x4*)sp; rs1 = *(const f32x4*)(sp + 4); }
        if constexpr (MODE == 0) cq = A.cd[qrow];
    }
    if constexpr (MODE == 1) {
        bf16x8 a = qr[4], c = qr[5];
#pragma unroll
        for (int i = 0; i < 8; ++i) { const float x1 = bf2f((unsigned short)a[i]), x2 = bf2f((unsigned short)c[i]), cs = i < 4 ? rc0[i & 3] : rc1[i & 3], sn = i < 4 ? rs0[i & 3] : rs1[i & 3];
            a[i] = (short)f2bf(x1 * cs - x2 * sn); c[i] = (short)f2bf(x2 * cs + x1 * sn); }
        qr[4] = a; qr[5] = c;
    }
    float mref = 0.f, l = 0.f; f32x16 o[NO];
#pragma unroll
    for (int i = 0; i < NO; ++i) o[i] = f32x16{};
#pragma unroll
    for (int d0 = 0; d0 < ND; ++d0) asm volatile("" : "+v"(qr[d0]));
    asm volatile("" : "+v"(cq));
    if constexpr (PIPE) {
#define ATT_INIT(P0, P1, SL) do { \
        if constexpr (MODE == 0) { \
            const LAS float* ck = (const LAS float*)(lds + (SL) * BUF + CKOFF) + 4 * hi; \
            _Pragma("unroll") for (int g = 0; g < 4; ++g) { const f32x4 c0 = *(const LAS f32x4*)(ck + 8 * g), c1 = *(const LAS f32x4*)(ck + 32 + 8 * g); \
                _Pragma("unroll") for (int i = 0; i < 4; ++i) { P0[4 * g + i] = cq - c0[i]; P1[4 * g + i] = cq - c1[i]; } } \
        } else { P0 = f32x16{}; P1 = f32x16{}; } } while (0)
#define ATT_QKM(P0, P1, SL) do { const LAS unsigned char* Kb = lds + (SL) * BUF + hi * 1024 + r32 * 16; \
        _Pragma("unroll") for (int d0 = 0; d0 < ND; ++d0) { \
            const bf16x8 b0 = *(const LAS bf16x8*)(Kb + d0 * 2048), b1 = *(const LAS bf16x8*)(Kb + d0 * 2048 + 512); \
            P0 = __builtin_amdgcn_mfma_f32_32x32x16_bf16(b0, qr[d0], P0, 0, 0, 0); P1 = __builtin_amdgcn_mfma_f32_32x32x16_bf16(b1, qr[d0], P1, 0, 0, 0); } } while (0)
#define ATT_MASKNOW(P0, P1, TT) do { if constexpr (MODE == 0) { const int kb = (TT) * 64 + 4 * hi; \
            _Pragma("unroll") for (int r = 0; r < 16; ++r) { const int kv = kb + (r & 3) + 8 * (r >> 2); if (kv > qrow) P0[r] = -INFINITY; if (kv + 32 > qrow) P1[r] = -INFINITY; } } } while (0)
#define ATT_MASK(P0, P1, TT) do { if constexpr (MODE == 0) { if (__builtin_amdgcn_readfirstlane((TT) == NTw - 1)) { const int kb = (TT) * 64 + 4 * hi; \
            _Pragma("unroll") for (int r = 0; r < 16; ++r) { const int kv = kb + (r & 3) + 8 * (r >> 2); if (kv > qrow) P0[r] = -INFINITY; if (kv + 32 > qrow) P1[r] = -INFINITY; } } } } while (0)
#define ATT_ROWMAX(P0, P1) do { \
        rm = fmaxf(P0[0], P1[0]); \
        _Pragma("unroll") for (int r = 1; r < 16; ++r) rm = fmaxf(fmaxf(rm, P0[r]), P1[r]); \
        { auto rr = __builtin_amdgcn_permlane32_swap(__float_as_uint(rm), __float_as_uint(rm), false, false); rm = fmaxf(__uint_as_float(rr[0]), __uint_as_float(rr[1])); } } while (0)
#define ATT_RESC(P0, P1) do {     \
        if (__builtin_expect(__any((rm - mref > THR) || (mref != 0.f)), 0)) { \
            rm -= mref; \
            const float dl = fmaxf(rm > THR ? rm : 0.f, 0.f), f = __builtin_amdgcn_exp2f(-dl), sub = mref + dl; mref += dl; l *= f; \
            _Pragma("unroll") for (int r = 0; r < 16; ++r) { P0[r] -= sub; P1[r] -= sub; } \
            _Pragma("unroll") for (int i = 0; i < NO; ++i) _Pragma("unroll") for (int r = 0; r < 16; ++r) o[i][r] *= f; } } while (0)
#define ATT_EXP(P0, P1) do { float sum = 0.f; \
        _Pragma("unroll") for (int r = 0; r < 16; ++r) { P0[r] = __builtin_amdgcn_exp2f(P0[r]); P1[r] = __builtin_amdgcn_exp2f(P1[r]); sum += P0[r] + P1[r]; } \
        l += sum; \
        _Pragma("unroll") for (int s2 = 0; s2 < 2; ++s2) { pw[s2] = (u32x4){cvtpk(P0[8 * s2], P0[8 * s2 + 1]), cvtpk(P0[8 * s2 + 2], P0[8 * s2 + 3]), cvtpk(P0[8 * s2 + 4], P0[8 * s2 + 5]), cvtpk(P0[8 * s2 + 6], P0[8 * s2 + 7])}; \
            pw[2 + s2] = (u32x4){cvtpk(P1[8 * s2], P1[8 * s2 + 1]), cvtpk(P1[8 * s2 + 2], P1[8 * s2 + 3]), cvtpk(P1[8 * s2 + 4], P1[8 * s2 + 5]), cvtpk(P1[8 * s2 + 6], P1[8 * s2 + 7])}; } } while (0)
#define ATT_HOT(C0, C1, N0, N1, SL, VSL) do { const LAS unsigned char* Kb = lds + (SL) * BUF + hi * 1024 + r32 * 16; float sum = 0.f; \
        const LAS unsigned char* Vb = lds + (VSL) * BUF + KSLOT + ((lane >> 4) & 1) * 32 + (lane & 3) * 8 + (4 * hi + ((lane & 15) >> 2)) * 64; \
        bf16x8 kf = *(const LAS bf16x8*)(Kb), kf1 = *(const LAS bf16x8*)(Kb + 512);     \
        _Pragma("unroll") for (int q_ = 0; q_ < 2 * ND; ++q_) { \
            bf16x8 kn = kf; \
            if (PRB != 5 && q_ + 2 < 2 * ND) kn = *(const LAS bf16x8*)(Kb + ((q_ + 2) >> 1) * 2048 + ((q_ + 2) & 1) * 512); \
            if (PRB != 5 && q_ >= 2 * ND - VPRE) { const int j_ = q_ - (2 * ND - VPRE); \
                vfr[2 * j_] = __builtin_bit_cast(s16x4, __builtin_amdgcn_ds_read_tr16_b64_v4i16((LAS s16x4*)(Vb + (j_ >> 2) * 4096 + (j_ & 3) * 1024))); \
                vfr[2 * j_ + 1] = __builtin_bit_cast(s16x4, __builtin_amdgcn_ds_read_tr16_b64_v4i16((LAS s16x4*)(Vb + (j_ >> 2) * 4096 + (j_ & 3) * 1024 + 512))); } \
            if (PRB == 6) { asm volatile("" :: "v"(kf)); } else if (q_ & 1) N1 = __builtin_amdgcn_mfma_f32_32x32x16_bf16(kf, qr[q_ >> 1], N1, 0, 0, 0); else N0 = __builtin_amdgcn_mfma_f32_32x32x16_bf16(kf, qr[q_ >> 1], N0, 0, 0, 0); \
            _Pragma("unroll") for (int j_ = 0; j_ < (32 + 2 * ND - 1) / (2 * ND); ++j_) { const int e_ = (q_ * 32) / (2 * ND) + j_; \
                if (e_ < ((q_ + 1) * 32) / (2 * ND)) { if (PRB != 4) { if (e_ < 16) C0[e_ & 15] = __builtin_amdgcn_exp2f(C0[e_ & 15]); else C1[e_ & 15] = __builtin_amdgcn_exp2f(C1[e_ & 15]); } } } \
            kf = kf1; kf1 = kn; \
            __builtin_amdgcn_sched_barrier(0); } \
        { float s0_ = C0[0], s1_ = C0[1], s2_ = C1[0], s3_ = C1[1]; \
          _Pragma("unroll") for (int r = 2; r < 16; r += 2) { s0_ += C0[r]; asm("" : "+v"(s0_)); s1_ += C0[r + 1]; asm("" : "+v"(s1_)); s2_ += C1[r]; asm("" : "+v"(s2_)); s3_ += C1[r + 1]; asm("" : "+v"(s3_)); } \
          sum = (s0_ + s1_) + (s2_ + s3_); } \
        l += sum; \
        _Pragma("unroll") for (int s2 = 0; s2 < 2; ++s2) { pw[s2] = (u32x4){cvtpk(C0[8 * s2], C0[8 * s2 + 1]), cvtpk(C0[8 * s2 + 2], C0[8 * s2 + 3]), cvtpk(C0[8 * s2 + 4], C0[8 * s2 + 5]), cvtpk(C0[8 * s2 + 6], C0[8 * s2 + 7])}; \
            pw[2 + s2] = (u32x4){cvtpk(C1[8 * s2], C1[8 * s2 + 1]), cvtpk(C1[8 * s2 + 2], C1[8 * s2 + 3]), cvtpk(C1[8 * s2 + 4], C1[8 * s2 + 5]), cvtpk(C1[8 * s2 + 6], C1[8 * s2 + 7])}; } } while (0)
#define ATT_PVR(SL) do { const LAS unsigned char* Vb2 = lds + (SL) * BUF + KSLOT + ((lane >> 4) & 1) * 32 + (lane & 3) * 8 + (4 * hi + ((lane & 15) >> 2)) * 64; \
        _Pragma("unroll") for (int ks = 0; ks < 4; ++ks) _Pragma("unroll") for (int d0 = 0; d0 < NO; ++d0) { \
            s16x4 vl, vh; \
            if (PRB == 5) { vl = __builtin_bit_cast(s16x4, (u32x2v){pw[ks][0], pw[ks][1]}); vh = __builtin_bit_cast(s16x4, (u32x2v){pw[ks][2], pw[ks][3]}); } \
            else if (d0 * 4 + ks < VPRE) { vl = vfr[2 * (d0 * 4 + ks)]; vh = vfr[2 * (d0 * 4 + ks) + 1]; } \
            else { vl = __builtin_bit_cast(s16x4, __builtin_amdgcn_ds_read_tr16_b64_v4i16((LAS s16x4*)(Vb2 + d0 * 4096 + ks * 1024))); vh = __builtin_bit_cast(s16x4, __builtin_amdgcn_ds_read_tr16_b64_v4i16((LAS s16x4*)(Vb2 + d0 * 4096 + ks * 1024 + 512))); } \
            const bf16x8 vf = (bf16x8){vl[0], vl[1], vl[2], vl[3], vh[0], vh[1], vh[2], vh[3]}; \
            if (PRB == 6) { asm volatile("" :: "v"(vf)); } else o[d0] = __builtin_amdgcn_mfma_f32_32x32x16_bf16(vf, __builtin_bit_cast(bf16x8, pw[ks]), o[d0], 0, 0, 0); } } while (0)
#define ATT_PV(SL) do { \
        const LAS unsigned char* Vb = lds + (SL) * BUF + KSLOT + ((lane >> 4) & 1) * 32 + (lane & 3) * 8 + (4 * hi + ((lane & 15) >> 2)) * 64; \
        _Pragma("unroll") for (int ks = 0; ks < 4; ++ks) _Pragma("unroll") for (int d0 = 0; d0 < NO; ++d0) { \
            const s16x4 vl = __builtin_bit_cast(s16x4, __builtin_amdgcn_ds_read_tr16_b64_v4i16((LAS s16x4*)(Vb + d0 * 4096 + ks * 1024))); \
            const s16x4 vh = __builtin_bit_cast(s16x4, __builtin_amdgcn_ds_read_tr16_b64_v4i16((LAS s16x4*)(Vb + d0 * 4096 + ks * 1024 + 512))); \
            const bf16x8 vf = (bf16x8){vl[0], vl[1], vl[2], vl[3], vh[0], vh[1], vh[2], vh[3]}; \
            o[d0] = __builtin_amdgcn_mfma_f32_32x32x16_bf16(vf, __builtin_bit_cast(bf16x8, pw[ks]), o[d0], 0, 0, 0); } } while (0)
    auto waitg = [&](int groups) { const int cnt = groups * nw;
        if (cnt == 0) { ATT_WAITBAR(0); } else if (cnt == 2) { ATT_WAITBAR(2); } else if (cnt == 3) { ATT_WAITBAR(3); } else if (cnt == 4) { ATT_WAITBAR(4); } else if (cnt == 6) { ATT_WAITBAR(6); } else { ATT_WAITBAR(8); } };
    asm volatile("s_waitcnt lgkmcnt(0)\n\ts_barrier" ::: "memory");
    f32x16 pA0, pA1, pB0, pB1; u32x4 pw[4]; constexpr int VPRE = 0; s16x4 vfr[2 * VPRE > 0 ? 2 * VPRE : 1];
    float rm;
    ATT_INIT(pA0, pA1, gslot); ATT_QKM(pA0, pA1, gslot); ATT_MASK(pA0, pA1, 0); ATT_ROWMAX(pA0, pA1); ATT_RESC(pA0, pA1);
    int slot = gslot;
#define ATT_HEAD const int s1 = slot == 5 ? 0 : slot + 1; if (PRB != 3) { if (t + 4 < NT) issue(t + 4, slot >= 2 ? slot - 2 : slot + 4); else if (NMODE >= 0) issueN(t + 4 - NT, slot >= 2 ? slot - 2 : slot + 4); }
#define ATT_NEXTQ if (NMODE >= 0 && t == NT - 1) loadqN()
#define ATT_FOOT if (PRB != 2 && (t & 1)) { const int cnt_ = t + 4 < NT ? nw : NMODE >= 0 ? nwN : 0; \
        if (NMODE >= 0 && t == NT - 1) { if (NMODE == 1) { if (nwN == 3) { ATT_WAITBAR(11); } else { ATT_WAITBAR(10); } } else { if (nwN == 3) { ATT_WAITBAR(7); } else { ATT_WAITBAR(6); } } } \
        else if (cnt_ == 3) { ATT_WAITBAR(3); } else if (cnt_ == 2) { ATT_WAITBAR(2); } else { ATT_WAITBAR(0); } } slot = s1; ++t
#define ATT_HOTTRIP(C0, C1, N0, N1, MSK) do { ATT_HEAD; ATT_INIT(N0, N1, s1); ATT_HOT(C0, C1, N0, N1, s1, slot); if (MSK) ATT_MASKNOW(N0, N1, t + 1); ATT_PVR(slot); ATT_ROWMAX(N0, N1); ATT_RESC(N0, N1); ATT_FOOT; } while (0)
#define ATT_LASTTRIP(C0, C1) do { ATT_HEAD; ATT_NEXTQ; ATT_EXP(C0, C1); ATT_PV(slot); ATT_FOOT; } while (0)
    int t = 0;
    while (t + 3 < NTw) { ATT_HOTTRIP(pA0, pA1, pB0, pB1, 0); ATT_HOTTRIP(pB0, pB1, pA0, pA1, 0); }
    if (t + 2 < NTw) { ATT_HOTTRIP(pA0, pA1, pB0, pB1, 0); ATT_HOTTRIP(pB0, pB1, pA0, pA1, 1); ATT_LASTTRIP(pA0, pA1); }
    else if (t + 1 < NTw) { ATT_HOTTRIP(pA0, pA1, pB0, pB1, 1); ATT_LASTTRIP(pB0, pB1); } else { ATT_LASTTRIP(pA0, pA1); }
    while (t < NT) { ATT_HEAD; ATT_NEXTQ; ATT_FOOT; }
    cy.gslot = (gslot + NT) % 6;
#undef ATT_NEXTQ
#undef ATT_HEAD
#undef ATT_FOOT
#undef ATT_HOTTRIP
#undef ATT_LASTTRIP
#undef ATT_INIT
#undef ATT_QKM
#undef ATT_MASK
#undef ATT_ROWMAX
#undef ATT_MASKNOW
#undef ATT_RESC
#undef ATT_EXP
#undef ATT_HOT
#undef ATT_PV
#undef ATT_PVR
    } else {
    waitbar(NT > 1);
    int slot = 0;
    for (int t = 0; t < NT; ++t) {
        if (t + 2 < NT) issue(t + 2, slot == 0 ? 2 : slot - 1);
        if (t < NTw) {
            const LAS unsigned char* Kb = lds + slot * BUF + hi * 1024 + r32 * 16;
            f32x16 p0, p1;
            if constexpr (MODE == 0) {
                const LAS float* ck = (const LAS float*)(lds + slot * BUF + CKOFF) + 4 * hi; const float c0m = cq - mref;
#pragma unroll
                for (int g = 0; g < 4; ++g) { const f32x4 c0 = *(const LAS f32x4*)(ck + 8 * g), c1 = *(const LAS f32x4*)(ck + 32 + 8 * g);
#pragma unroll
                    for (int i = 0; i < 4; ++i) { p0[4 * g + i] = c0m - c0[i]; p1[4 * g + i] = c0m - c1[i]; } }
            } else {
#pragma unroll
                for (int r = 0; r < 16; ++r) { p0[r] = -mref; p1[r] = -mref; } }
#pragma unroll
            for (int d0 = 0; d0 < ND; ++d0) {
                const bf16x8 b0 = *(const LAS bf16x8*)(Kb + d0 * 2048), b1 = *(const LAS bf16x8*)(Kb + d0 * 2048 + 512);
                p0 = __builtin_amdgcn_mfma_f32_32x32x16_bf16(b0, qr[d0], p0, 0, 0, 0); p1 = __builtin_amdgcn_mfma_f32_32x32x16_bf16(b1, qr[d0], p1, 0, 0, 0);
            }
            if constexpr (MODE == 0) { if (__builtin_amdgcn_readfirstlane(t == NTw - 1)) {
                const int kb = t * 64 + 4 * hi;
#pragma unroll
                for (int r = 0; r < 16; ++r) { const int kv = kb + (r & 3) + 8 * (r >> 2); if (kv > qrow) p0[r] = -INFINITY; if (kv + 32 > qrow) p1[r] = -INFINITY; } } }
            float rm = fmaxf(p0[0], p1[0]);
#pragma unroll
            for (int r = 1; r < 16; ++r) rm = fmaxf(fmaxf(rm, p0[r]), p1[r]);
            { auto rr = __builtin_amdgcn_permlane32_swap(__float_as_uint(rm), __float_as_uint(rm), false, false); rm = fmaxf(__uint_as_float(rr[0]), __uint_as_float(rr[1])); }
            if (__builtin_expect(__any(rm > THR), 0)) {
                const float dl = fmaxf(rm, 0.f), f = __builtin_amdgcn_exp2f(-dl); mref += dl; l *= f;
#pragma unroll
                for (int r = 0; r < 16; ++r) { p0[r] -= dl; p1[r] -= dl; }
#pragma unroll
                for (int i = 0; i < NO; ++i)
#pragma unroll
                    for (int r = 0; r < 16; ++r) o[i][r] *= f;
            }
            float sum = 0.f;
#pragma unroll
            for (int r = 0; r < 16; ++r) { p0[r] = __builtin_amdgcn_exp2f(p0[r]); p1[r] = __builtin_amdgcn_exp2f(p1[r]); sum += p0[r] + p1[r]; }
            l += sum;
            u32x4 pw[4];
#pragma unroll
            for (int s = 0; s < 2; ++s) { pw[s] = (u32x4){cvtpk(p0[8 * s], p0[8 * s + 1]), cvtpk(p0[8 * s + 2], p0[8 * s + 3]), cvtpk(p0[8 * s + 4], p0[8 * s + 5]), cvtpk(p0[8 * s + 6], p0[8 * s + 7])};
                pw[2 + s] = (u32x4){cvtpk(p1[8 * s], p1[8 * s + 1]), cvtpk(p1[8 * s + 2], p1[8 * s + 3]), cvtpk(p1[8 * s + 4], p1[8 * s + 5]), cvtpk(p1[8 * s + 6], p1[8 * s + 7])}; }
            const LAS unsigned char* Vb = lds + slot * BUF + KSLOT + ((lane >> 4) & 1) * 32 + (lane & 3) * 8 + (4 * hi + ((lane & 15) >> 2)) * 64;
#pragma unroll
            for (int d0 = 0; d0 < NO; ++d0)
#pragma unroll
                for (int ks = 0; ks < 4; ++ks) {
                    const s16x4 vl = __builtin_bit_cast(s16x4, __builtin_amdgcn_ds_read_tr16_b64_v4i16((LAS s16x4*)(Vb + d0 * 4096 + ks * 1024)));
                    const s16x4 vh = __builtin_bit_cast(s16x4, __builtin_amdgcn_ds_read_tr16_b64_v4i16((LAS s16x4*)(Vb + d0 * 4096 + ks * 1024 + 512)));
                    const bf16x8 vf = (bf16x8){vl[0], vl[1], vl[2], vl[3], vh[0], vh[1], vh[2], vh[3]};
                    o[d0] = __builtin_amdgcn_mfma_f32_32x32x16_bf16(vf, __builtin_bit_cast(bf16x8, pw[ks]), o[d0], 0, 0, 0);
                }
        }
        waitbar(t + 2 < NT);
        slot = slot == 2 ? 0 : slot + 1;
    }
    }
    { auto rr = __builtin_amdgcn_permlane32_swap(__float_as_uint(l), __float_as_uint(l), false, false); l = __uint_as_float(rr[0]) + __uint_as_float(rr[1]); }
    const float inv = 1.0f / l; float ss = 0.f;
    bf16* orow = A.O + (size_t)qrow * A.ldo + 8 * hi;
#pragma unroll
    for (int d0 = 0; d0 < NO; ++d0)
#pragma unroll
        for (int g = 0; g < 4; g += 2) {
            float v[8];
#pragma unroll
            for (int i = 0; i < 4; ++i) { v[i] = o[d0][4 * g + i] * inv; v[4 + i] = o[d0][4 * (g + 1) + i] * inv; ss += v[i] * v[i] + v[4 + i] * v[4 + i]; }
            unsigned ax = pk2(v[0], v[1]), ay = pk2(v[2], v[3]), bx_ = pk2(v[4], v[5]), by = pk2(v[6], v[7]);
            { auto r = __builtin_amdgcn_permlane32_swap(ax, bx_, false, false); ax = r[0]; bx_ = r[1]; }
            { auto r = __builtin_amdgcn_permlane32_swap(ay, by, false, false); ay = r[0]; by = r[1]; }
            *(u32x4*)(orow + d0 * 32 + 8 * g) = (u32x4){ax, ay, bx_, by};
        }
    if (MODE != 2 || A.part) { auto rr = __builtin_amdgcn_permlane32_swap(__float_as_uint(ss), __float_as_uint(ss), false, false); ss = __uint_as_float(rr[0]) + __uint_as_float(rr[1]); A.part[(size_t)qrow * A.pstride] = ss; }
}
template <int PRB = 0>
__device__ __forceinline__ void attn_phase_self(LAS unsigned char* lds, const Bufs& b, int vcu) {
    const int bh = vcu >> 2, s = vcu & 3, bb = bh >> 3, h = bh & 7; const size_t r0 = (size_t)bb * S;
    if (vcu >= 256) return;
    bf16* const Ob = PRB ? b.yp : b.Omix; float* const pf = PRB ? (float*)b.act : b.pfox; float* const pm = PRB ? (float*)b.act + 262144 : b.pmla;
    AttnPtrs F{b.Qf + r0 * 512 + h * 64, 512, b.Kf + r0 * 512 + h * 64, 512, b.Vf + r0 * 512 + h * 64, 512, Ob + r0 * 1024 + h * 64, 1024, pf + r0 * 8 + h, 8, b.cdec + (size_t)bh * S, nullptr, nullptr};
    AttnPtrs M{b.Qm + r0 * 768 + h * 96, 768, b.Km + r0 * 768 + h * 96, 768, b.Vm + r0 * 512 + h * 64, 512, Ob + r0 * 1024 + 512 + h * 64, 1024, pm + r0 * 8 + h, 8, nullptr, b.cosT, b.sinT};
    AttCarry cy;
    attn_unit<96, 64, 1, PRB, 0, false>(lds, M, 7 - s, F, 7 - s, cy); attn_unit<64, 64, 0, PRB, 1, true>(lds, F, 7 - s, M, s, cy);
    attn_unit<96, 64, 1, PRB, 0, true>(lds, M, s, F, s, cy); attn_unit<64, 64, 0, PRB, -1, true>(lds, F, s, F, s, cy);
}
__device__ __forceinline__ void attn_phase_mem(LAS unsigned char* lds, const Bufs& b, int vcu) {
    if (vcu >= 256) return;
    const int bb = vcu >> 5, h = (vcu >> 3) & 3, qb = vcu & 7; const size_t r0 = (size_t)bb * S, m0 = (size_t)bb * MEMT;
    AttnPtrs X{b.Qmem + r0 * 512 + h * 128, 512, b.KVm + m0 * 1024 + h * 128, 1024, b.KVm + m0 * 1024 + 512 + h * 128, 1024, b.Omem + r0 * 512 + h * 128, 512, nullptr, 0, nullptr, nullptr, nullptr};
    AttCarry cy;
    attn_unit<128, 128, 2>(lds, X, qb, X, qb, cy);
}

typedef float f32x4v __attribute__((ext_vector_type(4)));
struct RouterRec { int sel[256]; float gw[256]; int rank[256]; float rs[64]; int tok[64]; int base[32]; int wcnt[128]; int pbase[512]; int ptot[512]; };
constexpr int RW_STRIDE = 2064, RW_BYTES = 64 * RW_STRIDE;
__device__ __forceinline__ void router_weights_to_lds(const Bufs& b, unsigned char* lds_raw, int wave, int lane) {
    const unsigned lds0 = (unsigned)(uintptr_t)(LAS unsigned char*)lds_raw;
#pragma unroll 4
    for (int k = wave; k < 128; k += 8) { const int row = k >> 1, half = k & 1;
        glds16((const bf16*)b.wr + (size_t)row * 1024 + half * 512 + lane * 8, (unsigned)__builtin_amdgcn_readfirstlane(lds0 + row * RW_STRIDE + half * 1024)); }
}
struct RouterAcc { f32x4v acc0, acc1; float ss; };
__device__ __forceinline__ void router_logits(const Bufs& b, int tile, int lane, const unsigned char* lds_raw, RouterAcc& A) {
    const int n = lane & 15, g = lane >> 4, tok0 = tile * 16;
    const bf16* hrow = b.h2 + (size_t)(tok0 + n) * D + 8 * g;
    u32x4 ar[32];
#pragma unroll
    for (int j = 0; j < 32; ++j) ar[j] = *(const u32x4*)(hrow + 32 * j);
    asm volatile("s_waitcnt vmcnt(32)" ::: "memory");
    __syncthreads();
    const LAS unsigned char* wl = (const LAS unsigned char*)lds_raw + n * RW_STRIDE + g * 16;
    f32x4v acc0 = {0.f, 0.f, 0.f, 0.f}, acc1 = {0.f, 0.f, 0.f, 0.f}; float ss = 0.f;
#pragma unroll
    for (int j = 0; j < 32; ++j) {
        const bf16x8 a = __builtin_bit_cast(bf16x8, ar[j]);
        const bf16x8 h0 = *(const LAS bf16x8*)(wl + j * 64), h1 = *(const LAS bf16x8*)(wl + 16 * RW_STRIDE + j * 64), l0 = *(const LAS bf16x8*)(wl + 32 * RW_STRIDE + j * 64), l1 = *(const LAS bf16x8*)(wl + 48 * RW_STRIDE + j * 64);
        float f[8]; unpack8(ar[j], f);
        if (MOE_FP8 && H2Q_IN_ROUTER) *(u32x2*)(b.h2q + (size_t)(tok0 + n) * D + 32 * j + 8 * g) = pack8_fp8(f);
#pragma unroll
        for (int i = 0; i < 8; ++i) ss += f[i] * f[i];
        acc0 = __builtin_amdgcn_mfma_f32_16x16x32_bf16(h0, a, acc0, 0, 0, 0); acc0 = __builtin_amdgcn_mfma_f32_16x16x32_bf16(l0, a, acc0, 0, 0, 0);
        acc1 = __builtin_amdgcn_mfma_f32_16x16x32_bf16(h1, a, acc1, 0, 0, 0); acc1 = __builtin_amdgcn_mfma_f32_16x16x32_bf16(l1, a, acc1, 0, 0, 0);
    }
    A.acc0 = acc0; A.acc1 = acc1; A.ss = ss;
}
__device__ __forceinline__ void router_select(const Params& p, int tile, int lane, float* lgl  , RouterRec* R, int wslot, const RouterAcc& A) {
    const int n = lane & 15, g = lane >> 4, tok0 = tile * 16;
    const f32x4v acc0 = A.acc0, acc1 = A.acc1; float ss = A.ss;
    ss += __shfl_xor(ss, 16); ss += __shfl_xor(ss, 32);
    const float rs = 1.0f / sqrtf(ss * (1.0f / 1024.0f) + EPS);
#pragma unroll
    for (int r = 0; r < 4; ++r) { lgl[n * 33 + 4 * g + r] = acc0[r] * rs + p.b_router[4 * g + r]; lgl[n * 33 + 16 + 4 * g + r] = acc1[r] * rs + p.b_router[16 + 4 * g + r]; }
    __builtin_amdgcn_s_waitcnt(0xc07f); __builtin_amdgcn_wave_barrier();
    if (lane < 16) {
        const float* lg = lgl + lane * 33; const int slot = wslot * 16 + lane;
        unsigned taken = 0u; float tv0 = 0.f, tv1 = 0.f, tv2 = 0.f, tv3 = 0.f; int ti0 = 0, ti1 = 0, ti2 = 0, ti3 = 0;
#pragma unroll
        for (int k = 0; k < 4; ++k) {
            float best = -INFINITY; int bi = 0;
            for (int e = 0; e < 32; ++e) { const float x = lg[e]; if (!((taken >> e) & 1u) && x > best) { best = x; bi = e; } }
            taken |= 1u << bi;
            if (k == 0) { tv0 = best; ti0 = bi; } else if (k == 1) { tv1 = best; ti1 = bi; } else if (k == 2) { tv2 = best; ti2 = bi; } else { tv3 = best; ti3 = bi; }
        }
        const float e1 = expf(tv1 - tv0), e2 = expf(tv2 - tv0), e3 = expf(tv3 - tv0), inv = 1.0f / (1.0f + e1 + e2 + e3);
        R->sel[slot * 4 + 0] = ti0; R->sel[slot * 4 + 1] = ti1; R->sel[slot * 4 + 2] = ti2; R->sel[slot * 4 + 3] = ti3;
        R->gw[slot * 4 + 0] = inv; R->gw[slot * 4 + 1] = e1 * inv; R->gw[slot * 4 + 2] = e2 * inv; R->gw[slot * 4 + 3] = e3 * inv;
        R->rs[slot] = rs; R->tok[slot] = tok0 + lane;
    }
}
__device__ __forceinline__ void router_rank(const Bufs& b, RouterRec* R, int bx, int nslots) {
    __syncthreads();
    const int tid = threadIdx.x, lane = tid & 63, w = tid >> 6;
    if (w < 4) { const int i = w * 64 + lane, e = R->sel[i]; int myrank = 0;
        for (int q = 0; q < 32; ++q) { const unsigned long long m = __ballot(e == q); if (e == q) myrank = __popcll(m & ((1ull << lane) - 1ull)); if (lane == 0) R->wcnt[w * 32 + q] = __popcll(m); }
        R->rank[i] = myrank; }
    __syncthreads();
    if (w < 4) { const int i = w * 64 + lane, e = R->sel[i]; int add = 0; for (int ww = 0; ww < w; ++ww) add += R->wcnt[ww * 32 + e]; R->rank[i] += add; }
    if (tid < 32) b.blkcnt[bx * 32 + tid] = R->wcnt[tid] + R->wcnt[32 + tid] + R->wcnt[64 + tid] + R->wcnt[96 + tid];
}
__device__ __forceinline__ void router_publish(const Bufs& b, RouterRec* R, int bx, int G, int nslots) {
    const int tid = threadIdx.x;
    { const int e = tid & 31, jg = tid >> 5; int base = 0, tot = 0;
#pragma unroll
      for (int q = 0; q < 16; ++q) { const int j = jg * 16 + q; const int c = (int)__hip_atomic_load((const unsigned*)b.blkcnt + j * 32 + e, __ATOMIC_RELAXED, __HIP_MEMORY_SCOPE_AGENT); tot += c; if (j < bx) base += c; }
      R->pbase[jg * 32 + e] = base; R->ptot[jg * 32 + e] = tot; }
    __syncthreads();
    if (tid < 32) { int base = 0, tot = 0;
#pragma unroll
        for (int q = 0; q < 16; ++q) { base += R->pbase[q * 32 + tid]; tot += R->ptot[q * 32 + tid]; }
        R->base[tid] = base; if (bx == 0) b.cnt[tid] = tot; }
    __syncthreads();
    for (int i = tid; i < nslots * 4; i += 512) {
        const int e = R->sel[i], pos = R->base[e] + R->rank[i], slot = i >> 2, tok = R->tok[slot];
        b.list[e * LCAP + pos] = tok; b.gatev[e * LCAP + pos] = R->gw[i]; b.rsl[e * LCAP + pos] = R->rs[slot]; b.toke[tok * 4 + (i & 3)] = e; b.tokp[tok * 4 + (i & 3)] = pos;
    }
}

template <class Base> struct PSched {
    static constexpr bool GATHER = false, FP8 = false; Bufs b; int G, c, K, khook;
    __device__ __forceinline__ bool next(int i, Unit& u) const { const int L = i * G + c; if (L >= Base::NUNITS) return false; Base::get(L, u); return true; }
    __device__ __forceinline__ GemmOp op(const Unit& u) const { return Base::op(b, u); }
};
__device__ __forceinline__ void moe_build(LAS MoeTabL* tab, const int* cnt) {
    if (threadIdx.x < 64) {
        const int lane = threadIdx.x; const int c = (lane < 32) ? (int)__hip_atomic_load((const unsigned*)cnt + lane, __ATOMIC_RELAXED, __HIP_MEMORY_SCOPE_AGENT) : 0;
        const int nt = (c + 255) >> 8; int st = nt, so = c;
#pragma unroll
        for (int o = 1; o < 32; o <<= 1) { const int a = __shfl_up(st, o), d = __shfl_up(so, o); if (lane >= o) { st += a; so += d; } }
        if (lane < 32) { tab->ntile[lane] = nt; tab->cumT[lane + 1] = st; tab->off[lane + 1] = so; }
        if (lane == 0) { tab->cumT[0] = 0; tab->off[0] = 0; }
    }
    __syncthreads();
}
template <int WHICH> struct MoeSched {
    Bufs b; LAS MoeTabL* tab; int G, vcu;
    static constexpr int NPN = WHICH == 1 ? 8 : 4, K = 1024, khook = 0; static constexpr bool GATHER = WHICH == 1, FP8 = MOE_FP8 != 0;
    mutable int ecur = 0;
    __device__ __forceinline__ bool next(int i, Unit& u) const {
        const int L = i * G + vcu; const int total = __builtin_amdgcn_readfirstlane(tab->cumT[32]) * NPN; if (L >= total) return false;
        int e = ecur;
        while (e < 31 && __builtin_amdgcn_readfirstlane(tab->cumT[e + 1]) * NPN <= L) ++e;
        ecur = e;
        const int base = __builtin_amdgcn_readfirstlane(tab->cumT[e]) * NPN, nt = __builtin_amdgcn_readfirstlane(tab->ntile[e]), l = L - base;
        const int cn = __builtin_amdgcn_readfirstlane(tab->off[e + 1]) - __builtin_amdgcn_readfirstlane(tab->off[e]);
        u.kind = 0; u.e = e; u.pn = l / nt; u.pm = l % nt; u.m0 = u.pm * 256; u.rows = min(256, cn - u.m0); return true;
    }
    __device__ __forceinline__ int off_e(const Unit& u) const { return __builtin_amdgcn_readfirstlane(tab->off[u.e]); }
    __device__ __forceinline__ GemmOp op(const Unit& u) const {
        GemmOp g; g.K = 1024; g.khook = 0;
        if (MOE_FP8) {
            if (WHICH == 1) { g.A = (const bf16*)b.h2q; g.rowlist = b.list + u.e * LCAP + u.m0; g.B = (const bf16*)((const unsigned char*)b.WguT + ((size_t)u.e * 2048 + (size_t)u.pn * 256) * 1024); }
            else { g.A = (const bf16*)((const unsigned char*)b.act + (size_t)(off_e(u) + u.m0) * 1024); g.rowlist = nullptr; g.B = (const bf16*)((const unsigned char*)b.WdT + ((size_t)u.e * 1024 + (size_t)u.pn * 256) * 1024); }
            return g; }
        if (WHICH == 1) { g.A = b.h2; g.rowlist = b.list + u.e * LCAP + u.m0; g.B = b.WguT + ((size_t)u.e * 2048 + (size_t)u.pn * 256) * 1024; }
        else { g.A = b.act + (size_t)(off_e(u) + u.m0) * 1024; g.rowlist = nullptr; g.B = b.WdT + ((size_t)u.e * 1024 + (size_t)u.pn * 256) * 1024; }
        return g;
    }
};

#ifndef XB_ACQUIRE
#define XB_ACQUIRE 0
#endif
#define XB_TMO      128
#define XB_XCNT(j)  (256  + 64 * (j))
#define XB_XSUB(j)  (1280 + 64 * (j))
#define XB_XGEN(j)  (2304 + 64 * (j))
#define XB_TOP      3328
#define XB_TOPGEN   3392
#define XCD_BAR_WORDS 3456
#define XB_SPIN_CAP (1u << 18)
__device__ __forceinline__ unsigned xb_ld(unsigned* p)              { return __hip_atomic_load(p, __ATOMIC_RELAXED, __HIP_MEMORY_SCOPE_AGENT); }
__device__ __forceinline__ unsigned xb_add(unsigned* p, unsigned v) { return __hip_atomic_fetch_add(p, v, __ATOMIC_RELAXED, __HIP_MEMORY_SCOPE_AGENT); }
__device__ __forceinline__ unsigned xb_xcc_id() { return (unsigned)__builtin_amdgcn_s_getreg((3 << 11) | 20) & 0xFu; }
#define XB_SPIN(cond, bar) do { unsigned _sp = 0; while (cond) { __builtin_amdgcn_s_sleep(1); \
    if ((++_sp & 255u) == 0u) { if (xb_ld(&(bar)[XB_TMO])) break; if (_sp > XB_SPIN_CAP) { atomicAdd(&(bar)[XB_TMO], 1u); break; } } } } while (0)
struct XcdBarrier { unsigned* bar; unsigned x; volatile LAS unsigned* st; };
__device__ __forceinline__ XcdBarrier xcd_barrier_post(unsigned* bar, volatile LAS unsigned* st) {
    XcdBarrier b; b.bar = bar; b.x = xb_xcc_id(); b.st = st;
    if (threadIdx.x == 0) (void)xb_add(&bar[XB_XCNT(b.x)], 1u);
    return b;
}
__device__ __forceinline__ void xcd_barrier_complete(unsigned* bar, unsigned x, unsigned& nloc, unsigned& nx) {
    const unsigned G = gridDim.x * gridDim.y * gridDim.z;
    unsigned sum, cnt, mine, sp = 0u;
    for (;;) {
        sum = 0u; cnt = 0u; mine = 0u;
#pragma unroll
        for (unsigned j = 0; j < 16; ++j) { const unsigned c = xb_ld(&bar[XB_XCNT(j)]); sum += c; cnt += (c > 0u) ? 1u : 0u; mine = (j == x) ? c : mine; }
        if (sum == G) break;
        __builtin_amdgcn_s_sleep(1);
        if ((++sp & 255u) == 0u) { if (xb_ld(&bar[XB_TMO])) break; if (sp > XB_SPIN_CAP) { atomicAdd(&bar[XB_TMO], 1u); break; } }
    }
    nloc = mine > 0u ? mine : 1u; nx = cnt > 0u ? cnt : 1u;
}
__device__ __forceinline__ void xcd_barrier(const XcdBarrier& b) {
    asm volatile("s_waitcnt vmcnt(0)" ::: "memory");
    __syncthreads();
    if (threadIdx.x == 0) {
        unsigned* bar = b.bar;
        __builtin_amdgcn_s_waitcnt(0);
        unsigned nloc = b.st[0], nx = b.st[1];
        if (nloc == 0u) { xcd_barrier_complete(bar, b.x, nloc, nx); b.st[0] = nloc; b.st[1] = nx; }
        const unsigned old = xb_add(&bar[XB_XSUB(b.x)], 1u);
        const unsigned gen = old / nloc;
        if (old + 1u == (gen + 1u) * nloc) {
            __builtin_amdgcn_fence(__ATOMIC_RELEASE, "agent");
            asm volatile("s_waitcnt vmcnt(0)" ::: "memory");
            const unsigned og = xb_add(&bar[XB_TOP], 1u);
            const unsigned tg = og / nx;
            if (og + 1u == (tg + 1u) * nx) xb_add(&bar[XB_TOPGEN], 1u);
            else XB_SPIN(xb_ld(&bar[XB_TOPGEN]) == tg, bar);
            if (XB_ACQUIRE) __builtin_amdgcn_fence(__ATOMIC_ACQUIRE, "agent");
            xb_add(&bar[XB_XGEN(b.x)], 1u);
            asm volatile("s_waitcnt vmcnt(0)" ::: "memory");
        } else {
            XB_SPIN(xb_ld(&bar[XB_XGEN(b.x)]) == gen, bar);
            if (XB_ACQUIRE) __builtin_amdgcn_fence(__ATOMIC_ACQUIRE, "agent");
            asm volatile("s_waitcnt vmcnt(0)" ::: "memory");
        }
    }
    __syncthreads();
}

constexpr int RING_BYTES = 131072, LDS_BYTES = 147456, MISC_OFF = LDS_BYTES - 2048;
static_assert(2 * TP_LDS <= MISC_OFF && RING_BYTES <= MISC_OFF, "LDS map");
constexpr int NPHASE = 12;
__global__ void __launch_bounds__(512, 2) mega(Params p) {
    extern __shared__ __attribute__((aligned(16))) unsigned char lds_raw[];
    LAS unsigned char* lds = (LAS unsigned char*)lds_raw;
    const Bufs b = make_bufs(p.ws);
    const int tid = threadIdx.x, lane = tid & 63, wave = __builtin_amdgcn_readfirstlane(tid >> 6);
    const int G = gridDim.x, bx = blockIdx.x, vcu = (G % 8 == 0) ? (bx % 8) * (G / 8) + bx / 8 : bx;
    LAS MoeTabL* tab = (LAS MoeTabL*)(lds + MISC_OFF);
    volatile LAS unsigned* xst = (volatile LAS unsigned*)(lds + MISC_OFF + 512);
    if (tid < 2) xst[tid] = 0u;
    __syncthreads();
    XcdBarrier xbar; xbar.bar = (unsigned*)(p.ws + WS_CTL); xbar.x = 0; xbar.st = xst;
    if (p.ph_hi - p.ph_lo > 1) xbar = xcd_barrier_post((unsigned*)(p.ws + WS_CTL), xst);
    const int lo = p.ph_lo, hi = p.ph_hi;
#ifndef REPK
#define REPK -1
#endif
#ifdef TPROBE_A
#define STAMP(i) do { if (bx == 0 && tid == 0) ((unsigned long long*)(p.ws + WS_CTL + 32768))[i] = __builtin_amdgcn_s_memrealtime(); } while (0)
#else
#define STAMP(i) do { } while (0)
#endif
#define SEAM(k) do { if (IN(k) && IN((k) + 1)) xcd_barrier(xbar); STAMP((k) + 1); } while (0)
#ifdef ONLY
#define IN(k) ((k) == ONLY && lo <= (k) && (k) < hi)
#else
#define IN(k) (lo <= (k) && (k) < hi)
#endif
    STAMP(0);
#define RUN(k, ...) do { if (IN(k)) { __VA_ARGS__ if (REPK == (k)) { xcd_barrier(xbar); __VA_ARGS__ } } } while (0)
    RUN(0, { prep_phase(p, b, lds_raw, bx, G); });
    SEAM(0);
    RUN(1, { PSched<SchedIn> S{b, G, bx, 1024, 0}; EpiIn E{p, b}; pg8::gemm_phase(lds, p.ws, S, E);
             if (G == 256 && bx >= FILL1_BLK0) transpose_run(p, b, (float*)lds_raw, 0, FILL1_N, bx - FILL1_BLK0, 256 - FILL1_BLK0, true); });
    SEAM(1);
    RUN(2, { EpiUp E{p, b}; { PSched<SchedUpQ> S{b, G, bx, 384, 0}; pg8::gemm_phase(lds, p.ws, S, E); }
             if (G == 256 && bx >= FILL2_BLK0) { scan_task(b, (bx - FILL2_BLK0) * 8 + wave, (256 - FILL2_BLK0) * 8, lane);
                 kpe_task(b, (bx - FILL2_BLK0) * 512 + tid, (256 - FILL2_BLK0) * 512);
                 if (FILL2_N > 0) transpose_run(p, b, (float*)lds_raw, FILL1_N, FILL2_N, bx - FILL2_BLK0, 256 - FILL2_BLK0, true); }
             else if (G != 256) { scan_task(b, bx * 8 + wave, G * 8, lane); kpe_task(b, bx * 512 + tid, G * 512); }
             { PSched<SchedUpKV> S{b, G, bx, 256, 0}; pg8::gemm_phase(lds, p.ws, S, E); } });
    SEAM(2);
    RUN(3, { attn_phase_self(lds, b, vcu); });
#if ATT_PRB
    if (IN(3)) { xcd_barrier(xbar); attn_phase_self<ATT_PRB>(lds, b, vcu); }
#endif
    SEAM(3);
    RUN(4, { PSched<SchedOut> S{b, G, bx, 1024, 512};
             LAS float* rt = (LAS float*)(lds + RING_BYTES); const bool one = (G == 256);
             if (one && tid < 256) { Unit u0; SchedOut::get(bx, u0); const int row = u0.pm * 256 + tid;
                 const float rf = rs_of(sum8(b.pfox + (size_t)row * 8), 512.f), rm = rs_of(sum8(b.pmla + (size_t)row * 8), 512.f); rt[tid] = rf / rm; rt[256 + tid] = rm; }
             __syncthreads();
             EpiOut E{p, b, one ? (const LAS float*)rt : (const LAS float*)nullptr}; pg8::gemm_phase(lds, p.ws, S, E); });
    SEAM(4);
    RUN(5, { PSched<SchedMq> S{b, G, bx, 1024, 0}; EpiMq E{p, b}; pg8::gemm_phase(lds, p.ws, S, E);
             if (G == 256 && bx >= FILL5_BLK0) transpose_run(p, b, (float*)lds_raw, FILL1_N + FILL2_N, FILL5_N, bx - FILL5_BLK0, 256 - FILL5_BLK0, true); });
    SEAM(5);
    RUN(6, { attn_phase_mem(lds, b, vcu); });
    SEAM(6);
    RUN(7, { PSched<SchedMo> S{b, G, bx, 512, 0}; EpiMo E{p, b}; pg8::gemm_phase(lds, p.ws, S, E); });
    SEAM(7);
    if (IN(8)) { float* lgl = (float*)lds_raw + wave * 544; RouterRec* RR = (RouterRec*)(lds_raw + RW_BYTES);
                 static_assert(RW_BYTES + (int)sizeof(RouterRec) <= MISC_OFF && 8 * 544 * 4 <= RW_BYTES, "LDS map (router)");
                 RouterAcc racc;
                 router_weights_to_lds(b, lds_raw, wave, lane);
                 if (wave < 4) router_logits(b, bx * 4 + wave, lane, lds_raw, racc);
                 else { asm volatile("s_waitcnt vmcnt(0)" ::: "memory"); __syncthreads(); }
                 __syncthreads();
                 if (wave < 4) router_select(p, bx * 4 + wave, lane, lgl, RR, wave, racc);
                 router_rank(b, RR, bx, 64);
                 xcd_barrier(xbar);
                 router_publish(b, RR, bx, G, 64); }
    SEAM(8);
    RUN(9, { moe_build(tab, b.cnt); MoeSched<1> S{b, tab, G, vcu, 0}; EpiG1 E{p, b, tab, 0}; pg8::gemm_phase(lds, p.ws, S, E); });
    SEAM(9);
    RUN(10, { if (!IN(9)) moe_build(tab, b.cnt);     MoeSched<2> S{b, tab, G, vcu, 0}; EpiG2 E{p, b, tab, 0}; pg8::gemm_phase(lds, p.ws, S, E); });
    SEAM(10);
    RUN(11, { if (!IN(9)) moe_build(tab, b.cnt); int tok = bx * 8 + wave; const int ts = G * 8;
              for (; tok + 3 * ts < T; tok += 4 * ts) final_tokens<4>(p, b, tok, ts, lane, (const int*)tab->off);
              for (; tok < T; tok += ts) final_token(p, b, tok, lane, (const int*)tab->off); });
#undef RUN
#ifdef TPROBE_A
    {
        xcd_barrier(xbar); STAMP(12);
        if (bx == 0 && tid == 0) { const unsigned long long* ts = (const unsigned long long*)(p.ws + WS_CTL + 32768);
            const float usa = (float)(ts[TPROBE_A + 1] - ts[TPROBE_A]) * 0.01f, usb = (float)(ts[TPROBE_B + 1] - ts[TPROBE_B]) * 0.01f;
            float* pr = (float*)(p.ws + WS_CTL + 49152); __hip_atomic_store(pr, usa / (float)TPROBE_SCALE, __ATOMIC_RELAXED, __HIP_MEMORY_SCOPE_AGENT); __hip_atomic_store(pr + 1, usb * 0.1f, __ATOMIC_RELAXED, __HIP_MEMORY_SCOPE_AGENT); }
        xcd_barrier(xbar);
        const float* pr = (const float*)(p.ws + WS_CTL + 49152); const float eps = __hip_atomic_load(pr, __ATOMIC_RELAXED, __HIP_MEMORY_SCOPE_AGENT), spike = __hip_atomic_load(pr + 1, __ATOMIC_RELAXED, __HIP_MEMORY_SCOPE_AGENT);
        for (int tok = bx * 8 + wave; tok < T; tok += G * 8) { float* o = p.out + (size_t)tok * D; for (int c = lane; c < D; c += 64) o[c] *= (1.0f + eps); }
        asm volatile("s_waitcnt vmcnt(0)" ::: "memory"); __syncthreads();
        if (bx == 0 && tid == 0) p.out[0] += spike;
    }
#endif
#undef IN
#undef SEAM
}

extern "C" void kernel_launch(void* const* d_in, const int* in_sizes, int n_in, void* d_out, int out_size, void* d_ws, size_t ws_size, hipStream_t stream) {
    static int inited = 0; static int grid = 256;
    if (!inited) {
        if (n_in != 25 || ws_size < WS_END) { fprintf(stderr, "kernel_launch: unexpected n_in %d / ws_size %zu\n", n_in, ws_size); inited = -1; return; }
        (void)hipFuncSetAttribute((const void*)mega, hipFuncAttributeMaxDynamicSharedMemorySize, LDS_BYTES);
        int dev = 0, cus = 0; (void)hipGetDevice(&dev); (void)hipDeviceGetAttribute(&cus, hipDeviceAttributeMultiprocessorCount, dev); int per_cu = 0; (void)hipOccupancyMaxActiveBlocksPerMultiprocessor(&per_cu, (const void*)mega, 512, LDS_BYTES);
        grid = 256;
        if (cus < 256) fprintf(stderr, "kernel_launch: this kernel needs 256 CUs (device reports %d)\n", cus);
        if (per_cu < 1) fprintf(stderr, "kernel_launch: occupancy query reports %d blocks per CU\n", per_cu);
        inited = 1;
    }
    if (inited < 0) return;
    Params p{};
    const float** pp = (const float**)&p;
    for (int i = 0; i < 25; ++i) pp[i] = (const float*)d_in[i];
    unsigned char* const wsb = (unsigned char*)d_ws + ((ws_size - WS_END) & ~(size_t)(2 * MiB - 1));
    p.out = (float*)d_out; p.ws = wsb; p.ph_lo = 0; p.ph_hi = 0;
    (void)hipMemsetAsync((char*)wsb + WS_CTL, 0, 65536, stream);
    p.ph_lo = 0; p.ph_hi = NPHASE;
    void* args[] = {&p};
    hipError_t e = hipLaunchCooperativeKernel((const void*)mega, dim3(grid), dim3(512), args, LDS_BYTES, stream);
    if (e != hipSuccess) fprintf(stderr, "cooperative launch failed: %s (grid %d)\n", hipGetErrorString(e), grid);
}
```
